# Optimizing an MI355X kernel written in HIP

```python
import math
import jax, jax.numpy as jnp
from jax import lax
import numpy as np

D_MODEL = 1024
BATCH = 4
SEQ = 4096
DEPTH = 1

HEAD_DIM = 64
NSA_HEADS = 8
NSA_KV_HEADS = 2
NSA_GROUP = NSA_HEADS // NSA_KV_HEADS
SB_HEADS = 8
NSA_WIDTH = NSA_HEADS * HEAD_DIM
SB_WIDTH = SB_HEADS * HEAD_DIM
MIX_WIDTH = NSA_WIDTH + SB_WIDTH
NSA_KV_WIDTH = NSA_KV_HEADS * HEAD_DIM
N_BRANCH = 3
CMP_LEN = 32
CMP_STRIDE = 16
CMP_HIDDEN = HEAD_DIM
SLC_LEN = 64
SLC_TOPN = 16
WINDOW = 512
Q_BLOCK = 128
ROPE_DIM = HEAD_DIM // 4
ROPE_THETA = 500000.0
EPS = 1e-6
FORCE_BONUS = 1.0e4
IN_SIZES = (NSA_WIDTH,
            NSA_KV_WIDTH, NSA_KV_WIDTH,
            NSA_KV_WIDTH, NSA_KV_WIDTH,
            NSA_KV_WIDTH, NSA_KV_WIDTH,
            NSA_HEADS * N_BRANCH,
            NSA_WIDTH,
            SB_WIDTH, SB_WIDTH, SB_WIDTH,
            SB_WIDTH)
IN_COLS = sum(IN_SIZES)

kernel_name = "hybrid_nsa_stickbreaking_layer"


def rms_norm(x, g):
    xf = x.astype(jnp.float32)
    y = xf * lax.rsqrt(jnp.mean(xf * xf, axis=-1, keepdims=True) + EPS)
    return (y * g.astype(jnp.float32)).astype(x.dtype)


def rope_partial(x, pos):
    inv_freq = jnp.power(ROPE_THETA, -jnp.arange(0, ROPE_DIM, 2, dtype=jnp.float32) / ROPE_DIM)
    ang = pos.astype(jnp.float32)[:, None] * inv_freq[None, :]
    cos = jnp.cos(ang).astype(x.dtype)
    sin = jnp.sin(ang).astype(x.dtype)
    half = ROPE_DIM // 2
    x1, x2, rest = x[..., :half], x[..., half:ROPE_DIM], x[..., ROPE_DIM:]
    return jnp.concatenate([x1 * cos - x2 * sin, x2 * cos + x1 * sin, rest], axis=-1)


def masked_softmax(logits, mask):
    logits = jnp.where(mask, logits.astype(jnp.float32), -jnp.inf)
    m = jnp.max(logits, axis=-1, keepdims=True)
    m = jnp.where(jnp.isfinite(m), m, 0.0)
    p = jnp.where(mask, jnp.exp(logits - m), 0.0)
    return p / jnp.maximum(jnp.sum(p, axis=-1, keepdims=True), 1e-30)


def compress(blocks, pos_emb, w1, b1, w2):
    b_, g_, n_, l_, d_ = blocks.shape
    flat = (blocks + pos_emb).reshape(b_, g_, n_, l_ * d_)
    return jax.nn.silu(flat @ w1 + b1) @ w2


def setup_inputs(seed: int = 0) -> dict:
    key = jax.random.key(seed)
    ks = jax.random.split(key, 20)
    f32 = jnp.float32
    nrm = lambda k, shape, s: jax.random.normal(k, shape, f32) * s
    return {
        "x": nrm(ks[0], (BATCH, SEQ, D_MODEL), 1.0),
        "norm_gain": 1.0 + nrm(ks[1], (D_MODEL,), 0.01),
        "w_in": nrm(ks[2], (D_MODEL, IN_COLS), D_MODEL ** -0.5),
        "q_norm_gain": 1.0 + nrm(ks[3], (HEAD_DIM,), 0.01),
        "k_norm_cmp": 1.0 + nrm(ks[4], (HEAD_DIM,), 0.01),
        "k_norm_slc": 1.0 + nrm(ks[5], (HEAD_DIM,), 0.01),
        "k_norm_win": 1.0 + nrm(ks[6], (HEAD_DIM,), 0.01),
        "cmp_k_pos": nrm(ks[7], (CMP_LEN, HEAD_DIM), 0.02),
        "cmp_k_w1": nrm(ks[8], (CMP_LEN * HEAD_DIM, CMP_HIDDEN), (CMP_LEN * HEAD_DIM) ** -0.5),
        "cmp_k_b1": nrm(ks[9], (CMP_HIDDEN,), 0.01),
        "cmp_k_w2": nrm(ks[10], (CMP_HIDDEN, HEAD_DIM), CMP_HIDDEN ** -0.5),
        "cmp_v_pos": nrm(ks[11], (CMP_LEN, HEAD_DIM), 0.02),
        "cmp_v_w1": nrm(ks[12], (CMP_LEN * HEAD_DIM, CMP_HIDDEN), (CMP_LEN * HEAD_DIM) ** -0.5),
        "cmp_v_b1": nrm(ks[13], (CMP_HIDDEN,), 0.01),
        "cmp_v_w2": nrm(ks[14], (CMP_HIDDEN, HEAD_DIM), CMP_HIDDEN ** -0.5),
        "w_out": nrm(ks[15], (MIX_WIDTH, D_MODEL), MIX_WIDTH ** -0.5),
    }


def reference(x, norm_gain, w_in, q_norm_gain, k_norm_cmp, k_norm_slc, k_norm_win,
              cmp_k_pos, cmp_k_w1, cmp_k_b1, cmp_k_w2,
              cmp_v_pos, cmp_v_w1, cmp_v_b1, cmp_v_w2, w_out):
    B, S, _ = x.shape
    G, R, D = NSA_KV_HEADS, NSA_GROUP, HEAD_DIM
    nq = S // Q_BLOCK
    scale = 1.0 / math.sqrt(D)
    pos = jnp.arange(S, dtype=jnp.int32)

    def heads(t, n):
        return t.reshape(B, S, n, D).transpose(0, 2, 1, 3)

    for _layer in range(DEPTH):
        h = rms_norm(x, norm_gain)
        proj = h @ w_in
        parts, off = [], 0
        for sz in IN_SIZES:
            parts.append(proj[..., off:off + sz])
            off += sz
        (q_n, kc, vc, ks_, vs_, kw, vw, gate_logits, gate_nsa,
         q_sb, k_sb, v_sb, gate_sb) = parts

        q = rope_partial(rms_norm(heads(q_n, NSA_HEADS), q_norm_gain), pos)
        qg = q.reshape(B, G, R, S, D)

        n_cmp = (S - CMP_LEN) // CMP_STRIDE + 1
        tok_idx = jnp.arange(n_cmp)[:, None] * CMP_STRIDE + jnp.arange(CMP_LEN)[None, :]
        kc_blk = heads(kc, G)[:, :, tok_idx]
        vc_blk = heads(vc, G)[:, :, tok_idx]
        cmp_end = jnp.arange(n_cmp, dtype=jnp.int32) * CMP_STRIDE + (CMP_LEN - 1)
        k_cmp = rope_partial(rms_norm(compress(kc_blk, cmp_k_pos, cmp_k_w1, cmp_k_b1, cmp_k_w2),
                                      k_norm_cmp), cmp_end)
        v_cmp = compress(vc_blk, cmp_v_pos, cmp_v_w1, cmp_v_b1, cmp_v_w2)
        cmp_logits = jnp.einsum('bgrtd,bgnd->bgrtn', qg, k_cmp) * scale
        cmp_mask = cmp_end[None, :] <= pos[:, None]
        p_cmp = masked_softmax(cmp_logits, cmp_mask)
        o_cmp = jnp.einsum('bgrtn,bgnd->bgrtd', p_cmp.astype(v_cmp.dtype), v_cmp)

        n_slc = S // SLC_LEN
        cs = jnp.arange(n_cmp) * CMP_STRIDE
        ss = jnp.arange(n_slc) * SLC_LEN
        overlap = jnp.clip(jnp.minimum(cs[:, None] + CMP_LEN, ss[None, :] + SLC_LEN)
                           - jnp.maximum(cs[:, None], ss[None, :]), 0, None)
        overlap = overlap.astype(jnp.float32) / CMP_LEN
        p_slc = jnp.einsum('bgrtn,nj->bgtj', p_cmp, overlap)
        blk_t = pos // SLC_LEN
        j_idx = jnp.arange(n_slc)
        slc_valid = j_idx[None, :] <= blk_t[:, None]
        forced = (j_idx[None, :] == 0) | (j_idx[None, :] == blk_t[:, None]) | (j_idx[None, :] == blk_t[:, None] - 1)
        sel_logit = jnp.where(slc_valid, p_slc + jnp.where(forced, FORCE_BONUS, 0.0), -jnp.inf)
        top_n = min(SLC_TOPN, n_slc)
        sel_score, sel_idx = lax.top_k(sel_logit, top_n)
        sel_ok = jnp.isfinite(sel_score)

        k_slc = rope_partial(rms_norm(heads(ks_, G), k_norm_slc), pos).reshape(B, G, n_slc, SLC_LEN, D)
        v_slc = heads(vs_, G).reshape(B, G, n_slc, SLC_LEN, D)
        qb = jnp.moveaxis(qg.reshape(B, G, R, nq, Q_BLOCK, D), 3, 0)
        idx_b = jnp.moveaxis(sel_idx.reshape(B, G, nq, Q_BLOCK, top_n), 2, 0)
        ok_b = jnp.moveaxis(sel_ok.reshape(B, G, nq, Q_BLOCK, top_n), 2, 0)
        pos_b = pos.reshape(nq, Q_BLOCK)
        b_ix = jnp.arange(B)[:, None, None, None]
        g_ix = jnp.arange(G)[None, :, None, None]
        n_keys = top_n * SLC_LEN

        def slc_block(args):
            q_i, idx_i, ok_i, t_i = args
            k_sel = k_slc[b_ix, g_ix, idx_i].reshape(B, G, Q_BLOCK, n_keys, D)
            v_sel = v_slc[b_ix, g_ix, idx_i].reshape(B, G, Q_BLOCK, n_keys, D)
            key_pos = (idx_i[..., None] * SLC_LEN + jnp.arange(SLC_LEN)).reshape(B, G, Q_BLOCK, n_keys)
            ok = jnp.repeat(ok_i, SLC_LEN, axis=-1) & (key_pos <= t_i[None, None, :, None])
            logits = jnp.einsum('bgrtd,bgtkd->bgrtk', q_i, k_sel) * scale
            p = masked_softmax(logits, ok[:, :, None])
            return jnp.einsum('bgrtk,bgtkd->bgrtd', p.astype(v_sel.dtype), v_sel)

        o_slc = lax.map(slc_block, (qb, idx_b, ok_b, pos_b))
        o_slc = jnp.moveaxis(o_slc, 0, 3).reshape(B, G, R, S, D)

        n_wb = WINDOW // Q_BLOCK
        k_win = rope_partial(rms_norm(heads(kw, G), k_norm_win), pos)
        v_win = heads(vw, G)
        padw = ((0, 0), (0, 0), (WINDOW, 0), (0, 0))
        kpad = jnp.pad(k_win, padw).reshape(B, G, nq + n_wb, Q_BLOCK, D)
        vpad = jnp.pad(v_win, padw).reshape(B, G, nq + n_wb, Q_BLOCK, D)
        k_band = jnp.concatenate([kpad[:, :, i:i + nq] for i in range(n_wb + 1)], axis=3)
        v_band = jnp.concatenate([vpad[:, :, i:i + nq] for i in range(n_wb + 1)], axis=3)
        band_len = (n_wb + 1) * Q_BLOCK
        kp = jnp.arange(nq)[:, None] * Q_BLOCK - WINDOW + jnp.arange(band_len)[None, :]
        qp = pos.reshape(nq, Q_BLOCK)
        dist = qp[:, :, None] - kp[:, None, :]
        win_mask = (kp[:, None, :] >= 0) & (dist >= 0) & (dist < WINDOW)
        qw = qg.reshape(B, G, R, nq, Q_BLOCK, D)
        w_logits = jnp.einsum('bgrnqd,bgnkd->bgrnqk', qw, k_band) * scale
        p_win = masked_softmax(w_logits, win_mask)
        o_win = jnp.einsum('bgrnqk,bgnkd->bgrnqd', p_win.astype(v_band.dtype), v_band).reshape(B, G, R, S, D)

        gates = jax.nn.sigmoid(gate_logits.reshape(B, S, NSA_HEADS, N_BRANCH).transpose(0, 2, 1, 3)
                               .reshape(B, G, R, S, N_BRANCH))
        o_nsa = gates[..., 0:1] * o_cmp + gates[..., 1:2] * o_slc + gates[..., 2:3] * o_win
        o_nsa = o_nsa.reshape(B, NSA_HEADS, S, D).transpose(0, 2, 1, 3).reshape(B, S, NSA_WIDTH)
        o_nsa = o_nsa * jax.nn.silu(gate_nsa)

        q_s = heads(q_sb, SB_HEADS)
        k_s = heads(k_sb, SB_HEADS)
        v_s = heads(v_sb, SB_HEADS)
        qsb_b = jnp.moveaxis(q_s.reshape(B, SB_HEADS, nq, Q_BLOCK, D), 2, 0)

        def sb_block(args):
            q_i, t_i = args
            z = jnp.einsum('bhtd,bhsd->bhts', q_i, k_s).astype(jnp.float32) * scale
            causal = pos[None, :] < t_i[:, None]
            log_1m = jnp.where(causal, jax.nn.log_sigmoid(-z), 0.0)
            after = lax.cumsum(log_1m, axis=3, reverse=True) - log_1m
            a = jnp.where(causal, jnp.exp(jax.nn.log_sigmoid(z) + after), 0.0)
            return jnp.einsum('bhts,bhsd->bhtd', a.astype(v_s.dtype), v_s)

        o_sb = lax.map(sb_block, (qsb_b, pos_b))
        o_sb = jnp.moveaxis(o_sb, 0, 2).reshape(B, SB_HEADS, S, D).transpose(0, 2, 1, 3).reshape(B, S, SB_WIDTH)
        o_sb = o_sb * jax.nn.silu(gate_sb)

        mix = jnp.concatenate([o_nsa, o_sb], axis=-1)
        x = x + mix @ w_out
    return x
```

```cpp
#include <hip/hip_runtime.h>
#include <hip/hip_cooperative_groups.h>
#include <cstdio>
#include <cstdint>
#include <cmath>
namespace cg = cooperative_groups;
__device__ __forceinline__ int lane_id_opaque_g() { int x; asm volatile("v_mbcnt_lo_u32_b32 %0, -1, 0\n\tv_mbcnt_hi_u32_b32 %0, -1, %0" : "=v"(x)); return x; }
#define TIDX_G ((wv_ << 6) + lane_id_opaque_g())
namespace pg8 {
#define PG8_LAS __attribute__((address_space(3)))
typedef unsigned short bf16_t;
typedef short bf16x8 __attribute__((ext_vector_type(8)));
typedef float f32x4 __attribute__((ext_vector_type(4)));
typedef unsigned u32x4 __attribute__((ext_vector_type(4)));
constexpr int BM = 256, BK = 64, HALF = 128, HTB = HALF * BK * 2  , STAGE_BYTES = 8 * HTB, NXCD = 8, WGM = 8;

__host__ __device__ __forceinline__ int lds_byte(int r, int c) { const int st = (r >> 4) * 2 + (c >> 5), rr = r & 15, cc = c & 31, ob = rr * 64 + cc * 2; return st * 1024 + (ob ^ (((ob >> 9) & 1) << 5)); }
__host__ __device__ __forceinline__ void stage_rc(int b, int& R, int& C) { const int st = b / 1024, sb = b % 1024, swz = sb ^ (((sb >> 9) & 1) << 5); R = (st >> 1) * 16 + swz / 64; C = (st & 1) * 32 + (swz % 64) / 2; }
__host__ __device__ __forceinline__ int perm32(int rho) { const int n = rho >> 4, i = rho & 15; return 8 * (i >> 2) + 4 * n + (i & 3); }

struct Unit { int pm, pn; };
struct Gemm { const bf16_t* A; const bf16_t* Bt; int M, N, K; };

struct StaticOrder {
    int nM, nN, nwg, G, c;
    __host__ __device__ void init(int M, int N, int G_, int c_) { nM = M / BM; nN = N / BM; nwg = nM * nN; G = G_; c = c_; }
    __host__ __device__ bool next(int i, Unit& u) const {
        const long L = (long)i * G + c; if (L >= nwg) return false;
        int wgid = (int)L; { const int q = nwg / NXCD, r = nwg % NXCD, xcd = wgid % NXCD, off = wgid / NXCD; wgid = (xcd < r ? xcd * (q + 1) : r * (q + 1) + (xcd - r) * q) + off; }
        const int nig = WGM * nN, gid = wgid / nig, fm = gid * WGM, gsz = (nM - fm) < WGM ? (nM - fm) : WGM;
        u.pm = fm + ((wgid % nig) % gsz); u.pn = (wgid % nig) / gsz; return true;
    }
    __device__ __forceinline__ void a_ready(const Unit&) const {}
    __device__ __forceinline__ void done(const Unit&) const {}
};

__device__ __forceinline__ unsigned cvt_pk_bf16(float lo, float hi) { unsigned r; asm volatile("v_cvt_pk_bf16_f32 %0, %1, %2" : "=v"(r) : "v"(lo), "v"(hi)); return r; }
struct EpiProj {
    static constexpr bool PERM = true, AFTER_DRAIN = false;
    bf16_t* O; int ldc; const float* rstd;
    __device__ __forceinline__ void operator()(const f32x4 (&acc)[2][2][4][2], const Unit& u, int wr, int wc, int fr, int fq) const {
        const int row0 = u.pm * BM + wr * 64 + fr; const int col0 = u.pn * BM + wc * 32 + 8 * fq;
        float sc[2][4];
#pragma unroll
        for (int ai = 0; ai < 2; ++ai)
#pragma unroll
            for (int m = 0; m < 4; ++m) sc[ai][m] = rstd[row0 + ai * HALF + m * 16];
#pragma unroll
        for (int ai = 0; ai < 2; ++ai)
#pragma unroll
            for (int m = 0; m < 4; ++m) { const int row = row0 + ai * HALF + m * 16; const float s = sc[ai][m]; bf16_t* rowp = O + (size_t)row * ldc + col0;
#pragma unroll
                for (int bj = 0; bj < 2; ++bj) { f32x4 v0 = acc[ai][bj][m][0] * s, v1 = acc[ai][bj][m][1] * s;
                    u32x4 w; w.x = cvt_pk_bf16(v0[0], v0[1]); w.y = cvt_pk_bf16(v0[2], v0[3]); w.z = cvt_pk_bf16(v1[0], v1[1]); w.w = cvt_pk_bf16(v1[2], v1[3]);
                    *(u32x4*)(rowp + bj * HALF) = w; } }
    }
};
struct EpiOut {
    static constexpr bool PERM = true, AFTER_DRAIN = false;
    const float* X; float* O; int ldc;
    __device__ __forceinline__ void operator()(const f32x4 (&acc)[2][2][4][2], const Unit& u, int wr, int wc, int fr, int fq) const {
        const int row0 = u.pm * BM + wr * 64 + fr; const int col0 = u.pn * BM + wc * 32 + 8 * fq;
#pragma unroll
        for (int ai = 0; ai < 2; ++ai) {
            f32x4 xa[4][2][2];
#pragma unroll
            for (int m = 0; m < 4; ++m)
#pragma unroll
                for (int bj = 0; bj < 2; ++bj) { const size_t off = (size_t)(row0 + ai * HALF + m * 16) * ldc + col0 + bj * HALF;
                    xa[m][bj][0] = *(const f32x4*)(X + off); xa[m][bj][1] = *(const f32x4*)(X + off + 4); }
#pragma unroll
            for (int m = 0; m < 4; ++m)
#pragma unroll
                for (int bj = 0; bj < 2; ++bj) { const size_t off = (size_t)(row0 + ai * HALF + m * 16) * ldc + col0 + bj * HALF;
                    *(f32x4*)(O + off) = xa[m][bj][0] + acc[ai][bj][m][0]; *(f32x4*)(O + off + 4) = xa[m][bj][1] + acc[ai][bj][m][1]; }
        }
    }
};
template <class Epi, class Sched, bool ALIGN_EPI = false, bool SP2 = false>
__device__ __forceinline__ void gemm_phase(PG8_LAS unsigned char* lds, const Gemm g, const Sched& S, const Epi& E, const int wv_) {
    int tid_l = TIDX_G; asm volatile("" : "+v"(tid_l));
    const int tid = tid_l, wid = __builtin_amdgcn_readfirstlane(tid >> 6), lane = tid & 63, wr = wid >> 2, wc = wid & 3, fr = lane & 15, fq = lane >> 4;
    const int K = g.K, nt = K / BK;
    unsigned voffA[2], voffB[2];
#pragma unroll
    for (int i = 0; i < 2; ++i) { int R, C; stage_rc(tid * 16 + i * 8192, R, C); const int Rb = Epi::PERM ? ((R & ~31) + perm32(R & 31)) : R;
        voffA[i] = (unsigned)(R * K + C) * 2u; voffB[i] = (unsigned)(Rb * K + C) * 2u; }
    const size_t kstep = (size_t)(BK * 2);
    const size_t hstep = (size_t)HALF * K * 2;
    const size_t tstep = 2 * hstep;
    const unsigned ldsw = (unsigned)wid * 1024u;
    const int aoff = lds_byte(wr * 64 + fr, fq * 8), boff = lds_byte(wc * 32 + fr, fq * 8);
#define PG8_SA(b, h) (((b) * 2 + (h)) * HTB)
#define PG8_SB(b, h) ((4 + (b) * 2 + (h)) * HTB)
#define PG8_STAGE(bufoff, gbase, voff) do { _Pragma("unroll") for (int _i = 0; _i < 2; ++_i) \
        __builtin_amdgcn_global_load_lds((const unsigned*)((const char*)(gbase) + (voff)[_i]), (PG8_LAS unsigned*)(lds + (bufoff) + ldsw + _i * 8192), 16, 0, 0); } while (0)
#define PG8_LDA(dst, b, h) do { _Pragma("unroll") for (int m = 0; m < 4; ++m) _Pragma("unroll") for (int k = 0; k < 2; ++k) dst[m][k] = *(const PG8_LAS bf16x8*)(lds + PG8_SA(b, h) + aoff + m * 2048 + k * 1024); } while (0)
#define PG8_LDB(dst, b, h) do { _Pragma("unroll") for (int n = 0; n < 2; ++n) _Pragma("unroll") for (int k = 0; k < 2; ++k) dst[n][k] = *(const PG8_LAS bf16x8*)(lds + PG8_SB(b, h) + boff + n * 2048 + k * 1024); } while (0)
#define PG8_MMA(ai, bj, At, Bt) do { __builtin_amdgcn_s_setprio(1); _Pragma("unroll") for (int m = 0; m < 4; ++m) _Pragma("unroll") for (int n = 0; n < 2; ++n) _Pragma("unroll") for (int k = 0; k < 2; ++k) \
        acc[ai][bj][m][n] = __builtin_amdgcn_mfma_f32_16x16x32_bf16(Bt[n][k], At[m][k], acc[ai][bj][m][n], 0, 0, 0); __builtin_amdgcn_s_setprio(0); } while (0)
#define PG8_WAIT_V(n) asm volatile("s_waitcnt vmcnt(" #n ")" ::: "memory")
#define PG8_WAIT_L(n) asm volatile("s_waitcnt lgkmcnt(" #n ")" ::: "memory")
#define PG8_BAR __builtin_amdgcn_s_barrier()
#define PG8_SCHED __builtin_amdgcn_sched_barrier(0)
    Unit cur, nxt; int ui = 0;
    if (!S.next(0, cur)) return;
    f32x4 acc[2][2][4][2];
#pragma unroll
    for (int a = 0; a < 2; ++a)
#pragma unroll
        for (int b = 0; b < 2; ++b)
#pragma unroll
            for (int m = 0; m < 4; ++m)
#pragma unroll
                for (int n = 0; n < 2; ++n) acc[a][b][m][n] = (f32x4){0.f, 0.f, 0.f, 0.f};
    bf16x8 At[4][2], B0[2][2], B1[2][2];
    const char* cA = (const char*)g.A + (size_t)cur.pm * tstep; const char* cB = (const char*)g.Bt + (size_t)cur.pn * tstep;
    S.a_ready(cur);
    if constexpr (SP2) {
        PG8_STAGE(PG8_SB(0, 0), cB, voffB); PG8_STAGE(PG8_SB(0, 1), cB + hstep, voffB); PG8_STAGE(PG8_SA(0, 0), cA, voffA); PG8_STAGE(PG8_SA(0, 1), cA + hstep, voffA);
        if (wr == 1) PG8_BAR;
        PG8_WAIT_V(2); PG8_BAR;
        PG8_STAGE(PG8_SB(1, 0), cB + kstep, voffB); PG8_STAGE(PG8_SA(1, 0), cA + kstep, voffA); PG8_STAGE(PG8_SB(1, 1), cB + hstep + kstep, voffB);
        PG8_WAIT_V(6); PG8_BAR;
    } else {
        PG8_STAGE(PG8_SB(0, 0), cB, voffB); PG8_STAGE(PG8_SA(0, 0), cA, voffA); PG8_STAGE(PG8_SB(0, 1), cB + hstep, voffB); PG8_STAGE(PG8_SA(0, 1), cA + hstep, voffA);
        if (wr == 1) PG8_BAR;
        PG8_WAIT_V(4); PG8_BAR;
        PG8_STAGE(PG8_SB(1, 0), cB + kstep, voffB); PG8_STAGE(PG8_SA(1, 0), cA + kstep, voffA); PG8_STAGE(PG8_SB(1, 1), cB + hstep + kstep, voffB);
        PG8_WAIT_V(6); PG8_BAR;
    }
    for (;;) {
        const bool has_next = S.next(ui + 1, nxt);
        const char* nA = has_next ? (const char*)g.A + (size_t)nxt.pm * tstep : cA; const char* nB = has_next ? (const char*)g.Bt + (size_t)nxt.pn * tstep : cB;
        for (int t = 0; t < nt; t += 2) {
            const bool last = (t == nt - 2);
            const char* a1 = cA + (size_t)(t + 1) * kstep;
            const char* a2 = last ? nA : cA + (size_t)(t + 2) * kstep; const char* b2 = last ? nB : cB + (size_t)(t + 2) * kstep;
            const char* a3 = a2 + kstep; const char* b3 = b2 + kstep;
            if (last && has_next) S.a_ready(nxt);
            if constexpr (SP2) {
            PG8_LDB(B0, 0, 0); PG8_LDB(B1, 0, 1); PG8_SCHED; PG8_LDA(At, 0, 0); PG8_STAGE(PG8_SA(1, 1), a1 + hstep, voffA);
            PG8_WAIT_V(8); PG8_WAIT_L(0); PG8_BAR; PG8_MMA(0, 0, At, B0); PG8_MMA(0, 1, At, B1); PG8_BAR; PG8_SCHED;
            PG8_LDA(At, 0, 1); PG8_STAGE(PG8_SB(0, 0), b2, voffB); PG8_STAGE(PG8_SB(0, 1), b2 + hstep, voffB); PG8_STAGE(PG8_SA(0, 0), a2, voffA);
            PG8_WAIT_V(8); PG8_WAIT_L(0); PG8_BAR; PG8_MMA(1, 0, At, B0); PG8_MMA(1, 1, At, B1); PG8_BAR; PG8_SCHED;
            PG8_LDB(B0, 1, 0); PG8_LDB(B1, 1, 1); PG8_SCHED; PG8_LDA(At, 1, 0); PG8_STAGE(PG8_SA(0, 1), a2 + hstep, voffA);
            PG8_WAIT_V(8); PG8_WAIT_L(0); PG8_BAR; PG8_MMA(0, 0, At, B0); PG8_MMA(0, 1, At, B1); PG8_BAR; PG8_SCHED;
            PG8_LDA(At, 1, 1); PG8_STAGE(PG8_SB(1, 0), b3, voffB); PG8_STAGE(PG8_SB(1, 1), b3 + hstep, voffB); PG8_STAGE(PG8_SA(1, 0), a3, voffA);
            PG8_WAIT_V(8); PG8_WAIT_L(0); PG8_BAR; PG8_MMA(1, 0, At, B0); PG8_MMA(1, 1, At, B1); PG8_BAR; PG8_SCHED;
            } else {
            PG8_LDB(B0, 0, 0); PG8_SCHED; PG8_LDA(At, 0, 0); PG8_STAGE(PG8_SA(1, 1), a1 + hstep, voffA);
            PG8_WAIT_L(8); PG8_BAR; PG8_WAIT_L(0); PG8_MMA(0, 0, At, B0); PG8_BAR; PG8_SCHED;
            PG8_LDB(B1, 0, 1); PG8_STAGE(PG8_SB(0, 0), b2, voffB);
            PG8_BAR; PG8_WAIT_L(0); PG8_MMA(0, 1, At, B1); PG8_BAR;
            PG8_LDA(At, 0, 1); PG8_STAGE(PG8_SA(0, 0), a2, voffA);
            PG8_BAR; PG8_WAIT_L(0); PG8_MMA(1, 0, At, B0); PG8_BAR; PG8_SCHED;
            PG8_STAGE(PG8_SB(0, 1), b2 + hstep, voffB);
            PG8_WAIT_V(6); PG8_BAR; PG8_MMA(1, 1, At, B1); PG8_BAR;
            PG8_LDB(B0, 1, 0); PG8_SCHED; PG8_LDA(At, 1, 0); PG8_STAGE(PG8_SA(0, 1), a2 + hstep, voffA);
            PG8_WAIT_L(8); PG8_BAR; PG8_WAIT_L(0); PG8_MMA(0, 0, At, B0); PG8_BAR; PG8_SCHED;
            PG8_LDB(B1, 1, 1); PG8_STAGE(PG8_SB(1, 0), b3, voffB);
            PG8_BAR; PG8_WAIT_L(0); PG8_MMA(0, 1, At, B1); PG8_BAR;
            PG8_LDA(At, 1, 1); PG8_STAGE(PG8_SA(1, 0), a3, voffA);
            PG8_BAR; PG8_WAIT_L(0); PG8_MMA(1, 0, At, B0); PG8_BAR; PG8_SCHED;
            PG8_STAGE(PG8_SB(1, 1), b3 + hstep, voffB);
            PG8_WAIT_V(6); PG8_BAR; PG8_MMA(1, 1, At, B1); PG8_BAR;
            }
        }
        if constexpr (ALIGN_EPI) { if (wr == 0) PG8_BAR; }
        if constexpr (!Epi::AFTER_DRAIN) { E(acc, cur, wr, wc, fr, fq); S.done(cur); }
        if (!has_next) break;
#pragma unroll
        for (int a = 0; a < 2; ++a)
#pragma unroll
            for (int b = 0; b < 2; ++b)
#pragma unroll
                for (int m = 0; m < 4; ++m)
#pragma unroll
                    for (int n = 0; n < 2; ++n) acc[a][b][m][n] = (f32x4){0.f, 0.f, 0.f, 0.f};
        cur = nxt; cA = nA; cB = nB; ++ui;
        if constexpr (ALIGN_EPI) { if (wr == 1) PG8_BAR; }
    }
    PG8_WAIT_V(0);
    if constexpr (!ALIGN_EPI) { if (wr == 0) PG8_BAR; }
    PG8_BAR;
    if constexpr (Epi::AFTER_DRAIN) { E.fused(acc, cur, wr, wc, fr, fq, lds, wid, lane); S.done(cur); }
#undef PG8_SA
#undef PG8_SB
#undef PG8_STAGE
#undef PG8_LDA
#undef PG8_LDB
#undef PG8_MMA
#undef PG8_WAIT_V
#undef PG8_WAIT_L
#undef PG8_BAR
#undef PG8_SCHED
}
}

#define LAS __attribute__((address_space(3)))
typedef unsigned short bf16_t;
typedef short bf16x8 __attribute__((ext_vector_type(8)));
typedef short s16x4 __attribute__((ext_vector_type(4)));
typedef float f32x4 __attribute__((ext_vector_type(4)));
typedef float f32x16 __attribute__((ext_vector_type(16)));
typedef unsigned u32x4 __attribute__((ext_vector_type(4)));
typedef unsigned u32x2 __attribute__((ext_vector_type(2)));

constexpr int NB = 4, SEQ = 4096, NTOK = NB * SEQ, DM = 1024, NCP = 4096, NCOLS = 3864;
constexpr int C_QN = 0, C_KC = 512, C_VC = 640, C_KS = 768, C_VS = 896, C_KW = 1024, C_VW = 1152, C_GN = 1280, C_QSB = 1792, C_KSB = 2304, C_VSB = 2816, C_GSB = 3328, C_GL = 3840;
constexpr size_t MiB = 1u << 20;
constexpr size_t WS_WIN = 0, WS_WOUT = 8 * MiB, WS_W1T = 10 * MiB, WS_RSTD = 11 * MiB, WS_ROPE = 11 * MiB + 64 * 1024, WS_CBIAS = 11 * MiB + 384 * 1024, WS_MB = 11 * MiB + 400 * 1024;
constexpr size_t WS_KCMP = 12 * MiB, WS_VCMP = 12 * MiB + 512 * 1024, WS_SEL = 13 * MiB, WS_CTL = 14 * MiB, WS_XB = 16 * MiB, WS_P = 48 * MiB, WS_QN = 176 * MiB, WS_KSN = 192 * MiB, WS_KWN = 196 * MiB, WS_OC = 200 * MiB, WS_OW = 216 * MiB, WS_END = 232 * MiB;
constexpr int LDS_BYTES = 135168;
constexpr float C2 = 0.125f * 1.4426950408889634f;
constexpr float EPSN = 1e-6f;

struct Args { const float* in[16]; float* out; unsigned char* ws; double invf[8]; };

__device__ __forceinline__ unsigned pk2(float lo, float hi) {
    typedef float f2_t __attribute__((ext_vector_type(2))); typedef __bf16 b2_t __attribute__((ext_vector_type(2)));
    f2_t v = {lo, hi}; b2_t b = __builtin_convertvector(v, b2_t); return __builtin_bit_cast(unsigned, b); }
__device__ __forceinline__ float bflo(unsigned u) { return __uint_as_float(u << 16); }
__device__ __forceinline__ float bfhi(unsigned u) { return __uint_as_float(u & 0xffff0000u); }
__device__ __forceinline__ float bf1(bf16_t h) { return __uint_as_float(((unsigned)h) << 16); }
__device__ __forceinline__ float ex2(float x) { return __builtin_amdgcn_exp2f(x); }
__device__ __forceinline__ float lg2(float x) { return __builtin_amdgcn_logf(x); }
__device__ __forceinline__ float sigmoidf_(float x) { return 1.f / (1.f + __expf(-x)); }
__device__ __forceinline__ float wave_sum(float v) {
#pragma unroll
    for (int o = 1; o < 64; o <<= 1) v += __shfl_xor(v, o);
    return v;
}
__device__ __forceinline__ float wave_max(float v) {
#pragma unroll
    for (int o = 1; o < 64; o <<= 1) v = fmaxf(v, __shfl_xor(v, o));
    return v;
}
#define LDS_WAIT() asm volatile("s_waitcnt lgkmcnt(0)" ::: "memory")
__device__ __forceinline__ int lane_id_opaque() { int x; asm volatile("v_mbcnt_lo_u32_b32 %0, -1, 0\n\tv_mbcnt_hi_u32_b32 %0, -1, %0" : "=v"(x)); return x; }
#define TIDX ((wv_ << 6) + lane_id_opaque())
#define MFMA32(a, b, c) __builtin_amdgcn_mfma_f32_32x32x16_bf16((a), (b), (c), 0, 0, 0)

template <int MODE>
__device__ __forceinline__ void transpose_item(const float* W, int ldw, const float* gain, bf16_t* WT, int Kd, LAS float* scr, int kb, int nb, int lane) {
    const int k0 = 64 * kb, n0 = 32 * nb, n = n0 + (lane & 31);
    int sc = n; bool ok = true;
    if (MODE == 0) { if (n < 1280) sc = n; else if (n < 3840) sc = n + 24; else if (n < NCOLS) sc = n - 3840 + 1280; else { sc = 0; ok = false; } }
    float tv[32];
#pragma unroll
    for (int i = 0; i < 32; ++i) { const int kk = 2 * i + (lane >> 5); tv[i] = ok ? W[(size_t)(k0 + kk) * ldw + sc] : 0.f; }
#pragma unroll
    for (int i = 0; i < 32; ++i) { const int kk = 2 * i + (lane >> 5); float v = tv[i]; if (MODE == 0) v *= gain[k0 + kk]; scr[kk * 33 + (lane & 31)] = v; }
    LDS_WAIT();
    const int c = lane & 7;
#pragma unroll
    for (int j = 0; j < 4; ++j) { const int nn = (lane >> 3) + 8 * j; const LAS float* s = scr + (8 * c) * 33 + nn;
        u32x4 o; o.x = pk2(s[0 * 33], s[1 * 33]); o.y = pk2(s[2 * 33], s[3 * 33]); o.z = pk2(s[4 * 33], s[5 * 33]); o.w = pk2(s[6 * 33], s[7 * 33]);
        *(u32x4*)(WT + (size_t)(n0 + nn) * Kd + k0 + 8 * c) = o; }
    LDS_WAIT();
}

__device__ __forceinline__ void phase0(const Args& A, LAS unsigned char* lds, const int wv_) {
    const int tid = TIDX, lane = tid & 63, wave = __builtin_amdgcn_readfirstlane(tid >> 6);
    const int gw = blockIdx.x * 8 + wave, NGW = gridDim.x * 8;
    unsigned char* ws = A.ws;
    LAS float* scr = (LAS float*)(lds + wave * 8704);
    bf16_t* WinT = (bf16_t*)(ws + WS_WIN); bf16_t* WoutT = (bf16_t*)(ws + WS_WOUT); bf16_t* W1T = (bf16_t*)(ws + WS_W1T);
    constexpr int I_IN = 16 * 128, I_OUT = 16 * 32, I_W1 = 32 * 2;
    for (int it = gw; it < I_IN + I_OUT + 2 * I_W1; it += NGW) {
        int r = it;
        if (r < I_IN) { transpose_item<0>(A.in[2], NCOLS, A.in[1], WinT, DM, scr, r / 128, r % 128, lane); continue; } r -= I_IN;
        if (r < I_OUT) { transpose_item<1>(A.in[15], DM, nullptr, WoutT, DM, scr, r / 32, r % 32, lane); continue; } r -= I_OUT;
        if (r < I_W1) { transpose_item<1>(A.in[8], 64, nullptr, W1T, 2048, scr, r / 2, r % 2, lane); continue; } r -= I_W1;
        transpose_item<1>(A.in[12], 64, nullptr, W1T + 64 * 2048, 2048, scr, r / 2, r % 2, lane);
    }
    const float* x = A.in[0]; bf16_t* xb = (bf16_t*)(ws + WS_XB); float* rstd = (float*)(ws + WS_RSTD);
    {
        f32x4 va[2][4], vb[2][4];
        auto ldrows = [&](f32x4 (&v)[2][4], const int m0) __attribute__((always_inline)) {
#pragma unroll
            for (int u = 0; u < 2; ++u) { int m = m0 + u * NGW; m = m < NTOK ? m : NTOK - 1; const f32x4* xr = (const f32x4*)(x + (size_t)m * DM) + lane;
#pragma unroll
                for (int j = 0; j < 4; ++j) v[u][j] = xr[64 * j]; }
        };
        auto strows = [&](const f32x4 (&v)[2][4], const int m0) __attribute__((always_inline)) {
#pragma unroll
            for (int u = 0; u < 2; ++u) { const int m = m0 + u * NGW; float s = 0.f;
#pragma unroll
                for (int j = 0; j < 4; ++j) s += (v[u][j].x * v[u][j].x + v[u][j].y * v[u][j].y) + (v[u][j].z * v[u][j].z + v[u][j].w * v[u][j].w);
                s = wave_sum(s);
                if (m < NTOK) {
                    if (lane == 0) rstd[m] = 1.f / sqrtf(s * (1.f / DM) + EPSN);
                    unsigned long long* o8 = (unsigned long long*)(xb + (size_t)m * DM) + lane;
#pragma unroll
                    for (int j = 0; j < 4; ++j) o8[64 * j] = (unsigned long long)pk2(v[u][j].x, v[u][j].y) | ((unsigned long long)pk2(v[u][j].z, v[u][j].w) << 32); } }
        };
        int m0 = gw;
        if (m0 < NTOK) {
            ldrows(va, m0);
            for (;;) {
                ldrows(vb, m0 + 2 * NGW); strows(va, m0); m0 += 2 * NGW; if (m0 >= NTOK) break;
                ldrows(va, m0 + 2 * NGW); strows(vb, m0); m0 += 2 * NGW; if (m0 >= NTOK) break;
            }
        }
    }
    float* cbias = (float*)(ws + WS_CBIAS);
    for (int it = gw; it < 128; it += NGW) {
        const int kv = it >> 6, n = it & 63;
        const float* pos = A.in[kv ? 11 : 7]; const float* w1 = A.in[kv ? 12 : 8]; const float* b1 = A.in[kv ? 13 : 9];
        float s = 0.f;
        for (int k = lane; k < 2048; k += 64) s += pos[k] * w1[(size_t)k * 64 + n];
        s = wave_sum(s);
        if (lane == 0) cbias[it] = s + b1[n];
    }
    float2* rope = (float2*)(ws + WS_ROPE);
    for (int e = blockIdx.x * 512 + tid; e < SEQ * 8; e += gridDim.x * 512) {
        const int pos = e >> 3, i = e & 7;
        double rev = (double)pos * A.invf[i];
        rev -= floor(rev);
        const float rf = (float)rev;
        rope[e] = make_float2(__builtin_amdgcn_cosf(rf), __builtin_amdgcn_sinf(rf));
    }
    if (blockIdx.x == 0 && wave == 0) {
        const float gq = wave_max(fabsf(A.in[3][lane]));
        const float gc = wave_max(fabsf(A.in[4][lane])), gs = wave_max(fabsf(A.in[5][lane])), gwn = wave_max(fabsf(A.in[6][lane]));
        float* mb = (float*)(ws + WS_MB);
        if (lane == 0) { mb[0] = 8.f * gq * gc * 1.4426950408889634f * 1.02f; mb[1] = 8.f * gq * gs * 1.4426950408889634f * 1.02f; mb[2] = 8.f * gq * gwn * 1.4426950408889634f * 1.02f; }
    }
}

__device__ __forceinline__ void phase2_normrope(const Args& A, const int wv_, const int gw0, const int ngw) {
    const int tid = TIDX, lane = tid & 63;
    unsigned char* ws = A.ws;
    const bf16_t* __restrict__ P = (const bf16_t*)(ws + WS_P);
    bf16_t* __restrict__ ksn = (bf16_t*)(ws + WS_KSN); bf16_t* __restrict__ kwn = (bf16_t*)(ws + WS_KWN);
    const float2* __restrict__ rope = (const float2*)(ws + WS_ROPE);
    const int sub = lane & 7;
#pragma unroll 4
    for (int vb = gw0 * 8; vb < NTOK * 4; vb += ngw * 8) {
        const int v = vb + (lane >> 3);
        const int t = v >> 2, which = v & 3;
        int scol; const float* gain; bf16_t* dst;
        if (which < 2) { scol = C_KS + which * 64; gain = A.in[5]; dst = ksn + (size_t)t * 128 + which * 64; }
        else { scol = C_KW + (which - 2) * 64; gain = A.in[6]; dst = kwn + (size_t)t * 128 + (which - 2) * 64; }
        const u32x4 raw = *(const u32x4*)(P + (size_t)t * NCP + scol + sub * 8);
        float y[8];
        y[0] = bflo(raw.x); y[1] = bfhi(raw.x); y[2] = bflo(raw.y); y[3] = bfhi(raw.y); y[4] = bflo(raw.z); y[5] = bfhi(raw.z); y[6] = bflo(raw.w); y[7] = bfhi(raw.w);
        float ss = 0.f;
#pragma unroll
        for (int i = 0; i < 8; ++i) ss += y[i] * y[i];
        ss += __shfl_xor(ss, 1); ss += __shfl_xor(ss, 2); ss += __shfl_xor(ss, 4);
        const float r = 1.f / sqrtf(ss * (1.f / 64.f) + EPSN);
        const f32x4 g0 = *(const f32x4*)(gain + sub * 8), g1 = *(const f32x4*)(gain + sub * 8 + 4);
        y[0] *= r * g0.x; y[1] *= r * g0.y; y[2] *= r * g0.z; y[3] *= r * g0.w; y[4] *= r * g1.x; y[5] *= r * g1.y; y[6] *= r * g1.z; y[7] *= r * g1.w;
        const int pos = t & (SEQ - 1);
#pragma unroll
        for (int i = 0; i < 8; ++i) {
            const float oth = __shfl_xor(y[i], 1);
            const float2 cs = rope[pos * 8 + i];
            if (sub == 0) y[i] = y[i] * cs.x - oth * cs.y;
            else if (sub == 1) y[i] = y[i] * cs.x + oth * cs.y;
        }
        u32x4 o; o.x = pk2(y[0], y[1]); o.y = pk2(y[2], y[3]); o.z = pk2(y[4], y[5]); o.w = pk2(y[6], y[7]);
        *(u32x4*)(dst + sub * 8) = o;
    }
}

__device__ __forceinline__ void knorm_bg(const Args& A, const int wv_, const int bg, const int gw0, const int ngw) {
    const int tid = TIDX, lane = tid & 63;
    unsigned char* ws = A.ws;
    const bf16_t* __restrict__ P = (const bf16_t*)(ws + WS_P);
    bf16_t* __restrict__ ksn = (bf16_t*)(ws + WS_KSN); bf16_t* __restrict__ kwn = (bf16_t*)(ws + WS_KWN);
    const float2* __restrict__ rope = (const float2*)(ws + WS_ROPE);
    const int sub = lane & 7, b = bg >> 1, g = bg & 1;
#pragma unroll 4
    for (int ub = gw0 * 8; ub < SEQ * 2; ub += ngw * 8) {
        const int u = ub + (lane >> 3);
        const int t = b * SEQ + (u >> 1), win = u & 1;
        const int scol = (win ? C_KW : C_KS) + g * 64; const float* gain = A.in[win ? 6 : 5]; bf16_t* dst = (win ? kwn : ksn) + (size_t)t * 128 + g * 64;
        const u32x4 raw = *(const u32x4*)(P + (size_t)t * NCP + scol + sub * 8);
        float y[8];
        y[0] = bflo(raw.x); y[1] = bfhi(raw.x); y[2] = bflo(raw.y); y[3] = bfhi(raw.y); y[4] = bflo(raw.z); y[5] = bfhi(raw.z); y[6] = bflo(raw.w); y[7] = bfhi(raw.w);
        float ss = 0.f;
#pragma unroll
        for (int i = 0; i < 8; ++i) ss += y[i] * y[i];
        ss += __shfl_xor(ss, 1); ss += __shfl_xor(ss, 2); ss += __shfl_xor(ss, 4);
        const float r = 1.f / sqrtf(ss * (1.f / 64.f) + EPSN);
        const f32x4 g0 = *(const f32x4*)(gain + sub * 8), g1 = *(const f32x4*)(gain + sub * 8 + 4);
        y[0] *= r * g0.x; y[1] *= r * g0.y; y[2] *= r * g0.z; y[3] *= r * g0.w; y[4] *= r * g1.x; y[5] *= r * g1.y; y[6] *= r * g1.z; y[7] *= r * g1.w;
        const int pos = t & (SEQ - 1);
#pragma unroll
        for (int i = 0; i < 8; ++i) {
            const float oth = __shfl_xor(y[i], 1);
            const float2 cs = rope[pos * 8 + i];
            if (sub == 0) y[i] = y[i] * cs.x - oth * cs.y;
            else if (sub == 1) y[i] = y[i] * cs.x + oth * cs.y;
        }
        u32x4 o; o.x = pk2(y[0], y[1]); o.y = pk2(y[2], y[3]); o.z = pk2(y[4], y[5]); o.w = pk2(y[6], y[7]);
        *(u32x4*)(dst + sub * 8) = o;
    }
}
__device__ __forceinline__ void group_arrive(unsigned* ctr, const int wv_) {
    asm volatile("s_waitcnt vmcnt(0)" ::: "memory");
    __syncthreads();
    if (TIDX == 0) {
        __builtin_amdgcn_fence(__ATOMIC_RELEASE, "agent");
        asm volatile("s_waitcnt vmcnt(0)" ::: "memory");
        __hip_atomic_fetch_add(ctr, 1u, __ATOMIC_RELAXED, __HIP_MEMORY_SCOPE_AGENT);
    }
}
__device__ __forceinline__ void group_wait(unsigned* ctr, const unsigned n, const int wv_) {
    if (TIDX == 0) {
        unsigned sp = 0;
        while (__hip_atomic_load(ctr, __ATOMIC_RELAXED, __HIP_MEMORY_SCOPE_AGENT) < n) { __builtin_amdgcn_s_sleep(1); if (++sp > (1u << 22)) break; }
        __builtin_amdgcn_fence(__ATOMIC_ACQUIRE, "agent");
        asm volatile("s_waitcnt vmcnt(0)" ::: "memory");
    }
    __syncthreads();
}

__device__ __forceinline__ void compress_item(const Args& A, LAS unsigned char* lds, int item, const int wv_) {
    const int tid = TIDX, lane = tid & 63, r32 = lane & 31, hi = lane >> 5, wave = __builtin_amdgcn_readfirstlane(tid >> 6);
    unsigned char* ws = A.ws;
    const int kv = item >> 6, b = (item >> 4) & 3, g = (item >> 3) & 1, nt = item & 7, n0 = 32 * nt;
    const bf16_t* P = (const bf16_t*)(ws + WS_P);
    const bf16_t* W1T = (const bf16_t*)(ws + WS_W1T) + (size_t)kv * 64 * 2048;
    const int col = (kv ? C_VC : C_KC) + g * 64;
    const int n = n0 + r32; const bool nok = n <= 254;
    f32x16 acc0 = {}, acc1 = {};
#pragma unroll 8
    for (int ks = 0; ks < 16; ++ks) {
        const int kk = 256 * wave + 16 * ks + 8 * hi;
        const int tok = 16 * n + (kk >> 6), d = kk & 63;
        bf16x8 a = {};
        if (nok) a = *(const bf16x8*)(P + (size_t)(b * SEQ + tok) * NCP + col + d);
        const bf16x8 b0 = *(const bf16x8*)(W1T + (size_t)r32 * 2048 + kk);
        const bf16x8 b1 = *(const bf16x8*)(W1T + (size_t)(32 + r32) * 2048 + kk);
        acc0 = MFMA32(a, b0, acc0); acc1 = MFMA32(a, b1, acc1);
    }
    LAS float* red = (LAS float*)lds;
    LAS float* hid = (LAS float*)(lds + 65536);
#pragma unroll
    for (int i = 0; i < 16; ++i) { const int row = (i & 3) + 8 * (i >> 2) + 4 * hi; red[(wave * 32 + row) * 64 + r32] = acc0[i]; red[(wave * 32 + row) * 64 + 32 + r32] = acc1[i]; }
    __syncthreads();
    const float* cbias = (const float*)(ws + WS_CBIAS) + kv * 64;
#pragma unroll
    for (int j = 0; j < 4; ++j) { const int e = tid + 512 * j, c = e & 63; float s = cbias[c];
#pragma unroll
        for (int w = 0; w < 8; ++w) s += red[w * 2048 + e];
        hid[e] = s * sigmoidf_(s); }
    __syncthreads();
    const float* w2 = A.in[kv ? 14 : 10];
    const int row = tid >> 4, c4 = (tid & 15) * 4;
    f32x4 o = {0.f, 0.f, 0.f, 0.f};
    for (int j = 0; j < 64; ++j) { const float hv = hid[row * 64 + j]; const f32x4 wv = *(const f32x4*)(w2 + j * 64 + c4); o += wv * hv; }
    const int nn = n0 + row;
    bf16_t* dst = (bf16_t*)(ws + (kv ? WS_VCMP : WS_KCMP)) + ((size_t)((b * 2 + g) * 256 + nn)) * 64 + c4;
    if (kv == 0) {
        float ss = o.x * o.x + o.y * o.y + o.z * o.z + o.w * o.w;
        ss += __shfl_xor(ss, 1); ss += __shfl_xor(ss, 2); ss += __shfl_xor(ss, 4); ss += __shfl_xor(ss, 8);
        const float r = 1.f / sqrtf(ss * (1.f / 64.f) + EPSN);
        const f32x4 gn = *(const f32x4*)(A.in[4] + c4);
        o = o * r * gn;
        const int pos = 16 * nn + 31;
        const f32x4 oth = {__shfl_xor(o.x, 2), __shfl_xor(o.y, 2), __shfl_xor(o.z, 2), __shfl_xor(o.w, 2)};
        const int cc = tid & 15;
        if (cc < 4 && nn <= 254) {
            const float2* rope = (const float2*)(ws + WS_ROPE) + pos * 8 + (cc & 1) * 4;
            const float2 c0 = rope[0], c1 = rope[1], c2_ = rope[2], c3 = rope[3];
            if (cc < 2) { o.x = o.x * c0.x - oth.x * c0.y; o.y = o.y * c1.x - oth.y * c1.y; o.z = o.z * c2_.x - oth.z * c2_.y; o.w = o.w * c3.x - oth.w * c3.y; }
            else        { o.x = o.x * c0.x + oth.x * c0.y; o.y = o.y * c1.x + oth.y * c1.y; o.z = o.z * c2_.x + oth.z * c2_.y; o.w = o.w * c3.x + oth.w * c3.y; }
        }
    }
    if (nn > 254) o = (f32x4){0.f, 0.f, 0.f, 0.f};
    u32x2 pk; pk.x = pk2(o.x, o.y); pk.y = pk2(o.z, o.w);
    *(u32x2*)dst = pk;
    __syncthreads();
}

constexpr int KV_BUF = 17664, KV_VOFF = 9216, V_HALF = 4224;
constexpr int ATT_FLAGS = 35328, ATT_LINV = 35392, ATT_PW = 36416;

struct KVStage { u32x4 k, v; };
__device__ __forceinline__ void kv_load(KVStage& st, const bf16_t* Kb, int kpitch, const bf16_t* Vb, int vpitch, int key0, int tid) {
    const int key = tid >> 3, c = tid & 7;
    st.k = *(const u32x4*)(Kb + (size_t)(key0 + key) * kpitch + c * 8);
    st.v = *(const u32x4*)(Vb + (size_t)(key0 + key) * vpitch + c * 8);
}
__device__ __forceinline__ void kv_store(const KVStage& st, LAS unsigned char* buf, int tid) {
    const int key = tid >> 3, c = tid & 7;
    *(LAS u32x4*)(buf + key * 144 + c * 16) = st.k;
    *(LAS u32x4*)(buf + KV_VOFF + (c >> 2) * V_HALF + key * 64 + (c & 3) * 16) = st.v;
}
__device__ __forceinline__ void qk_tile(f32x16& p0, f32x16& p1, const f32x16& cinit, const LAS unsigned char* kb, const bf16x8* qr, int r32, int hi) {
    const LAS unsigned char* base = kb + r32 * 144 + hi * 16;
    { const bf16x8 a0 = *(const LAS bf16x8*)(base), a1 = *(const LAS bf16x8*)(base + 32 * 144);
      p0 = MFMA32(a0, qr[0], cinit); p1 = MFMA32(a1, qr[0], cinit); }
#pragma unroll
    for (int d0 = 1; d0 < 4; ++d0) { const bf16x8 a0 = *(const LAS bf16x8*)(base + d0 * 32), a1 = *(const LAS bf16x8*)(base + 32 * 144 + d0 * 32);
        p0 = MFMA32(a0, qr[d0], p0); p1 = MFMA32(a1, qr[d0], p1); }
}
typedef short v4i16_t __attribute__((ext_vector_type(4)));
__device__ __forceinline__ s16x4 vtr(const LAS unsigned char* p) { return __builtin_bit_cast(s16x4, __builtin_amdgcn_ds_read_tr16_b64_v4i16((LAS v4i16_t*)p)); }
__device__ __forceinline__ void pv_packed(f32x16* o, const LAS unsigned char* vb, const bf16x8* pa, int lane) {
    const int hi = lane >> 5;
    const LAS unsigned char* base = vb + ((lane >> 4) & 1) * 32 + (lane & 3) * 8 + (4 * hi + ((lane & 15) >> 2)) * 64;
#pragma unroll
    for (int d0 = 0; d0 < 2; ++d0)
#pragma unroll
        for (int s = 0; s < 4; ++s) {
            const s16x4 lo = vtr(base + d0 * V_HALF + s * 1024);
            const s16x4 hh = vtr(base + d0 * V_HALF + s * 1024 + 512);
            const bf16x8 vf = __builtin_shufflevector(lo, hh, 0, 1, 2, 3, 4, 5, 6, 7);
            o[d0] = MFMA32(vf, pa[s], o[d0]);
        }
}
__device__ __forceinline__ void pack_half(bf16x8* pa2, const f32x16& p) {
    u32x4 w0 = {pk2(p[0], p[1]), pk2(p[2], p[3]), pk2(p[4], p[5]), pk2(p[6], p[7])};
    u32x4 w1 = {pk2(p[8], p[9]), pk2(p[10], p[11]), pk2(p[12], p[13]), pk2(p[14], p[15])};
    pa2[0] = __builtin_bit_cast(bf16x8, w0); pa2[1] = __builtin_bit_cast(bf16x8, w1);
}
__device__ __forceinline__ void pv_tile(f32x16* o, const LAS unsigned char* vb, const f32x16& p0, const f32x16& p1, int lane) {
    bf16x8 pa[4]; pack_half(pa, p0); pack_half(pa + 2, p1);
    pv_packed(o, vb, pa, lane);
}
__device__ __forceinline__ f32x16 splat16(float v) { f32x16 r;
#pragma unroll
    for (int i = 0; i < 16; ++i) r[i] = v;
    return r; }
__device__ __forceinline__ int crow(int i, int hi) { return (i & 3) + 8 * (i >> 2) + 4 * hi; }

enum { M_WIN = 0, M_SLC = 1, M_SB = 2, M_CMP = 3 };

template <int MODE>
__device__ __forceinline__ void attn_item(const Args& A, LAS unsigned char* lds, int item, const int wv_) {
    int tid_l = TIDX; asm volatile("" : "+v"(tid_l));
    const int tid = tid_l, lane = tid & 63, r32 = lane & 31, hi = lane >> 5, w = __builtin_amdgcn_readfirstlane(tid >> 6);
    unsigned char* ws = A.ws;
    const bf16_t* P = (const bf16_t*)(ws + WS_P);
    int b, g = 0, hd, m, T0, trel;
    const bf16_t *Qrow, *Kb, *Vb; int kpitch, vpitch, kt_first, nt, kt_step = 1;
    if (MODE == M_SB) {
        b = item >> 7; hd = (item >> 4) & 7; m = item & 15; T0 = 256 * m; trel = 32 * w + r32;
        Qrow = P + (size_t)(b * SEQ + T0 + trel) * NCP + C_QSB + hd * 64;
        Kb = P + (size_t)(b * SEQ) * NCP + C_KSB + hd * 64; Vb = P + (size_t)(b * SEQ) * NCP + C_VSB + hd * 64; kpitch = NCP; vpitch = NCP;
        kt_first = 4 * m + 3; nt = 4 * m + 4; kt_step = -1;
    } else {
        if (MODE == M_SLC) { int bg; if (item < 256) { bg = item >> 5; m = 32 + (item & 31); } else { const int i2 = item - 256; bg = i2 >> 5; m = 31 - (i2 & 31); } b = bg >> 1; g = bg & 1; }
        else { b = item >> 7; g = (item >> 6) & 1; m = item & 63; }
        T0 = 64 * m; hd = 4 * g + (w & 3); trel = 32 * (w >> 2) + r32;
        Qrow = (const bf16_t*)(ws + WS_QN) + (size_t)(b * SEQ + T0 + trel) * 512 + hd * 64;
        if (MODE == M_WIN) { Kb = (const bf16_t*)(ws + WS_KWN) + (size_t)(b * SEQ) * 128 + g * 64; kpitch = 128; Vb = P + (size_t)(b * SEQ) * NCP + C_VW + g * 64; vpitch = NCP; kt_first = m >= 8 ? m - 8 : 0; nt = m - kt_first + 1; }
        else if (MODE == M_SLC) { Kb = (const bf16_t*)(ws + WS_KSN) + (size_t)(b * SEQ) * 128 + g * 64; kpitch = 128; Vb = P + (size_t)(b * SEQ) * NCP + C_VS + g * 64; vpitch = NCP; kt_first = 0; nt = m + 1; }
        else { Kb = (const bf16_t*)(ws + WS_KCMP) + (size_t)((b * 2 + g) * 256) * 64; kpitch = 64; Vb = (const bf16_t*)(ws + WS_VCMP) + (size_t)((b * 2 + g) * 256) * 64; vpitch = 64; kt_first = 0; nt = ((4 * m + 2) >> 6) + 1; }
    }
    const int t = T0 + trel;
    bf16x8 qr[4];
#pragma unroll
    for (int d0 = 0; d0 < 4; ++d0) qr[d0] = *(const bf16x8*)(Qrow + 16 * d0 + 8 * hi);
    if (MODE == M_SB) {
#pragma unroll
        for (int d0 = 0; d0 < 4; ++d0) { u32x4 u = __builtin_bit_cast(u32x4, qr[d0]);
            u.x = pk2(bflo(u.x) * C2, bfhi(u.x) * C2); u.y = pk2(bflo(u.y) * C2, bfhi(u.y) * C2); u.z = pk2(bflo(u.z) * C2, bfhi(u.z) * C2); u.w = pk2(bflo(u.w) * C2, bfhi(u.w) * C2);
            qr[d0] = __builtin_bit_cast(bf16x8, u); }
    }
    float negmb = 0.f;
    if (MODE != M_SB) negmb = -((const float*)(ws + WS_MB))[MODE == M_CMP ? 0 : (MODE == M_SLC ? 1 : 2)];
    unsigned sel_lo = 0, sel_hi = 0;
    if (MODE == M_SLC) { const u32x2 sm = *(const u32x2*)((const unsigned long long*)(ws + WS_SEL) + (size_t)(b * 2 + g) * SEQ + t); sel_lo = sm.x; sel_hi = sm.y; }
    const int nmax = (t - 31) >> 4;
    f32x16 o[2]; o[0] = splat16(0.f); o[1] = splat16(0.f);
    float lsum = 0.f, carry = (MODE == M_SB) ? 1.f : 0.f  ;
    bool done = false;
    LAS unsigned* flags = (LAS unsigned*)(lds + ATT_FLAGS);
    LAS float* pw = (LAS float*)(lds + ATT_PW) + (w * 32 + r32) * 65;
    if (MODE == M_CMP) {
#pragma unroll
        for (int j = 0; j < 32; ++j) pw[hi * 32 + j] = 0.f;
        if (hi) pw[64] = 0.f;
    }
    f32x16 cneg = splat16(negmb);
    if (MODE != M_SB) asm volatile("" : "+v"(cneg));
    KVStage sA, sB;
    kv_load(sA, Kb, kpitch, Vb, vpitch, kt_first * 64, tid);
    kv_store(sA, lds, tid);
    kv_load(sA, Kb, kpitch, Vb, vpitch, (kt_first + (nt > 1 ? kt_step : 0)) * 64, tid);
    __syncthreads();
    auto step = [&](const int it, KVStage& have, KVStage& recv) __attribute__((always_inline)) -> bool {
        const int kt = kt_first + it * kt_step;
        const LAS unsigned char* cur = lds + (it & 1) * KV_BUF;
        LAS unsigned char* nxt = lds + ((it & 1) ^ 1) * KV_BUF;
        const bool more = it + 1 < nt;
        { const int itn = it + 2 < nt ? it + 2 : nt - 1; kv_load(recv, Kb, kpitch, Vb, vpitch, (kt_first + itn * kt_step) * 64, tid); }
        if (MODE == M_WIN) {
            f32x16 p0, p1;
            qk_tile(p0, p1, cneg, cur, qr, r32, hi);
#pragma unroll
            for (int i = 0; i < 16; ++i) { p0[i] = ex2(p0[i]); p1[i] = ex2(p1[i]); }
            if (kt == m) {
#pragma unroll
                for (int i = 0; i < 16; ++i) { const int rel = crow(i, hi); if (rel > trel) p0[i] = 0.f; if (rel + 32 > trel) p1[i] = 0.f; }
            }
            if (kt == m - 8) {
#pragma unroll
                for (int i = 0; i < 16; ++i) { const int rel = crow(i, hi); if (rel <= trel) p0[i] = 0.f; if (rel + 32 <= trel) p1[i] = 0.f; }
            }
            float s = 0.f;
#pragma unroll
            for (int i = 0; i < 16; ++i) s += p0[i] + p1[i];
            lsum += s;
            pv_tile(o, cur + KV_VOFF, p0, p1, lane);
        } else if (MODE == M_SLC) {
            const unsigned bit = ((kt < 32 ? sel_lo : sel_hi) >> (kt & 31)) & 1u;
            if (__any((int)bit)) {
                f32x16 p0, p1;
                qk_tile(p0, p1, cneg, cur, qr, r32, hi);
                const float bf = bit ? 1.f : 0.f;
#pragma unroll
                for (int i = 0; i < 16; ++i) { p0[i] = ex2(p0[i]) * bf; p1[i] = ex2(p1[i]) * bf; }
                if (kt == m) {
#pragma unroll
                    for (int i = 0; i < 16; ++i) { const int rel = crow(i, hi); if (rel > trel) p0[i] = 0.f; if (rel + 32 > trel) p1[i] = 0.f; }
                }
                float s = 0.f;
#pragma unroll
                for (int i = 0; i < 16; ++i) s += p0[i] + p1[i];
                lsum += s;
                pv_tile(o, cur + KV_VOFF, p0, p1, lane);
            }
        } else if (MODE == M_CMP) {
            f32x16 p0, p1;
            qk_tile(p0, p1, cneg, cur, qr, r32, hi);
            const int lim = nmax - kt * 64;
#pragma unroll
            for (int i = 0; i < 16; ++i) { const int rel = crow(i, hi); p0[i] = rel <= lim ? ex2(p0[i]) : 0.f; p1[i] = rel + 32 <= lim ? ex2(p1[i]) : 0.f; }
            float s = 0.f;
#pragma unroll
            for (int i = 0; i < 16; ++i) s += p0[i] + p1[i];
            lsum += s;
#pragma unroll
            for (int q = 0; q < 8; ++q) {
                const f32x16& pq = q < 4 ? p0 : p1; const int qb = 4 * (q & 3); const float e0 = pq[qb], e1 = pq[qb + 1], e2 = pq[qb + 2], e3 = pq[qb + 3];
                float a = e0 + e1 + e2 + 0.5f * e3; const float bq = 0.5f * e3;
                const float pb = __shfl_xor(bq, 32);
                a += hi ? pb : carry;
                carry = pb;
                pw[kt * 16 + 2 * q + hi] = a;
            }
            pv_tile(o, cur + KV_VOFF, p0, p1, lane);
        } else {
            const int kbase = kt * 64 - T0;
            const bool skip = done || (kbase >= 32 * w + 31);
            if (!skip) {
                f32x16 pz[2];
                qk_tile(pz[0], pz[1], splat16(0.f), cur, qr, r32, hi);
                const bool partial = kbase + 63 >= 32 * w;
                const int lim = trel - kbase;
                bf16x8 pa[4];
                float run = carry;
#pragma unroll
                for (int h2 = 1; h2 >= 0; --h2) {
                    f32x16 om, be;
#pragma unroll
                    for (int i = 0; i < 16; ++i) { const float z = __builtin_amdgcn_fmed3f(pz[h2][i], -60.f, 60.f); const float e = ex2(-z); const float bb = __builtin_amdgcn_rcpf(1.f + e); be[i] = bb; om[i] = e * bb; }
                    if (partial) {
#pragma unroll
                        for (int i = 0; i < 16; ++i) { const int rel = crow(i, hi) + 32 * h2; if (rel >= lim) { om[i] = 1.f; be[i] = 0.f; } }
                    }
                    float gs[4], po[4];
#pragma unroll
                    for (int q = 0; q < 4; ++q) { gs[q] = (om[4 * q] * om[4 * q + 1]) * (om[4 * q + 2] * om[4 * q + 3]); po[q] = __shfl_xor(gs[q], 32); }
#pragma unroll
                    for (int q = 3; q >= 0; --q) {
                        const float ghi = hi ? gs[q] : po[q], glo = hi ? po[q] : gs[q];
                        const float t1 = run; run *= ghi; const float t0 = run; run *= glo;
                        float af = hi ? t1 : t0;
                        be[4 * q + 3] *= af; af *= om[4 * q + 3];
                        be[4 * q + 2] *= af; af *= om[4 * q + 2];
                        be[4 * q + 1] *= af; af *= om[4 * q + 1];
                        be[4 * q] *= af;
                    }
                    pack_half(pa + 2 * h2, be);
                }
                carry = run;
                pv_packed(o, cur + KV_VOFF, pa, lane);
                done = __all(carry < 3.5527e-15f);
            }
        }
        if (more) kv_store(have, nxt, tid);
        if (MODE == M_SB) { if (lane == 0) flags[(it & 1) * 8 + w] = done ? 1u : 0u; }
        __syncthreads();
        if (MODE == M_SB) {
            const u32x4 f0 = *(const LAS u32x4*)(flags + (it & 1) * 8), f1 = *(const LAS u32x4*)(flags + (it & 1) * 8 + 4);
            if ((f0.x & f0.y & f0.z & f0.w & f1.x & f1.y & f1.z & f1.w) != 0u) return true;
        }
        return false;
    };
    for (int it = 0; it < nt; it += 2) {
        if (step(it, sA, sB)) break;
        if (it + 1 >= nt) break;
        if (step(it + 1, sB, sA)) break;
    }
    if (MODE == M_SB) {
        const bf16_t* gp = P + (size_t)(b * SEQ + t) * NCP + C_GSB + hd * 64;
        bf16_t* dst = (bf16_t*)(ws + WS_XB) + (size_t)(b * SEQ + t) * DM + 512 + hd * 64;
        u32x2 gvv[8];
#pragma unroll
        for (int e = 0; e < 8; ++e) gvv[e] = *(const u32x2*)(gp + (e >> 2) * 32 + 8 * (e & 3) + 4 * hi);
#pragma unroll
        for (int d0 = 0; d0 < 2; ++d0)
#pragma unroll
            for (int q = 0; q < 4; ++q) { const int d = d0 * 32 + 8 * q + 4 * hi;
                const u32x2 gv = gvv[d0 * 4 + q];
                const float g0 = bflo(gv.x), g1 = bfhi(gv.x), g2 = bflo(gv.y), g3 = bfhi(gv.y);
                u32x2 pk; pk.x = pk2(o[d0][4 * q] * g0 * sigmoidf_(g0), o[d0][4 * q + 1] * g1 * sigmoidf_(g1)); pk.y = pk2(o[d0][4 * q + 2] * g2 * sigmoidf_(g2), o[d0][4 * q + 3] * g3 * sigmoidf_(g3));
                *(u32x2*)(dst + d) = pk; }
    } else {
        lsum += __shfl_xor(lsum, 32);
        const float inv = lsum > 0.f ? 1.f / lsum : 0.f;
        const int br = MODE == M_CMP ? 0 : (MODE == M_SLC ? 1 : 2);
        const float gate = sigmoidf_(bf1(P[(size_t)(b * SEQ + t) * NCP + C_GL + hd * 3 + br]));
        const float sc = inv * gate;
        const size_t orow = (size_t)(b * SEQ + t) * 512 + hd * 64;
        if (MODE == M_SLC) {
            const bf16_t* oc = (const bf16_t*)(ws + WS_OC) + orow; const bf16_t* ow = (const bf16_t*)(ws + WS_OW) + orow;
            const bf16_t* gp = P + (size_t)(b * SEQ + t) * NCP + C_GN + hd * 64;
            bf16_t* dst = (bf16_t*)(ws + WS_XB) + (size_t)(b * SEQ + t) * DM + hd * 64;
#pragma unroll
            for (int d0 = 0; d0 < 2; ++d0)
#pragma unroll
                for (int q = 0; q < 4; ++q) { const int d = d0 * 32 + 8 * q + 4 * hi;
                    const u32x2 gv = *(const u32x2*)(gp + d), cv = *(const u32x2*)(oc + d), wv = *(const u32x2*)(ow + d);
                    const float g0 = bflo(gv.x), g1 = bfhi(gv.x), g2 = bflo(gv.y), g3 = bfhi(gv.y);
                    const float v0 = o[d0][4 * q] * sc + bflo(cv.x) + bflo(wv.x), v1 = o[d0][4 * q + 1] * sc + bfhi(cv.x) + bfhi(wv.x);
                    const float v2 = o[d0][4 * q + 2] * sc + bflo(cv.y) + bflo(wv.y), v3 = o[d0][4 * q + 3] * sc + bfhi(cv.y) + bfhi(wv.y);
                    u32x2 pk; pk.x = pk2(v0 * g0 * sigmoidf_(g0), v1 * g1 * sigmoidf_(g1)); pk.y = pk2(v2 * g2 * sigmoidf_(g2), v3 * g3 * sigmoidf_(g3));
                    *(u32x2*)(dst + d) = pk; }
        } else {
            bf16_t* dst = (bf16_t*)(ws + (MODE == M_CMP ? WS_OC : WS_OW)) + orow;
#pragma unroll
            for (int d0 = 0; d0 < 2; ++d0)
#pragma unroll
                for (int q = 0; q < 4; ++q) { const int d = d0 * 32 + 8 * q + 4 * hi;
                    u32x2 pk; pk.x = pk2(o[d0][4 * q] * sc, o[d0][4 * q + 1] * sc); pk.y = pk2(o[d0][4 * q + 2] * sc, o[d0][4 * q + 3] * sc);
                    *(u32x2*)(dst + d) = pk; }
        }
        if (MODE == M_CMP) {
            LAS float* linv = (LAS float*)(lds + ATT_LINV);
            if (hi == 0) linv[w * 32 + r32] = inv;
            __syncthreads();
            const LAS float* pwb = (const LAS float*)(lds + ATT_PW);
            unsigned long long* sel = (unsigned long long*)(ws + WS_SEL) + (size_t)(b * 2 + g) * SEQ + T0;
            const int j = lane, blk = m;
            const bool valid = j <= blk, forced = (j == 0) || (j == blk) || (j == blk - 1);
            for (int i = 0; i < 8; ++i) {
                const int tok = w * 8 + i, half = tok >> 5, r = tok & 31;
                float sc2 = 0.f;
#pragma unroll
                for (int hh = 0; hh < 4; ++hh) sc2 += pwb[((half * 4 + hh) * 32 + r) * 65 + j] * linv[(half * 4 + hh) * 32 + r];
                const float s = valid ? (forced ? sc2 + 1.0e4f : sc2) : -INFINITY;
                int cnt = 0;
#pragma unroll
                for (int l2 = 0; l2 < 64; ++l2) { const float sl = __uint_as_float(__builtin_amdgcn_readlane(__float_as_uint(s), l2)); cnt += ((sl > s) || (sl == s && l2 < lane)) ? 1 : 0; }
                const unsigned long long mk = __ballot(valid && cnt < 16);
                if (lane == 0) sel[tok] = mk;
            }
        }
    }
    __syncthreads();
}


__device__ __forceinline__ void k_reads(bf16x8* kf, const LAS unsigned char* kb, int r32, int hi) {
    const LAS unsigned char* base = kb + r32 * 144 + hi * 16;
#pragma unroll
    for (int d0 = 0; d0 < 4; ++d0) { kf[2 * d0] = *(const LAS bf16x8*)(base + d0 * 32); kf[2 * d0 + 1] = *(const LAS bf16x8*)(base + 32 * 144 + d0 * 32); }
}
__device__ __forceinline__ void qk_mfma(f32x16& p0, f32x16& p1, const f32x16& cinit, const bf16x8* kf, const bf16x8* qr) {
    p0 = MFMA32(kf[0], qr[0], cinit); p1 = MFMA32(kf[1], qr[0], cinit);
#pragma unroll
    for (int d0 = 1; d0 < 4; ++d0) { p0 = MFMA32(kf[2 * d0], qr[d0], p0); p1 = MFMA32(kf[2 * d0 + 1], qr[d0], p1); }
}
__device__ __forceinline__ void v_reads(s16x4* vlo, s16x4* vhi, const LAS unsigned char* vb, int lane) {
    const int hi = lane >> 5;
    const LAS unsigned char* base = vb + ((lane >> 4) & 1) * 32 + (lane & 3) * 8 + (4 * hi + ((lane & 15) >> 2)) * 64;
#pragma unroll
    for (int d0 = 0; d0 < 2; ++d0)
#pragma unroll
        for (int s = 0; s < 4; ++s) { vlo[d0 * 4 + s] = vtr(base + d0 * V_HALF + s * 1024); vhi[d0 * 4 + s] = vtr(base + d0 * V_HALF + s * 1024 + 512); }
}
__device__ __forceinline__ void pv_mfma(f32x16* o, const s16x4* vlo, const s16x4* vhi, const bf16x8* pa) {
#pragma unroll
    for (int s = 0; s < 4; ++s)
#pragma unroll
        for (int d0 = 0; d0 < 2; ++d0) {
            const bf16x8 vf = __builtin_shufflevector(vlo[d0 * 4 + s], vhi[d0 * 4 + s], 0, 1, 2, 3, 4, 5, 6, 7);
            o[d0] = MFMA32(vf, pa[s], o[d0]);
        }
}
__device__ __forceinline__ float fadd_s(float a, float b) { float r; asm("v_add_f32_e32 %0, %1, %2" : "=v"(r) : "v"(a), "v"(b)); return r; }
typedef float f32x2v __attribute__((ext_vector_type(2)));
template <int MODE>
__device__ __forceinline__ void softmax_stage(f32x16& p0, f32x16& p1, bf16x8* pa, float& lsum, int kt, int m, int trel, int hi, unsigned bit) {
#pragma unroll
    for (int i = 0; i < 16; ++i) { p0[i] = ex2(p0[i]); p1[i] = ex2(p1[i]); }
    if (kt == m) {
#pragma unroll
        for (int i = 0; i < 16; ++i) { const int rel = crow(i, hi); if (rel > trel) p0[i] = 0.f; if (rel + 32 > trel) p1[i] = 0.f; }
    }
    if (MODE == M_WIN && kt == m - 8) {
#pragma unroll
        for (int i = 0; i < 16; ++i) { const int rel = crow(i, hi); if (rel <= trel) p0[i] = 0.f; if (rel + 32 <= trel) p1[i] = 0.f; }
    }
    f32x2v acc = {0.f, 0.f};
#pragma unroll
    for (int i = 0; i < 8; ++i) { acc += (f32x2v){p0[2 * i], p0[2 * i + 1]}; acc += (f32x2v){p1[2 * i], p1[2 * i + 1]}; }
    float sum = acc.x + acc.y;
    const unsigned mk = (MODE == M_SLC) ? (bit ? 0xffffffffu : 0u) : 0xffffffffu;
#pragma unroll
    for (int k = 0; k < 4; ++k) { const f32x16& p = k < 2 ? p0 : p1; const int bs = 8 * (k & 1);
        u32x4 wv = {pk2(p[bs], p[bs + 1]), pk2(p[bs + 2], p[bs + 3]), pk2(p[bs + 4], p[bs + 5]), pk2(p[bs + 6], p[bs + 7])};
        if (MODE == M_SLC) { wv.x &= mk; wv.y &= mk; wv.z &= mk; wv.w &= mk; }
        pa[k] = __builtin_bit_cast(bf16x8, wv); }
    if (MODE == M_SLC) sum = bit ? sum : 0.f;
    lsum += sum;
}

template <int MODE>
__device__ __forceinline__ void attn_item2(const Args& A, LAS unsigned char* lds, int item, const int wv_) {
    int tid_l = TIDX; asm volatile("" : "+v"(tid_l));
    const int tid = tid_l, lane = tid & 63, r32 = lane & 31, hi = lane >> 5, w = __builtin_amdgcn_readfirstlane(tid >> 6);
    unsigned char* ws = A.ws;
    const bf16_t* P = (const bf16_t*)(ws + WS_P);
    int b, g, m;
    if (MODE == M_SLC) { int bg; if (item < 256) { bg = item >> 5; m = 32 + (item & 31); } else { const int i2 = item - 256; bg = i2 >> 5; m = 31 - (i2 & 31); } b = bg >> 1; g = bg & 1; }
    else { b = item >> 7; g = (item >> 6) & 1; m = item & 63; }
    const int T0 = 64 * m, hd = 4 * g + (w & 3), trel = 32 * (w >> 2) + r32, t = T0 + trel;
    const bf16_t* Qrow = (const bf16_t*)(ws + WS_QN) + (size_t)(b * SEQ + t) * 512 + hd * 64;
    const bf16_t* Kb = (const bf16_t*)(ws + (MODE == M_WIN ? WS_KWN : WS_KSN)) + (size_t)(b * SEQ) * 128 + g * 64;
    const bf16_t* Vb = P + (size_t)(b * SEQ) * NCP + (MODE == M_WIN ? C_VW : C_VS) + g * 64;
    const int kpitch = 128, vpitch = NCP;
    const int kt_first = (MODE == M_WIN && m >= 8) ? m - 8 : 0, nt = m - kt_first + 1;
    bf16x8 qr[4];
#pragma unroll
    for (int d0 = 0; d0 < 4; ++d0) qr[d0] = *(const bf16x8*)(Qrow + 16 * d0 + 8 * hi);
    const float negmb = -((const float*)(ws + WS_MB))[MODE == M_SLC ? 1 : 2];
    unsigned sel_lo = 0xffffffffu, sel_hi = 0xffffffffu;
    if (MODE == M_SLC) { const u32x2 sm = *(const u32x2*)((const unsigned long long*)(ws + WS_SEL) + (size_t)(b * 2 + g) * SEQ + t); sel_lo = sm.x; sel_hi = sm.y; }
    f32x16 o[2]; o[0] = splat16(0.f); o[1] = splat16(0.f);
    float lsum = 0.f;
    f32x16 cneg = splat16(negmb);
    asm volatile("" : "+v"(cneg));
    const bool grpA = (w < 4);
    KVStage sA, sB;
#define TILE_CL(i) ((kt_first + ((i) < nt ? (i) : nt - 1)) * 64)
    kv_load(sA, Kb, kpitch, Vb, vpitch, TILE_CL(0), tid);
    kv_load(sB, Kb, kpitch, Vb, vpitch, TILE_CL(1), tid);
    kv_store(sA, lds, tid);
    kv_store(sB, lds + KV_BUF, tid);
    kv_load(sA, Kb, kpitch, Vb, vpitch, TILE_CL(2), tid);
    __syncthreads();
    f32x16 SA0, SA1, SB0, SB1;
    qk_tile(SA0, SA1, cneg, lds, qr, r32, hi);
    int s0 = 0, s1 = KV_BUF, s2 = 2 * KV_BUF;
    auto step = [&](const int it, KVStage& have, KVStage& recv, f32x16& c0, f32x16& c1, f32x16& n0, f32x16& n1) __attribute__((always_inline)) {
        const int kt = kt_first + it;
        kv_load(recv, Kb, kpitch, Vb, vpitch, TILE_CL(it + 3), tid);
        const unsigned bit = ((kt < 32 ? sel_lo : sel_hi) >> (kt & 31)) & 1u;
        bf16x8 pa[4];
        bf16x8 kf[8]; s16x4 vlo[8], vhi[8];
        if (grpA) {
            k_reads(kf, lds + s1, r32, hi);
            __builtin_amdgcn_sched_barrier(0);
            __builtin_amdgcn_s_setprio(1); qk_mfma(n0, n1, cneg, kf, qr); __builtin_amdgcn_s_setprio(0);
            v_reads(vlo, vhi, lds + s0 + KV_VOFF, lane);
            __builtin_amdgcn_sched_barrier(0);
            softmax_stage<MODE>(c0, c1, pa, lsum, kt, m, trel, hi, bit);
            __builtin_amdgcn_sched_barrier(0);
            __builtin_amdgcn_s_setprio(1); pv_mfma(o, vlo, vhi, pa); __builtin_amdgcn_s_setprio(0);
        } else {
            v_reads(vlo, vhi, lds + s0 + KV_VOFF, lane);
            __builtin_amdgcn_sched_barrier(0);
            softmax_stage<MODE>(c0, c1, pa, lsum, kt, m, trel, hi, bit);
            k_reads(kf, lds + s1, r32, hi);
            __builtin_amdgcn_sched_barrier(0);
            __builtin_amdgcn_s_setprio(1); pv_mfma(o, vlo, vhi, pa);
            __builtin_amdgcn_sched_barrier(0);
            qk_mfma(n0, n1, cneg, kf, qr); __builtin_amdgcn_s_setprio(0);
        }
        kv_store(have, lds + s2, tid);
        __syncthreads();
        const int tmp = s0; s0 = s1; s1 = s2; s2 = tmp;
    };
    for (int it = 0; it < nt; it += 2) {
        step(it, sA, sB, SA0, SA1, SB0, SB1);
        if (it + 1 >= nt) break;
        step(it + 1, sB, sA, SB0, SB1, SA0, SA1);
    }
#undef TILE_CL
    lsum += __shfl_xor(lsum, 32);
    const float inv = lsum > 0.f ? 1.f / lsum : 0.f;
    const int br = MODE == M_SLC ? 1 : 2;
    const float gate = sigmoidf_(bf1(P[(size_t)(b * SEQ + t) * NCP + C_GL + hd * 3 + br]));
    const float sc = inv * gate;
    const size_t orow = (size_t)(b * SEQ + t) * 512 + hd * 64;
    if (MODE == M_SLC) {
        const bf16_t* oc = (const bf16_t*)(ws + WS_OC) + orow; const bf16_t* ow = (const bf16_t*)(ws + WS_OW) + orow;
        const bf16_t* gp = P + (size_t)(b * SEQ + t) * NCP + C_GN + hd * 64;
        bf16_t* dst = (bf16_t*)(ws + WS_XB) + (size_t)(b * SEQ + t) * DM + hd * 64;
#pragma unroll
        for (int d0 = 0; d0 < 2; ++d0)
#pragma unroll
            for (int q = 0; q < 4; ++q) { const int d = d0 * 32 + 8 * q + 4 * hi;
                const u32x2 gv = *(const u32x2*)(gp + d), cv = *(const u32x2*)(oc + d), wv = *(const u32x2*)(ow + d);
                const float g0 = bflo(gv.x), g1 = bfhi(gv.x), g2 = bflo(gv.y), g3 = bfhi(gv.y);
                const float v0 = o[d0][4 * q] * sc + bflo(cv.x) + bflo(wv.x), v1 = o[d0][4 * q + 1] * sc + bfhi(cv.x) + bfhi(wv.x);
                const float v2 = o[d0][4 * q + 2] * sc + bflo(cv.y) + bflo(wv.y), v3 = o[d0][4 * q + 3] * sc + bfhi(cv.y) + bfhi(wv.y);
                u32x2 pk; pk.x = pk2(v0 * g0 * sigmoidf_(g0), v1 * g1 * sigmoidf_(g1)); pk.y = pk2(v2 * g2 * sigmoidf_(g2), v3 * g3 * sigmoidf_(g3));
                *(u32x2*)(dst + d) = pk; }
    } else {
        bf16_t* dst = (bf16_t*)(ws + WS_OW) + orow;
#pragma unroll
        for (int d0 = 0; d0 < 2; ++d0)
#pragma unroll
            for (int q = 0; q < 4; ++q) { const int d = d0 * 32 + 8 * q + 4 * hi;
                u32x2 pk; pk.x = pk2(o[d0][4 * q] * sc, o[d0][4 * q + 1] * sc); pk.y = pk2(o[d0][4 * q + 2] * sc, o[d0][4 * q + 3] * sc);
                *(u32x2*)(dst + d) = pk; }
    }
    __syncthreads();
}

constexpr int NS_LINV = 53056, NS_SEL = 54080, NS_PW = 54784, NS_GL = 121344;

template <int MODE>
__device__ __forceinline__ void nsa_softmax(f32x16& p0, f32x16& p1, bf16x8* pa, float& lsum, float negmb, int kt, int m, int trel, int hi, unsigned bit, int nmax, LAS float* pw, float& carry) {
    if (MODE == M_CMP) {
#pragma unroll
        for (int i = 0; i < 16; ++i) { p0[i] += negmb; p1[i] += negmb; }
    }
    if (MODE == M_CMP) {
        const int lim = nmax - kt * 64;
#pragma unroll
        for (int i = 0; i < 16; ++i) { const int rel = crow(i, hi); p0[i] = rel <= lim ? ex2(p0[i]) : 0.f; p1[i] = rel + 32 <= lim ? ex2(p1[i]) : 0.f; }
#pragma unroll
        for (int q = 0; q < 8; ++q) {
            const f32x16& pq = q < 4 ? p0 : p1; const int qb = 4 * (q & 3); const float e0 = pq[qb], e1 = pq[qb + 1], e2 = pq[qb + 2], e3 = pq[qb + 3];
            float a = e0 + e1 + e2 + 0.5f * e3; const float bq = 0.5f * e3;
            const float pb = __shfl_xor(bq, 32);
            a += hi ? pb : carry;
            carry = pb;
            pw[kt * 16 + 2 * q + hi] = a;
        }
    } else {
#pragma unroll
        for (int i = 0; i < 16; ++i) { p0[i] = ex2(p0[i]); p1[i] = ex2(p1[i]); }
        if (kt == m) {
            asm volatile("" ::: "memory");
#pragma unroll
            for (int i = 0; i < 16; ++i) { const int rel = crow(i, hi); if (rel > trel) p0[i] = 0.f; if (rel + 32 > trel) p1[i] = 0.f; }
        }
        if (MODE == M_WIN && kt == m - 8) {
            asm volatile("" ::: "memory");
#pragma unroll
            for (int i = 0; i < 16; ++i) { const int rel = crow(i, hi); if (rel <= trel) p0[i] = 0.f; if (rel + 32 <= trel) p1[i] = 0.f; }
        }
    }
    float sa = 0.f, sb = 0.f, sc_ = 0.f, sd = 0.f;
#pragma unroll
    for (int i = 0; i < 16; i += 2) { sa = fadd_s(sa, p0[i]); sb = fadd_s(sb, p0[i + 1]); sc_ = fadd_s(sc_, p1[i]); sd = fadd_s(sd, p1[i + 1]); }
    float sum = fadd_s(fadd_s(sa, sb), fadd_s(sc_, sd));
    const unsigned mk = (MODE == M_SLC) ? (bit ? 0xffffffffu : 0u) : 0xffffffffu;
#pragma unroll
    for (int k = 0; k < 4; ++k) { const f32x16& p = k < 2 ? p0 : p1; const int bs = 8 * (k & 1);
        u32x4 wv = {pk2(p[bs], p[bs + 1]), pk2(p[bs + 2], p[bs + 3]), pk2(p[bs + 4], p[bs + 5]), pk2(p[bs + 6], p[bs + 7])};
        if (MODE == M_SLC) { wv.x &= mk; wv.y &= mk; wv.z &= mk; wv.w &= mk; }
        pa[k] = __builtin_bit_cast(bf16x8, wv); }
    if (MODE == M_SLC) sum = bit ? sum : 0.f;
    lsum += sum;
}

template <int MODE>
__device__ __forceinline__ void nsa_branch(LAS unsigned char* lds, const bf16_t* Kb, const int kpitch, const bf16_t* Vb, const int vpitch, const int kt_first, const int nt,
                                           const bf16x8* qr, const float negmb, f32x16* o, float& lsum, const int m, const int trel, const int tid, const int w,
                                           const unsigned sel_lo, const unsigned sel_hi, const int nmax, LAS float* pw) {
    const int lane = tid & 63, r32 = lane & 31, hi = lane >> 5;
    f32x16 cneg = splat16(MODE == M_CMP ? 0.f : negmb);
    if (MODE != M_CMP) asm volatile("" : "+v"(cneg));
    const bool grpA = (w < 4);
    float carry = 0.f;
    KVStage sA;
#define TILE_CL(i) ((kt_first + ((i) < nt ? (i) : nt - 1)) * 64)
    {   KVStage sB;
        kv_load(sA, Kb, kpitch, Vb, vpitch, TILE_CL(0), tid);
        kv_load(sB, Kb, kpitch, Vb, vpitch, TILE_CL(1), tid);
        kv_store(sA, lds, tid);
        kv_store(sB, lds + KV_BUF, tid); }
    __syncthreads();
    int s0 = 0, s1 = KV_BUF, s2 = 2 * KV_BUF;
    (void)grpA;
    for (int it = 0; it < nt; ++it) {
        const int kt = kt_first + it;
        kv_load(sA, Kb, kpitch, Vb, vpitch, TILE_CL(it + 2), tid);
        const unsigned bit = ((kt < 32 ? sel_lo : sel_hi) >> (kt & 31)) & 1u;
        bf16x8 pa[4];
        bf16x8 kf[8]; s16x4 vlo[8], vhi[8];
        f32x16 c0, c1;
        k_reads(kf, lds + s0, r32, hi);
        v_reads(vlo, vhi, lds + s0 + KV_VOFF, lane);
        __builtin_amdgcn_sched_barrier(0);
        qk_mfma(c0, c1, cneg, kf, qr);
        __builtin_amdgcn_sched_barrier(0);
        nsa_softmax<MODE>(c0, c1, pa, lsum, negmb, kt, m, trel, hi, bit, nmax, pw, carry);
        __builtin_amdgcn_sched_barrier(0);
        pv_mfma(o, vlo, vhi, pa);
        kv_store(sA, lds + s2, tid);
        __syncthreads();
        const int tmp = s0; s0 = s1; s1 = s2; s2 = tmp;
    }
#undef TILE_CL
}

__device__ __forceinline__ void nsa_item(const Args& A, LAS unsigned char* lds, int item, const int wv_) {
    unsigned char* ws = A.ws;
    const bf16_t* P = (const bf16_t*)(ws + WS_P);
    const int bg = item >> 6, m = item & 63;
    const int b = bg >> 1, g = bg & 1, T0 = 64 * m, w = wv_;
#define NSA_LANE() int tid_l = TIDX; asm volatile("" : "+v"(tid_l)); const int tid = tid_l, lane = tid & 63, r32 = lane & 31, hi = lane >> 5, hd = 4 * g + (w & 3), trel = 32 * (w >> 2) + r32, t = T0 + trel; \
                   const size_t tokrow = (size_t)(b * SEQ + t); (void)hd; (void)hi; (void)tokrow; (void)lane
    const float* mbp = (const float*)(ws + WS_MB);
    bf16x8 qr[4];
    f32x16 o[2]; float lsum;
    {   NSA_LANE();
        {
            const bf16_t* Qraw = P + tokrow * NCP + C_QN + hd * 64;
            u32x4 raw[4];
#pragma unroll
            for (int d0 = 0; d0 < 4; ++d0) raw[d0] = *(const u32x4*)(Qraw + 16 * d0 + 8 * hi);
            float y[32];
#pragma unroll
            for (int d0 = 0; d0 < 4; ++d0) { y[8 * d0] = bflo(raw[d0].x); y[8 * d0 + 1] = bfhi(raw[d0].x); y[8 * d0 + 2] = bflo(raw[d0].y); y[8 * d0 + 3] = bfhi(raw[d0].y);
                y[8 * d0 + 4] = bflo(raw[d0].z); y[8 * d0 + 5] = bfhi(raw[d0].z); y[8 * d0 + 6] = bflo(raw[d0].w); y[8 * d0 + 7] = bfhi(raw[d0].w); }
            float ss = 0.f;
#pragma unroll
            for (int i = 0; i < 32; ++i) ss += y[i] * y[i];
            ss += __shfl_xor(ss, 32);
            const float r = 1.f / sqrtf(ss * (1.f / 64.f) + EPSN);
            const float* gq = A.in[3];
#pragma unroll
            for (int d0 = 0; d0 < 4; ++d0) { const f32x4 ga = *(const f32x4*)(gq + 16 * d0 + 8 * hi), gb = *(const f32x4*)(gq + 16 * d0 + 8 * hi + 4);
                y[8 * d0] *= r * ga.x; y[8 * d0 + 1] *= r * ga.y; y[8 * d0 + 2] *= r * ga.z; y[8 * d0 + 3] *= r * ga.w; y[8 * d0 + 4] *= r * gb.x; y[8 * d0 + 5] *= r * gb.y; y[8 * d0 + 6] *= r * gb.z; y[8 * d0 + 7] *= r * gb.w; }
            const float2* rope = (const float2*)(ws + WS_ROPE) + t * 8;
#pragma unroll
            for (int j = 0; j < 8; ++j) { const float oth = __shfl_xor(y[j], 32); const float2 cs = rope[j];
                y[j] = hi ? (y[j] * cs.x + oth * cs.y) : (y[j] * cs.x - oth * cs.y); }
#pragma unroll
            for (int d0 = 0; d0 < 4; ++d0) { u32x4 u = {pk2(y[8 * d0] * C2, y[8 * d0 + 1] * C2), pk2(y[8 * d0 + 2] * C2, y[8 * d0 + 3] * C2), pk2(y[8 * d0 + 4] * C2, y[8 * d0 + 5] * C2), pk2(y[8 * d0 + 6] * C2, y[8 * d0 + 7] * C2)};
                qr[d0] = __builtin_bit_cast(bf16x8, u); }
        }
        const bf16_t* glp = P + tokrow * NCP + C_GL + hd * 3;
        LAS float* gls = (LAS float*)(lds + NS_GL) + tid;
        gls[0] = sigmoidf_(bf1(glp[0])); gls[512] = sigmoidf_(bf1(glp[1])); gls[1024] = sigmoidf_(bf1(glp[2]));
        LAS float* pw = (LAS float*)(lds + NS_PW) + (w * 32 + r32) * 65;
#pragma unroll
        for (int j = 0; j < 32; ++j) pw[hi * 32 + j] = 0.f;
        if (hi) pw[64] = 0.f;
        o[0] = splat16(0.f); o[1] = splat16(0.f); lsum = 0.f;
        const bf16_t* Kc = (const bf16_t*)(ws + WS_KCMP) + (size_t)((b * 2 + g) * 256) * 64; const bf16_t* Vc = (const bf16_t*)(ws + WS_VCMP) + (size_t)((b * 2 + g) * 256) * 64;
        nsa_branch<M_CMP>(lds, Kc, 64, Vc, 64, 0, ((4 * m + 2) >> 6) + 1, qr, -mbp[0], o, lsum, m, trel, tid, w, 0u, 0u, (t - 31) >> 4, pw);
    }
    float inv_c;
    {   NSA_LANE();
        lsum += __shfl_xor(lsum, 32);
        inv_c = lsum > 0.f ? 1.f / lsum : 0.f;
        LAS float* linv = (LAS float*)(lds + NS_LINV);
        if (hi == 0) linv[w * 32 + r32] = inv_c;
    }
    __syncthreads();
    {
        NSA_LANE();
        const LAS float* pwb = (const LAS float*)(lds + NS_PW);
        const LAS float* linv = (const LAS float*)(lds + NS_LINV);
        LAS unsigned long long* sell = (LAS unsigned long long*)(lds + NS_SEL);
        const int j = lane, blk = m;
        const bool valid = j <= blk, forced = (j == 0) || (j == blk) || (j == blk - 1);
        if (blk < 16) {
            const unsigned long long mk = __ballot(valid);
            if (lane < 8) sell[w * 8 + lane] = mk;
        } else {
            unsigned key[8], v[8];
#pragma unroll
            for (int i = 0; i < 8; ++i) {
                const int tok = w * 8 + i, half = tok >> 5, r = tok & 31;
                float sc2 = 0.f;
#pragma unroll
                for (int hh = 0; hh < 4; ++hh) sc2 += pwb[((half * 4 + hh) * 32 + r) * 65 + j] * linv[(half * 4 + hh) * 32 + r];
                const float sv = forced ? sc2 + 1.0e4f : sc2;
                key[i] = valid ? ((__float_as_uint(sv) & ~63u) | (unsigned)(63 - j)) : 0u;
                v[i] = key[i];
            }
#pragma unroll
            for (int k = 2; k <= 64; k <<= 1)
#pragma unroll
                for (int jj = k >> 1; jj > 0; jj >>= 1) {
                    const bool takemax = ((lane & jj) == 0) == ((lane & k) == 0);
#pragma unroll
                    for (int i = 0; i < 8; ++i) { const unsigned p = (unsigned)__shfl_xor((int)v[i], jj); const unsigned hi_ = v[i] > p ? v[i] : p, lo_ = v[i] > p ? p : v[i]; v[i] = takemax ? hi_ : lo_; }
                }
#pragma unroll
            for (int i = 0; i < 8; ++i) {
                const unsigned thr = (unsigned)__builtin_amdgcn_readlane((int)v[i], 15);
                const unsigned long long mk = __ballot(valid && key[i] >= thr);
                if (lane == 0) sell[w * 8 + i] = mk;
            }
        }
    }
    __syncthreads();
    {   NSA_LANE();
        const u32x2 sm = *(const LAS u32x2*)(lds + NS_SEL + trel * 8);
        LAS float* omix = (LAS float*)(lds + NS_PW) + w * 2048 + lane;
        const float sc = inv_c * ((const LAS float*)(lds + NS_GL))[tid];
#pragma unroll
        for (int i = 0; i < 16; ++i) { omix[i * 64] = o[0][i] * sc; omix[(16 + i) * 64] = o[1][i] * sc; }
        o[0] = splat16(0.f); o[1] = splat16(0.f); lsum = 0.f;
        const bf16_t* Ks = (const bf16_t*)(ws + WS_KSN) + (size_t)(b * SEQ) * 128 + g * 64; const bf16_t* Vs = P + (size_t)(b * SEQ) * NCP + C_VS + g * 64;
        nsa_branch<M_SLC>(lds, Ks, 128, Vs, NCP, 0, m + 1, qr, -mbp[1], o, lsum, m, trel, tid, w, sm.x, sm.y, 0, nullptr);
    }
    {   NSA_LANE();
        lsum += __shfl_xor(lsum, 32);
        const float inv = lsum > 0.f ? 1.f / lsum : 0.f;
        LAS float* omix = (LAS float*)(lds + NS_PW) + w * 2048 + lane;
        const float sc = inv * ((const LAS float*)(lds + NS_GL))[512 + tid];
#pragma unroll
        for (int i = 0; i < 16; ++i) { omix[i * 64] += o[0][i] * sc; omix[(16 + i) * 64] += o[1][i] * sc; }
        o[0] = splat16(0.f); o[1] = splat16(0.f); lsum = 0.f;
        const bf16_t* Kw = (const bf16_t*)(ws + WS_KWN) + (size_t)(b * SEQ) * 128 + g * 64; const bf16_t* Vw = P + (size_t)(b * SEQ) * NCP + C_VW + g * 64;
        const int kf0 = m >= 8 ? m - 8 : 0;
        nsa_branch<M_WIN>(lds, Kw, 128, Vw, NCP, kf0, m - kf0 + 1, qr, -mbp[2], o, lsum, m, trel, tid, w, 0u, 0u, 0, nullptr);
    }
    {   NSA_LANE();
        lsum += __shfl_xor(lsum, 32);
        const float inv = lsum > 0.f ? 1.f / lsum : 0.f;
        const LAS float* omix = (const LAS float*)(lds + NS_PW) + w * 2048 + lane;
        const float sc = inv * ((const LAS float*)(lds + NS_GL))[1024 + tid];
        const bf16_t* gp = P + tokrow * NCP + C_GN + hd * 64;
        bf16_t* dst = (bf16_t*)(ws + WS_XB) + tokrow * DM + hd * 64;
        u32x2 gvv[8];
#pragma unroll
        for (int e = 0; e < 8; ++e) gvv[e] = *(const u32x2*)(gp + (e >> 2) * 32 + 8 * (e & 3) + 4 * hi);
#pragma unroll
        for (int d0 = 0; d0 < 2; ++d0)
#pragma unroll
            for (int q = 0; q < 4; ++q) { const int d = d0 * 32 + 8 * q + 4 * hi;
                const u32x2 gv = gvv[d0 * 4 + q];
                const float g0 = bflo(gv.x), g1 = bfhi(gv.x), g2 = bflo(gv.y), g3 = bfhi(gv.y);
                const float v0 = o[d0][4 * q] * sc + omix[(d0 * 16 + 4 * q) * 64], v1 = o[d0][4 * q + 1] * sc + omix[(d0 * 16 + 4 * q + 1) * 64];
                const float v2 = o[d0][4 * q + 2] * sc + omix[(d0 * 16 + 4 * q + 2) * 64], v3 = o[d0][4 * q + 3] * sc + omix[(d0 * 16 + 4 * q + 3) * 64];
                u32x2 pk; pk.x = pk2(v0 * g0 * sigmoidf_(g0), v1 * g1 * sigmoidf_(g1)); pk.y = pk2(v2 * g2 * sigmoidf_(g2), v3 * g3 * sigmoidf_(g3));
                *(u32x2*)(dst + d) = pk; }
    }
#undef NSA_LANE
    __syncthreads();
}

#define XB_TMO      128
#define XB_XCNT(j)  (256  + 64 * (j))
#define XB_XSUB(j)  (1280 + 64 * (j))
#define XB_XGEN(j)  (2304 + 64 * (j))
#define XB_TOP      3328
#define XB_TOPGEN   3392
#define XCD_BAR_WORDS 3456
#define XB_SPIN_CAP (1u << 18)

__device__ __forceinline__ unsigned xb_ld(unsigned* p)              { return __hip_atomic_load(p, __ATOMIC_RELAXED, __HIP_MEMORY_SCOPE_AGENT); }
__device__ __forceinline__ unsigned xb_add(unsigned* p, unsigned v) { return __hip_atomic_fetch_add(p, v, __ATOMIC_RELAXED, __HIP_MEMORY_SCOPE_AGENT); }
__device__ __forceinline__ unsigned xb_xcc_id() { return (unsigned)__builtin_amdgcn_s_getreg((3 << 11) | 20) & 0xFu; }
#define XB_SPIN(cond, bar) do { unsigned _sp = 0; while (cond) { __builtin_amdgcn_s_sleep(1); \
    if ((++_sp & 255u) == 0u) { if (xb_ld(&(bar)[XB_TMO])) break; if (_sp > XB_SPIN_CAP) { atomicAdd(&(bar)[XB_TMO], 1u); break; } } } } while (0)

struct XcdBarrier {
    unsigned* bar; unsigned x;
    volatile LAS unsigned* st;
};

__device__ __forceinline__ XcdBarrier xcd_barrier_post(unsigned* bar, volatile LAS unsigned* st, const int wv_) {
    XcdBarrier b; b.bar = bar; b.x = xb_xcc_id(); b.st = st;
    if (TIDX == 0) (void)xb_add(&bar[XB_XCNT(b.x)], 1u);
    return b;
}
__device__ __forceinline__ void xcd_barrier_complete(unsigned* bar, unsigned x, unsigned& nloc, unsigned& nx) {
    const unsigned G = gridDim.x * gridDim.y * gridDim.z;
    unsigned sum, cnt, mine, sp = 0u;
    for (;;) {
        sum = 0u; cnt = 0u; mine = 0u;
#pragma unroll
        for (unsigned j = 0; j < 16; ++j) { const unsigned c = xb_ld(&bar[XB_XCNT(j)]); sum += c; cnt += (c > 0u) ? 1u : 0u; mine = (j == x) ? c : mine; }
        if (sum == G) break;
        __builtin_amdgcn_s_sleep(1);
        if ((++sp & 255u) == 0u) { if (xb_ld(&bar[XB_TMO])) break; if (sp > XB_SPIN_CAP) { atomicAdd(&bar[XB_TMO], 1u); break; } }
    }
    nloc = mine > 0u ? mine : 1u; nx = cnt > 0u ? cnt : 1u;
}

__device__ __forceinline__ void xcd_barrier(const XcdBarrier& b, const int wv_) {
    asm volatile("s_waitcnt vmcnt(0)" ::: "memory");
    __syncthreads();
    if (TIDX == 0) {
        unsigned* bar = b.bar;
        __builtin_amdgcn_s_waitcnt(0);
        unsigned nloc = b.st[0], nx = b.st[1];
        if (nloc == 0u) { xcd_barrier_complete(bar, b.x, nloc, nx); b.st[0] = nloc; b.st[1] = nx; }
        const unsigned old = xb_add(&bar[XB_XSUB(b.x)], 1u);
        const unsigned gen = old / nloc;
        if (old + 1u == (gen + 1u) * nloc) {
            __builtin_amdgcn_fence(__ATOMIC_RELEASE, "agent");
            asm volatile("s_waitcnt vmcnt(0)" ::: "memory");
            const unsigned og = xb_add(&bar[XB_TOP], 1u);
            const unsigned tg = og / nx;
            if (og + 1u == (tg + 1u) * nx) xb_add(&bar[XB_TOPGEN], 1u);
            else XB_SPIN(xb_ld(&bar[XB_TOPGEN]) == tg, bar);
            __builtin_amdgcn_fence(__ATOMIC_ACQUIRE, "agent");
            xb_add(&bar[XB_XGEN(b.x)], 1u);
            asm volatile("s_waitcnt vmcnt(0)" ::: "memory");
        } else {
            XB_SPIN(xb_ld(&bar[XB_XGEN(b.x)]) == gen, bar);
            __builtin_amdgcn_fence(__ATOMIC_ACQUIRE, "agent");
            asm volatile("s_waitcnt vmcnt(0)" ::: "memory");
        }
    }
    __syncthreads();
}

#define REP_P0 1
#define REP_G1 1
#define REP_P2 1
#define REP_SB 1
#define REP_WIN 1
#define REP_CMP 1
#define REP_SLC 1
#define REP_G2 1
#define XSYNC 0
__global__ void __launch_bounds__(512, 2) hybrid_fwd(Args A) {
    extern __shared__ __attribute__((aligned(16))) unsigned char lds_raw[];
    LAS unsigned char* lds = (LAS unsigned char*)lds_raw;
    cg::grid_group grid = cg::this_grid();
    const int wv_ = __builtin_amdgcn_readfirstlane((int)threadIdx.x >> 6);
    volatile LAS unsigned* bst = (volatile LAS unsigned*)(lds + 131072 + 64);
    if (TIDX < 2) bst[TIDX] = 0u;
    __syncthreads();
    XcdBarrier xbar = xcd_barrier_post((unsigned*)(A.ws + WS_CTL), bst, wv_);
    if (A.ws == nullptr) grid.sync();
#define GSYNC() xcd_barrier(xbar, wv_)
    unsigned char* ws = A.ws;
    const int G = gridDim.x, bx = blockIdx.x;

    for (int rep = 0; rep < REP_P0; ++rep) phase0(A, lds, wv_);
    GSYNC();
    for (int rep = 0; rep < XSYNC; ++rep) GSYNC();
#pragma unroll 1
    for (int rep = 0; rep < REP_G1; ++rep) {
        pg8::Gemm g{(const pg8::bf16_t*)(ws + WS_XB), (const pg8::bf16_t*)(ws + WS_WIN), NTOK, NCP, DM}; pg8::StaticOrder S; S.init(NTOK, NCP, G, bx);
        pg8::EpiProj E{(pg8::bf16_t*)(ws + WS_P), NCP, (const float*)(ws + WS_RSTD)};
        pg8::gemm_phase<pg8::EpiProj, pg8::StaticOrder, true, true>(lds, g, S, E, wv_);
    }
    GSYNC();
    if (G != 256) {
        for (int it = bx; it < 128; it += G) compress_item(A, lds, it, wv_);
        phase2_normrope(A, wv_, bx * 8 + wv_, G * 8);
        GSYNC();
    }
    if (G == 256) {
        const int x = bx & 7, j = bx >> 3;
        if (j < 16) compress_item(A, lds, (j >> 3) * 64 + (x >> 1) * 16 + (x & 1) * 8 + (j & 7), wv_);
        else knorm_bg(A, wv_, x, (j - 16) * 8 + wv_, 16 * 8);
        group_arrive((unsigned*)(ws + WS_CTL) + 3584 + 64 * x, wv_);
    }
    for (int rep = 0; rep < REP_SB; ++rep) for (int it = bx; it < 512; it += G) {
        int item = it;
        if (G == 256) { const int x = bx & 7, idx = (bx >> 3) * 2 + (it >> 8); item = (x * 4 + (idx >> 4)) * 16 + (idx & 15); }
        attn_item<M_SB>(A, lds, item, wv_);
    }
    if (G == 256) group_wait((unsigned*)(ws + WS_CTL) + 3584 + 64 * (bx & 7), 32u, wv_);
    for (int rep = 0; rep < REP_SLC; ++rep) for (int it = bx; it < 512; it += G) {
        int item;
        if (G == 256) { const int x = bx & 7, j = bx >> 3; item = x * 64 + ((it >> 8) ? 31 - j : 32 + j); }
        else { if (it < 256) item = (it >> 5) * 64 + 32 + (it & 31); else item = ((it - 256) >> 5) * 64 + 31 - ((it - 256) & 31); }
        nsa_item(A, lds, item, wv_);
    }
    GSYNC();
    for (int rep = 0; rep < REP_G2; ++rep) {
        pg8::Gemm g{(const pg8::bf16_t*)(ws + WS_XB), (const pg8::bf16_t*)(ws + WS_WOUT), NTOK, DM, DM}; pg8::StaticOrder S; S.init(NTOK, DM, G, bx);
        pg8::EpiOut E{A.in[0], A.out, DM};
        pg8::gemm_phase<pg8::EpiOut, pg8::StaticOrder, true, true>(lds, g, S, E, wv_);
    }
}

extern "C" void kernel_launch(void* const* d_in, const int* in_sizes, int n_in, void* d_out, int out_size, void* d_ws, size_t ws_size, hipStream_t stream) {
    static int grid = 0;
    if (grid == 0) {
        if (n_in != 16 || ws_size < WS_END) { fprintf(stderr, "kernel_launch: unexpected inputs (n_in %d, ws %zu)\n", n_in, ws_size); grid = -1; return; }
        int dev = 0, cus = 0, per_cu = 0;
        hipGetDevice(&dev);
        hipDeviceGetAttribute(&cus, hipDeviceAttributeMultiprocessorCount, dev);
        if (hipFuncSetAttribute((const void*)hybrid_fwd, hipFuncAttributeMaxDynamicSharedMemorySize, LDS_BYTES) != hipSuccess) { fprintf(stderr, "kernel_launch: hipFuncSetAttribute failed\n"); }
        hipOccupancyMaxActiveBlocksPerMultiprocessor(&per_cu, (const void*)hybrid_fwd, 512, LDS_BYTES);
        if (per_cu < 1) { fprintf(stderr, "kernel_launch: occupancy query says %d blocks/CU\n", per_cu); per_cu = 1; }
        (void)hipGetLastError();
        grid = cus * 1;
    }
    if (grid < 0) return;
    Args a{};
    for (int i = 0; i < 16; ++i) a.in[i] = (const float*)d_in[i];
    a.out = (float*)d_out; a.ws = (unsigned char*)d_ws;
    for (int i = 0; i < 8; ++i) a.invf[i] = std::pow(500000.0, -(double)(2 * i) / 16.0) / 6.283185307179586476925;
    if (hipMemsetAsync((char*)d_ws + WS_CTL, 0, 16384, stream) != hipSuccess) { fprintf(stderr, "kernel_launch: memset failed\n"); return; }
    void* args[] = {&a};
    hipError_t e = hipLaunchCooperativeKernel((const void*)hybrid_fwd, dim3(grid), dim3(512), args, LDS_BYTES, stream);
    if (e != hipSuccess) fprintf(stderr, "cooperative launch failed: %s (grid %d)\n", hipGetErrorString(e), grid);
}
```

```cpp
#include <hip/hip_runtime.h>
#include <hip/hip_cooperative_groups.h>
#include <cstdio>
#include <cstdint>
#include <cmath>
namespace cg = cooperative_groups;
__device__ __forceinline__ int lane_id_opaque_g() { int x; asm volatile("v_mbcnt_lo_u32_b32 %0, -1, 0\n\tv_mbcnt_hi_u32_b32 %0, -1, %0" : "=v"(x)); return x; }
#define TIDX_G ((wv_ << 6) + lane_id_opaque_g())
namespace pg8 {
#define PG8_LAS __attribute__((address_space(3)))
typedef unsigned short bf16_t;
typedef short bf16x8 __attribute__((ext_vector_type(8)));
typedef float f32x4 __attribute__((ext_vector_type(4)));
typedef unsigned u32x4 __attribute__((ext_vector_type(4)));
constexpr int BM = 256, BK = 64, HALF = 128, HTB = HALF * BK * 2  , STAGE_BYTES = 8 * HTB, NXCD = 8, WGM = 8;

__host__ __device__ __forceinline__ int lds_byte(int r, int c) { const int st = (r >> 4) * 2 + (c >> 5), rr = r & 15, cc = c & 31, ob = rr * 64 + cc * 2; return st * 1024 + (ob ^ (((ob >> 9) & 1) << 5)); }
__host__ __device__ __forceinline__ void stage_rc(int b, int& R, int& C) { const int st = b / 1024, sb = b % 1024, swz = sb ^ (((sb >> 9) & 1) << 5); R = (st >> 1) * 16 + swz / 64; C = (st & 1) * 32 + (swz % 64) / 2; }
__host__ __device__ __forceinline__ int perm32(int rho) { const int n = rho >> 4, i = rho & 15; return 8 * (i >> 2) + 4 * n + (i & 3); }

struct Unit { int pm, pn; };
struct Gemm { const bf16_t* A; const bf16_t* Bt; int M, N, K; };

struct StaticOrder {
    int nM, nN, nwg, G, c;
    __host__ __device__ void init(int M, int N, int G_, int c_) { nM = M / BM; nN = N / BM; nwg = nM * nN; G = G_; c = c_; }
    __host__ __device__ bool next(int i, Unit& u) const {
        const long L = (long)i * G + c; if (L >= nwg) return false;
        int wgid = (int)L; { const int q = nwg / NXCD, r = nwg % NXCD, xcd = wgid % NXCD, off = wgid / NXCD; wgid = (xcd < r ? xcd * (q + 1) : r * (q + 1) + (xcd - r) * q) + off; }
        const int nig = WGM * nN, gid = wgid / nig, fm = gid * WGM, gsz = (nM - fm) < WGM ? (nM - fm) : WGM;
        u.pm = fm + ((wgid % nig) % gsz); u.pn = (wgid % nig) / gsz; return true;
    }
    __device__ __forceinline__ void a_ready(const Unit&) const {}
    __device__ __forceinline__ void done(const Unit&) const {}
};

__device__ __forceinline__ unsigned cvt_pk_bf16(float lo, float hi) { unsigned r; asm volatile("v_cvt_pk_bf16_f32 %0, %1, %2" : "=v"(r) : "v"(lo), "v"(hi)); return r; }
struct EpiProj {
    static constexpr bool PERM = true, AFTER_DRAIN = false;
    bf16_t* O; int ldc; const float* rstd;
    __device__ __forceinline__ void operator()(const f32x4 (&acc)[2][2][4][2], const Unit& u, int wr, int wc, int fr, int fq) const {
        const int row0 = u.pm * BM + wr * 64 + fr; const int col0 = u.pn * BM + wc * 32 + 8 * fq;
        float sc[2][4];
#pragma unroll
        for (int ai = 0; ai < 2; ++ai)
#pragma unroll
            for (int m = 0; m < 4; ++m) sc[ai][m] = rstd[row0 + ai * HALF + m * 16];
#pragma unroll
        for (int ai = 0; ai < 2; ++ai)
#pragma unroll
            for (int m = 0; m < 4; ++m) { const int row = row0 + ai * HALF + m * 16; const float s = sc[ai][m]; bf16_t* rowp = O + (size_t)row * ldc + col0;
#pragma unroll
                for (int bj = 0; bj < 2; ++bj) { f32x4 v0 = acc[ai][bj][m][0] * s, v1 = acc[ai][bj][m][1] * s;
                    u32x4 w; w.x = cvt_pk_bf16(v0[0], v0[1]); w.y = cvt_pk_bf16(v0[2], v0[3]); w.z = cvt_pk_bf16(v1[0], v1[1]); w.w = cvt_pk_bf16(v1[2], v1[3]);
                    *(u32x4*)(rowp + bj * HALF) = w; } }
    }
};
struct EpiOut {
    static constexpr bool PERM = true, AFTER_DRAIN = false;
    const float* X; float* O; int ldc;
    __device__ __forceinline__ void operator()(const f32x4 (&acc)[2][2][4][2], const Unit& u, int wr, int wc, int fr, int fq) const {
        const int row0 = u.pm * BM + wr * 64 + fr; const int col0 = u.pn * BM + wc * 32 + 8 * fq;
#pragma unroll
        for (int ai = 0; ai < 2; ++ai) {
            f32x4 xa[4][2][2];
#pragma unroll
            for (int m = 0; m < 4; ++m)
#pragma unroll
                for (int bj = 0; bj < 2; ++bj) { const size_t off = (size_t)(row0 + ai * HALF + m * 16) * ldc + col0 + bj * HALF;
                    xa[m][bj][0] = *(const f32x4*)(X + off); xa[m][bj][1] = *(const f32x4*)(X + off + 4); }
#pragma unroll
            for (int m = 0; m < 4; ++m)
#pragma unroll
                for (int bj = 0; bj < 2; ++bj) { const size_t off = (size_t)(row0 + ai * HALF + m * 16) * ldc + col0 + bj * HALF;
                    *(f32x4*)(O + off) = xa[m][bj][0] + acc[ai][bj][m][0]; *(f32x4*)(O + off + 4) = xa[m][bj][1] + acc[ai][bj][m][1]; }
        }
    }
};
template <class Epi, class Sched, bool ALIGN_EPI = false, bool SP2 = false>
__device__ __forceinline__ void gemm_phase(PG8_LAS unsigned char* lds, const Gemm g, const Sched& S, const Epi& E, const int wv_) {
    int tid_l = TIDX_G; asm volatile("" : "+v"(tid_l));
    const int tid = tid_l, wid = __builtin_amdgcn_readfirstlane(tid >> 6), lane = tid & 63, wr = wid >> 2, wc = wid & 3, fr = lane & 15, fq = lane >> 4;
    const int K = g.K, nt = K / BK;
    unsigned voffA[2], voffB[2];
#pragma unroll
    for (int i = 0; i < 2; ++i) { int R, C; stage_rc(tid * 16 + i * 8192, R, C); const int Rb = Epi::PERM ? ((R & ~31) + perm32(R & 31)) : R;
        voffA[i] = (unsigned)(R * K + C) * 2u; voffB[i] = (unsigned)(Rb * K + C) * 2u; }
    const size_t kstep = (size_t)(BK * 2);
    const size_t hstep = (size_t)HALF * K * 2;
    const size_t tstep = 2 * hstep;
    const unsigned ldsw = (unsigned)wid * 1024u;
    const int aoff = lds_byte(wr * 64 + fr, fq * 8), boff = lds_byte(wc * 32 + fr, fq * 8);
#define PG8_SA(b, h) (((b) * 2 + (h)) * HTB)
#define PG8_SB(b, h) ((4 + (b) * 2 + (h)) * HTB)
#define PG8_STAGE(bufoff, gbase, voff) do { _Pragma("unroll") for (int _i = 0; _i < 2; ++_i) \
        __builtin_amdgcn_global_load_lds((const unsigned*)((const char*)(gbase) + (voff)[_i]), (PG8_LAS unsigned*)(lds + (bufoff) + ldsw + _i * 8192), 16, 0, 0); } while (0)
#define PG8_LDA(dst, b, h) do { _Pragma("unroll") for (int m = 0; m < 4; ++m) _Pragma("unroll") for (int k = 0; k < 2; ++k) dst[m][k] = *(const PG8_LAS bf16x8*)(lds + PG8_SA(b, h) + aoff + m * 2048 + k * 1024); } while (0)
#define PG8_LDB(dst, b, h) do { _Pragma("unroll") for (int n = 0; n < 2; ++n) _Pragma("unroll") for (int k = 0; k < 2; ++k) dst[n][k] = *(const PG8_LAS bf16x8*)(lds + PG8_SB(b, h) + boff + n * 2048 + k * 1024); } while (0)
#define PG8_MMA(ai, bj, At, Bt) do { __builtin_amdgcn_s_setprio(1); _Pragma("unroll") for (int m = 0; m < 4; ++m) _Pragma("unroll") for (int n = 0; n < 2; ++n) _Pragma("unroll") for (int k = 0; k < 2; ++k) \
        acc[ai][bj][m][n] = __builtin_amdgcn_mfma_f32_16x16x32_bf16(Bt[n][k], At[m][k], acc[ai][bj][m][n], 0, 0, 0); __builtin_amdgcn_s_setprio(0); } while (0)
#define PG8_WAIT_V(n) asm volatile("s_waitcnt vmcnt(" #n ")" ::: "memory")
#define PG8_WAIT_L(n) asm volatile("s_waitcnt lgkmcnt(" #n ")" ::: "memory")
#define PG8_BAR __builtin_amdgcn_s_barrier()
#define PG8_SCHED __builtin_amdgcn_sched_barrier(0)
    Unit cur, nxt; int ui = 0;
    if (!S.next(0, cur)) return;
    f32x4 acc[2][2][4][2];
#pragma unroll
    for (int a = 0; a < 2; ++a)
#pragma unroll
        for (int b = 0; b < 2; ++b)
#pragma unroll
            for (int m = 0; m < 4; ++m)
#pragma unroll
                for (int n = 0; n < 2; ++n) acc[a][b][m][n] = (f32x4){0.f, 0.f, 0.f, 0.f};
    bf16x8 At[4][2], B0[2][2], B1[2][2];
    const char* cA = (const char*)g.A + (size_t)cur.pm * tstep; const char* cB = (const char*)g.Bt + (size_t)cur.pn * tstep;
    S.a_ready(cur);
    if constexpr (SP2) {
        PG8_STAGE(PG8_SB(0, 0), cB, voffB); PG8_STAGE(PG8_SB(0, 1), cB + hstep, voffB); PG8_STAGE(PG8_SA(0, 0), cA, voffA); PG8_STAGE(PG8_SA(0, 1), cA + hstep, voffA);
        if (wr == 1) PG8_BAR;
        PG8_WAIT_V(2); PG8_BAR;
        PG8_STAGE(PG8_SB(1, 0), cB + kstep, voffB); PG8_STAGE(PG8_SA(1, 0), cA + kstep, voffA); PG8_STAGE(PG8_SB(1, 1), cB + hstep + kstep, voffB);
        PG8_WAIT_V(6); PG8_BAR;
    } else {
        PG8_STAGE(PG8_SB(0, 0), cB, voffB); PG8_STAGE(PG8_SA(0, 0), cA, voffA); PG8_STAGE(PG8_SB(0, 1), cB + hstep, voffB); PG8_STAGE(PG8_SA(0, 1), cA + hstep, voffA);
        if (wr == 1) PG8_BAR;
        PG8_WAIT_V(4); PG8_BAR;
        PG8_STAGE(PG8_SB(1, 0), cB + kstep, voffB); PG8_STAGE(PG8_SA(1, 0), cA + kstep, voffA); PG8_STAGE(PG8_SB(1, 1), cB + hstep + kstep, voffB);
        PG8_WAIT_V(6); PG8_BAR;
    }
    for (;;) {
        const bool has_next = S.next(ui + 1, nxt);
        const char* nA = has_next ? (const char*)g.A + (size_t)nxt.pm * tstep : cA; const char* nB = has_next ? (const char*)g.Bt + (size_t)nxt.pn * tstep : cB;
        for (int t = 0; t < nt; t += 2) {
            const bool last = (t == nt - 2);
            const char* a1 = cA + (size_t)(t + 1) * kstep;
            const char* a2 = last ? nA : cA + (size_t)(t + 2) * kstep; const char* b2 = last ? nB : cB + (size_t)(t + 2) * kstep;
            const char* a3 = a2 + kstep; const char* b3 = b2 + kstep;
            if (last && has_next) S.a_ready(nxt);
            if constexpr (SP2) {
            PG8_LDB(B0, 0, 0); PG8_LDB(B1, 0, 1); PG8_SCHED; PG8_LDA(At, 0, 0); PG8_STAGE(PG8_SA(1, 1), a1 + hstep, voffA);
            PG8_WAIT_V(8); PG8_WAIT_L(0); PG8_BAR; PG8_MMA(0, 0, At, B0); PG8_MMA(0, 1, At, B1); PG8_BAR; PG8_SCHED;
            PG8_LDA(At, 0, 1); PG8_STAGE(PG8_SB(0, 0), b2, voffB); PG8_STAGE(PG8_SB(0, 1), b2 + hstep, voffB); PG8_STAGE(PG8_SA(0, 0), a2, voffA);
            PG8_WAIT_V(8); PG8_WAIT_L(0); PG8_BAR; PG8_MMA(1, 0, At, B0); PG8_MMA(1, 1, At, B1); PG8_BAR; PG8_SCHED;
            PG8_LDB(B0, 1, 0); PG8_LDB(B1, 1, 1); PG8_SCHED; PG8_LDA(At, 1, 0); PG8_STAGE(PG8_SA(0, 1), a2 + hstep, voffA);
            PG8_WAIT_V(8); PG8_WAIT_L(0); PG8_BAR; PG8_MMA(0, 0, At, B0); PG8_MMA(0, 1, At, B1); PG8_BAR; PG8_SCHED;
            PG8_LDA(At, 1, 1); PG8_STAGE(PG8_SB(1, 0), b3, voffB); PG8_STAGE(PG8_SB(1, 1), b3 + hstep, voffB); PG8_STAGE(PG8_SA(1, 0), a3, voffA);
            PG8_WAIT_V(8); PG8_WAIT_L(0); PG8_BAR; PG8_MMA(1, 0, At, B0); PG8_MMA(1, 1, At, B1); PG8_BAR; PG8_SCHED;
            } else {
            PG8_LDB(B0, 0, 0); PG8_SCHED; PG8_LDA(At, 0, 0); PG8_STAGE(PG8_SA(1, 1), a1 + hstep, voffA);
            PG8_WAIT_L(8); PG8_BAR; PG8_WAIT_L(0); PG8_MMA(0, 0, At, B0); PG8_BAR; PG8_SCHED;
            PG8_LDB(B1, 0, 1); PG8_STAGE(PG8_SB(0, 0), b2, voffB);
            PG8_BAR; PG8_WAIT_L(0); PG8_MMA(0, 1, At, B1); PG8_BAR;
            PG8_LDA(At, 0, 1); PG8_STAGE(PG8_SA(0, 0), a2, voffA);
            PG8_BAR; PG8_WAIT_L(0); PG8_MMA(1, 0, At, B0); PG8_BAR; PG8_SCHED;
            PG8_STAGE(PG8_SB(0, 1), b2 + hstep, voffB);
            PG8_WAIT_V(6); PG8_BAR; PG8_MMA(1, 1, At, B1); PG8_BAR;
            PG8_LDB(B0, 1, 0); PG8_SCHED; PG8_LDA(At, 1, 0); PG8_STAGE(PG8_SA(0, 1), a2 + hstep, voffA);
            PG8_WAIT_L(8); PG8_BAR; PG8_WAIT_L(0); PG8_MMA(0, 0, At, B0); PG8_BAR; PG8_SCHED;
            PG8_LDB(B1, 1, 1); PG8_STAGE(PG8_SB(1, 0), b3, voffB);
            PG8_BAR; PG8_WAIT_L(0); PG8_MMA(0, 1, At, B1); PG8_BAR;
            PG8_LDA(At, 1, 1); PG8_STAGE(PG8_SA(1, 0), a3, voffA);
            PG8_BAR; PG8_WAIT_L(0); PG8_MMA(1, 0, At, B0); PG8_BAR; PG8_SCHED;
            PG8_STAGE(PG8_SB(1, 1), b3 + hstep, voffB);
            PG8_WAIT_V(6); PG8_BAR; PG8_MMA(1, 1, At, B1); PG8_BAR;
            }
        }
        if constexpr (ALIGN_EPI) { if (wr == 0) PG8_BAR; }
        if constexpr (!Epi::AFTER_DRAIN) { E(acc, cur, wr, wc, fr, fq); S.done(cur); }
        if (!has_next) break;
#pragma unroll
        for (int a = 0; a < 2; ++a)
#pragma unroll
            for (int b = 0; b < 2; ++b)
#pragma unroll
                for (int m = 0; m < 4; ++m)
#pragma unroll
                    for (int n = 0; n < 2; ++n) acc[a][b][m][n] = (f32x4){0.f, 0.f, 0.f, 0.f};
        cur = nxt; cA = nA; cB = nB; ++ui;
        if constexpr (ALIGN_EPI) { if (wr == 1) PG8_BAR; }
    }
    PG8_WAIT_V(0);
    if constexpr (!ALIGN_EPI) { if (wr == 0) PG8_BAR; }
    PG8_BAR;
    if constexpr (Epi::AFTER_DRAIN) { E.fused(acc, cur, wr, wc, fr, fq, lds, wid, lane); S.done(cur); }
#undef PG8_SA
#undef PG8_SB
#undef PG8_STAGE
#undef PG8_LDA
#undef PG8_LDB
#undef PG8_MMA
#undef PG8_WAIT_V
#undef PG8_WAIT_L
#undef PG8_BAR
#undef PG8_SCHED
}
}

#define LAS __attribute__((address_space(3)))
typedef unsigned short bf16_t;
typedef short bf16x8 __attribute__((ext_vector_type(8)));
typedef short s16x4 __attribute__((ext_vector_type(4)));
typedef float f32x4 __attribute__((ext_vector_type(4)));
typedef float f32x16 __attribute__((ext_vector_type(16)));
typedef unsigned u32x4 __attribute__((ext_vector_type(4)));
typedef unsigned u32x2 __attribute__((ext_vector_type(2)));

constexpr int NB = 4, SEQ = 4096, NTOK = NB * SEQ, DM = 1024, NCP = 4096, NCOLS = 3864;
constexpr int C_QN = 0, C_KC = 512, C_VC = 640, C_KS = 768, C_VS = 896, C_KW = 1024, C_VW = 1152, C_GN = 1280, C_QSB = 1792, C_KSB = 2304, C_VSB = 2816, C_GSB = 3328, C_GL = 3840;
constexpr size_t MiB = 1u << 20;
constexpr size_t WS_WIN = 0, WS_WOUT = 8 * MiB, WS_W1T = 10 * MiB, WS_RSTD = 11 * MiB, WS_ROPE = 11 * MiB + 64 * 1024, WS_CBIAS = 11 * MiB + 384 * 1024, WS_MB = 11 * MiB + 400 * 1024;
constexpr size_t WS_KCMP = 12 * MiB, WS_VCMP = 12 * MiB + 512 * 1024, WS_SEL = 13 * MiB, WS_CTL = 14 * MiB, WS_XB = 16 * MiB, WS_P = 48 * MiB, WS_QN = 176 * MiB, WS_KSN = 192 * MiB, WS_KWN = 196 * MiB, WS_OC = 200 * MiB, WS_OW = 216 * MiB, WS_END = 232 * MiB;
constexpr int LDS_BYTES = 135168;
constexpr float C2 = 0.125f * 1.4426950408889634f;
constexpr float EPSN = 1e-6f;

struct Args { const float* in[16]; float* out; unsigned char* ws; double invf[8]; };

__device__ __forceinline__ unsigned pk2(float lo, float hi) {
    typedef float f2_t __attribute__((ext_vector_type(2))); typedef __bf16 b2_t __attribute__((ext_vector_type(2)));
    f2_t v = {lo, hi}; b2_t b = __builtin_convertvector(v, b2_t); return __builtin_bit_cast(unsigned, b); }
__device__ __forceinline__ float bflo(unsigned u) { return __uint_as_float(u << 16); }
__device__ __forceinline__ float bfhi(unsigned u) { return __uint_as_float(u & 0xffff0000u); }
__device__ __forceinline__ float bf1(bf16_t h) { return __uint_as_float(((unsigned)h) << 16); }
__device__ __forceinline__ float ex2(float x) { return __builtin_amdgcn_exp2f(x); }
__device__ __forceinline__ float lg2(float x) { return __builtin_amdgcn_logf(x); }
__device__ __forceinline__ float sigmoidf_(float x) { return 1.f / (1.f + __expf(-x)); }
__device__ __forceinline__ float wave_sum(float v) {
#pragma unroll
    for (int o = 1; o < 64; o <<= 1) v += __shfl_xor(v, o);
    return v;
}
__device__ __forceinline__ float wave_max(float v) {
#pragma unroll
    for (int o = 1; o < 64; o <<= 1) v = fmaxf(v, __shfl_xor(v, o));
    return v;
}
#define LDS_WAIT() asm volatile("s_waitcnt lgkmcnt(0)" ::: "memory")
__device__ __forceinline__ int lane_id_opaque() { int x; asm volatile("v_mbcnt_lo_u32_b32 %0, -1, 0\n\tv_mbcnt_hi_u32_b32 %0, -1, %0" : "=v"(x)); return x; }
#define TIDX ((wv_ << 6) + lane_id_opaque())
#define MFMA32(a, b, c) __builtin_amdgcn_mfma_f32_32x32x16_bf16((a), (b), (c), 0, 0, 0)

template <int MODE>
__device__ __forceinline__ void transpose_item(const float* W, int ldw, const float* gain, bf16_t* WT, int Kd, LAS float* scr, int kb, int nb, int lane) {
    const int k0 = 64 * kb, n0 = 32 * nb, n = n0 + (lane & 31);
    int sc = n; bool ok = true;
    if (MODE == 0) { if (n < 1280) sc = n; else if (n < 3840) sc = n + 24; else if (n < NCOLS) sc = n - 3840 + 1280; else { sc = 0; ok = false; } }
    float tv[32];
#pragma unroll
    for (int i = 0; i < 32; ++i) { const int kk = 2 * i + (lane >> 5); tv[i] = ok ? W[(size_t)(k0 + kk) * ldw + sc] : 0.f; }
#pragma unroll
    for (int i = 0; i < 32; ++i) { const int kk = 2 * i + (lane >> 5); float v = tv[i]; if (MODE == 0) v *= gain[k0 + kk]; scr[kk * 33 + (lane & 31)] = v; }
    LDS_WAIT();
    const int c = lane & 7;
#pragma unroll
    for (int j = 0; j < 4; ++j) { const int nn = (lane >> 3) + 8 * j; const LAS float* s = scr + (8 * c) * 33 + nn;
        u32x4 o; o.x = pk2(s[0 * 33], s[1 * 33]); o.y = pk2(s[2 * 33], s[3 * 33]); o.z = pk2(s[4 * 33], s[5 * 33]); o.w = pk2(s[6 * 33], s[7 * 33]);
        *(u32x4*)(WT + (size_t)(n0 + nn) * Kd + k0 + 8 * c) = o; }
    LDS_WAIT();
}

__device__ __forceinline__ void phase0(const Args& A, LAS unsigned char* lds, const int wv_) {
    const int tid = TIDX, lane = tid & 63, wave = __builtin_amdgcn_readfirstlane(tid >> 6);
    const int gw = blockIdx.x * 8 + wave, NGW = gridDim.x * 8;
    unsigned char* ws = A.ws;
    LAS float* scr = (LAS float*)(lds + wave * 8704);
    bf16_t* WinT = (bf16_t*)(ws + WS_WIN); bf16_t* WoutT = (bf16_t*)(ws + WS_WOUT); bf16_t* W1T = (bf16_t*)(ws + WS_W1T);
    constexpr int I_IN = 16 * 128, I_OUT = 16 * 32, I_W1 = 32 * 2;
    for (int it = gw; it < I_IN + I_OUT + 2 * I_W1; it += NGW) {
        int r = it;
        if (r < I_IN) { transpose_item<0>(A.in[2], NCOLS, A.in[1], WinT, DM, scr, r / 128, r % 128, lane); continue; } r -= I_IN;
        if (r < I_OUT) { transpose_item<1>(A.in[15], DM, nullptr, WoutT, DM, scr, r / 32, r % 32, lane); continue; } r -= I_OUT;
        if (r < I_W1) { transpose_item<1>(A.in[8], 64, nullptr, W1T, 2048, scr, r / 2, r % 2, lane); continue; } r -= I_W1;
        transpose_item<1>(A.in[12], 64, nullptr, W1T + 64 * 2048, 2048, scr, r / 2, r % 2, lane);
    }
    const float* x = A.in[0]; bf16_t* xb = (bf16_t*)(ws + WS_XB); float* rstd = (float*)(ws + WS_RSTD);
    for (int m0 = gw; m0 < NTOK; m0 += 2 * NGW) {
        f32x4 v[2][4];
#pragma unroll
        for (int u = 0; u < 2; ++u) { const int m = m0 + u * NGW; const f32x4* xr = (const f32x4*)(x + (size_t)m * DM) + lane;
#pragma unroll
            for (int j = 0; j < 4; ++j) v[u][j] = xr[64 * j]; }
#pragma unroll
        for (int u = 0; u < 2; ++u) { const int m = m0 + u * NGW; float s = 0.f;
#pragma unroll
            for (int j = 0; j < 4; ++j) s += (v[u][j].x * v[u][j].x + v[u][j].y * v[u][j].y) + (v[u][j].z * v[u][j].z + v[u][j].w * v[u][j].w);
            s = wave_sum(s);
            if (lane == 0) rstd[m] = 1.f / sqrtf(s * (1.f / DM) + EPSN);
            unsigned long long* o8 = (unsigned long long*)(xb + (size_t)m * DM) + lane;
#pragma unroll
            for (int j = 0; j < 4; ++j) o8[64 * j] = (unsigned long long)pk2(v[u][j].x, v[u][j].y) | ((unsigned long long)pk2(v[u][j].z, v[u][j].w) << 32); }
    }
    float* cbias = (float*)(ws + WS_CBIAS);
    for (int it = gw; it < 128; it += NGW) {
        const int kv = it >> 6, n = it & 63;
        const float* pos = A.in[kv ? 11 : 7]; const float* w1 = A.in[kv ? 12 : 8]; const float* b1 = A.in[kv ? 13 : 9];
        float s = 0.f;
        for (int k = lane; k < 2048; k += 64) s += pos[k] * w1[(size_t)k * 64 + n];
        s = wave_sum(s);
        if (lane == 0) cbias[it] = s + b1[n];
    }
    float2* rope = (float2*)(ws + WS_ROPE);
    for (int e = blockIdx.x * 512 + tid; e < SEQ * 8; e += gridDim.x * 512) {
        const int pos = e >> 3, i = e & 7;
        double rev = (double)pos * A.invf[i];
        rev -= floor(rev);
        const float rf = (float)rev;
        rope[e] = make_float2(__builtin_amdgcn_cosf(rf), __builtin_amdgcn_sinf(rf));
    }
    if (blockIdx.x == 0 && wave == 0) {
        const float gq = wave_max(fabsf(A.in[3][lane]));
        const float gc = wave_max(fabsf(A.in[4][lane])), gs = wave_max(fabsf(A.in[5][lane])), gwn = wave_max(fabsf(A.in[6][lane]));
        float* mb = (float*)(ws + WS_MB);
        if (lane == 0) { mb[0] = 8.f * gq * gc * 1.4426950408889634f * 1.02f; mb[1] = 8.f * gq * gs * 1.4426950408889634f * 1.02f; mb[2] = 8.f * gq * gwn * 1.4426950408889634f * 1.02f; }
    }
}

__device__ __forceinline__ void phase2_normrope(const Args& A, const int wv_, const int gw0, const int ngw) {
    const int tid = TIDX, lane = tid & 63;
    unsigned char* ws = A.ws;
    const bf16_t* __restrict__ P = (const bf16_t*)(ws + WS_P);
    bf16_t* __restrict__ ksn = (bf16_t*)(ws + WS_KSN); bf16_t* __restrict__ kwn = (bf16_t*)(ws + WS_KWN);
    const float2* __restrict__ rope = (const float2*)(ws + WS_ROPE);
    const int sub = lane & 7;
#pragma unroll 4
    for (int vb = gw0 * 8; vb < NTOK * 4; vb += ngw * 8) {
        const int v = vb + (lane >> 3);
        const int t = v >> 2, which = v & 3;
        int scol; const float* gain; bf16_t* dst;
        if (which < 2) { scol = C_KS + which * 64; gain = A.in[5]; dst = ksn + (size_t)t * 128 + which * 64; }
        else { scol = C_KW + (which - 2) * 64; gain = A.in[6]; dst = kwn + (size_t)t * 128 + (which - 2) * 64; }
        const u32x4 raw = *(const u32x4*)(P + (size_t)t * NCP + scol + sub * 8);
        float y[8];
        y[0] = bflo(raw.x); y[1] = bfhi(raw.x); y[2] = bflo(raw.y); y[3] = bfhi(raw.y); y[4] = bflo(raw.z); y[5] = bfhi(raw.z); y[6] = bflo(raw.w); y[7] = bfhi(raw.w);
        float ss = 0.f;
#pragma unroll
        for (int i = 0; i < 8; ++i) ss += y[i] * y[i];
        ss += __shfl_xor(ss, 1); ss += __shfl_xor(ss, 2); ss += __shfl_xor(ss, 4);
        const float r = 1.f / sqrtf(ss * (1.f / 64.f) + EPSN);
        const f32x4 g0 = *(const f32x4*)(gain + sub * 8), g1 = *(const f32x4*)(gain + sub * 8 + 4);
        y[0] *= r * g0.x; y[1] *= r * g0.y; y[2] *= r * g0.z; y[3] *= r * g0.w; y[4] *= r * g1.x; y[5] *= r * g1.y; y[6] *= r * g1.z; y[7] *= r * g1.w;
        const int pos = t & (SEQ - 1);
#pragma unroll
        for (int i = 0; i < 8; ++i) {
            const float oth = __shfl_xor(y[i], 1);
            const float2 cs = rope[pos * 8 + i];
            if (sub == 0) y[i] = y[i] * cs.x - oth * cs.y;
            else if (sub == 1) y[i] = y[i] * cs.x + oth * cs.y;
        }
        u32x4 o; o.x = pk2(y[0], y[1]); o.y = pk2(y[2], y[3]); o.z = pk2(y[4], y[5]); o.w = pk2(y[6], y[7]);
        *(u32x4*)(dst + sub * 8) = o;
    }
}

__device__ __forceinline__ void knorm_bg(const Args& A, const int wv_, const int bg, const int gw0, const int ngw) {
    const int tid = TIDX, lane = tid & 63;
    unsigned char* ws = A.ws;
    const bf16_t* __restrict__ P = (const bf16_t*)(ws + WS_P);
    bf16_t* __restrict__ ksn = (bf16_t*)(ws + WS_KSN); bf16_t* __restrict__ kwn = (bf16_t*)(ws + WS_KWN);
    const float2* __restrict__ rope = (const float2*)(ws + WS_ROPE);
    const int sub = lane & 7, b = bg >> 1, g = bg & 1;
#pragma unroll 4
    for (int ub = gw0 * 8; ub < SEQ * 2; ub += ngw * 8) {
        const int u = ub + (lane >> 3);
        const int t = b * SEQ + (u >> 1), win = u & 1;
        const int scol = (win ? C_KW : C_KS) + g * 64; const float* gain = A.in[win ? 6 : 5]; bf16_t* dst = (win ? kwn : ksn) + (size_t)t * 128 + g * 64;
        const u32x4 raw = *(const u32x4*)(P + (size_t)t * NCP + scol + sub * 8);
        float y[8];
        y[0] = bflo(raw.x); y[1] = bfhi(raw.x); y[2] = bflo(raw.y); y[3] = bfhi(raw.y); y[4] = bflo(raw.z); y[5] = bfhi(raw.z); y[6] = bflo(raw.w); y[7] = bfhi(raw.w);
        float ss = 0.f;
#pragma unroll
        for (int i = 0; i < 8; ++i) ss += y[i] * y[i];
        ss += __shfl_xor(ss, 1); ss += __shfl_xor(ss, 2); ss += __shfl_xor(ss, 4);
        const float r = 1.f / sqrtf(ss * (1.f / 64.f) + EPSN);
        const f32x4 g0 = *(const f32x4*)(gain + sub * 8), g1 = *(const f32x4*)(gain + sub * 8 + 4);
        y[0] *= r * g0.x; y[1] *= r * g0.y; y[2] *= r * g0.z; y[3] *= r * g0.w; y[4] *= r * g1.x; y[5] *= r * g1.y; y[6] *= r * g1.z; y[7] *= r * g1.w;
        const int pos = t & (SEQ - 1);
#pragma unroll
        for (int i = 0; i < 8; ++i) {
            const float oth = __shfl_xor(y[i], 1);
            const float2 cs = rope[pos * 8 + i];
            if (sub == 0) y[i] = y[i] * cs.x - oth * cs.y;
            else if (sub == 1) y[i] = y[i] * cs.x + oth * cs.y;
        }
        u32x4 o; o.x = pk2(y[0], y[1]); o.y = pk2(y[2], y[3]); o.z = pk2(y[4], y[5]); o.w = pk2(y[6], y[7]);
        *(u32x4*)(dst + sub * 8) = o;
    }
}
__device__ __forceinline__ void group_arrive(unsigned* ctr, const int wv_) {
    asm volatile("s_waitcnt vmcnt(0)" ::: "memory");
    __syncthreads();
    if (TIDX == 0) {
        __builtin_amdgcn_fence(__ATOMIC_RELEASE, "agent");
        asm volatile("s_waitcnt vmcnt(0)" ::: "memory");
        __hip_atomic_fetch_add(ctr, 1u, __ATOMIC_RELAXED, __HIP_MEMORY_SCOPE_AGENT);
    }
}
__device__ __forceinline__ void group_wait(unsigned* ctr, const unsigned n, const int wv_) {
    if (TIDX == 0) {
        unsigned sp = 0;
        while (__hip_atomic_load(ctr, __ATOMIC_RELAXED, __HIP_MEMORY_SCOPE_AGENT) < n) { __builtin_amdgcn_s_sleep(1); if (++sp > (1u << 22)) break; }
        __builtin_amdgcn_fence(__ATOMIC_ACQUIRE, "agent");
        asm volatile("s_waitcnt vmcnt(0)" ::: "memory");
    }
    __syncthreads();
}

__device__ __forceinline__ void compress_item(const Args& A, LAS unsigned char* lds, int item, const int wv_) {
    const int tid = TIDX, lane = tid & 63, r32 = lane & 31, hi = lane >> 5, wave = __builtin_amdgcn_readfirstlane(tid >> 6);
    unsigned char* ws = A.ws;
    const int kv = item >> 6, b = (item >> 4) & 3, g = (item >> 3) & 1, nt = item & 7, n0 = 32 * nt;
    const bf16_t* P = (const bf16_t*)(ws + WS_P);
    const bf16_t* W1T = (const bf16_t*)(ws + WS_W1T) + (size_t)kv * 64 * 2048;
    const int col = (kv ? C_VC : C_KC) + g * 64;
    const int n = n0 + r32; const bool nok = n <= 254;
    f32x16 acc0 = {}, acc1 = {};
#pragma unroll 8
    for (int ks = 0; ks < 16; ++ks) {
        const int kk = 256 * wave + 16 * ks + 8 * hi;
        const int tok = 16 * n + (kk >> 6), d = kk & 63;
        bf16x8 a = {};
        if (nok) a = *(const bf16x8*)(P + (size_t)(b * SEQ + tok) * NCP + col + d);
        const bf16x8 b0 = *(const bf16x8*)(W1T + (size_t)r32 * 2048 + kk);
        const bf16x8 b1 = *(const bf16x8*)(W1T + (size_t)(32 + r32) * 2048 + kk);
        acc0 = MFMA32(a, b0, acc0); acc1 = MFMA32(a, b1, acc1);
    }
    LAS float* red = (LAS float*)lds;
    LAS float* hid = (LAS float*)(lds + 65536);
#pragma unroll
    for (int i = 0; i < 16; ++i) { const int row = (i & 3) + 8 * (i >> 2) + 4 * hi; red[(wave * 32 + row) * 64 + r32] = acc0[i]; red[(wave * 32 + row) * 64 + 32 + r32] = acc1[i]; }
    __syncthreads();
    const float* cbias = (const float*)(ws + WS_CBIAS) + kv * 64;
#pragma unroll
    for (int j = 0; j < 4; ++j) { const int e = tid + 512 * j, c = e & 63; float s = cbias[c];
#pragma unroll
        for (int w = 0; w < 8; ++w) s += red[w * 2048 + e];
        hid[e] = s * sigmoidf_(s); }
    __syncthreads();
    const float* w2 = A.in[kv ? 14 : 10];
    const int row = tid >> 4, c4 = (tid & 15) * 4;
    f32x4 o = {0.f, 0.f, 0.f, 0.f};
    for (int j = 0; j < 64; ++j) { const float hv = hid[row * 64 + j]; const f32x4 wv = *(const f32x4*)(w2 + j * 64 + c4); o += wv * hv; }
    const int nn = n0 + row;
    bf16_t* dst = (bf16_t*)(ws + (kv ? WS_VCMP : WS_KCMP)) + ((size_t)((b * 2 + g) * 256 + nn)) * 64 + c4;
    if (kv == 0) {
        float ss = o.x * o.x + o.y * o.y + o.z * o.z + o.w * o.w;
        ss += __shfl_xor(ss, 1); ss += __shfl_xor(ss, 2); ss += __shfl_xor(ss, 4); ss += __shfl_xor(ss, 8);
        const float r = 1.f / sqrtf(ss * (1.f / 64.f) + EPSN);
        const f32x4 gn = *(const f32x4*)(A.in[4] + c4);
        o = o * r * gn;
        const int pos = 16 * nn + 31;
        const f32x4 oth = {__shfl_xor(o.x, 2), __shfl_xor(o.y, 2), __shfl_xor(o.z, 2), __shfl_xor(o.w, 2)};
        const int cc = tid & 15;
        if (cc < 4 && nn <= 254) {
            const float2* rope = (const float2*)(ws + WS_ROPE) + pos * 8 + (cc & 1) * 4;
            const float2 c0 = rope[0], c1 = rope[1], c2_ = rope[2], c3 = rope[3];
            if (cc < 2) { o.x = o.x * c0.x - oth.x * c0.y; o.y = o.y * c1.x - oth.y * c1.y; o.z = o.z * c2_.x - oth.z * c2_.y; o.w = o.w * c3.x - oth.w * c3.y; }
            else        { o.x = o.x * c0.x + oth.x * c0.y; o.y = o.y * c1.x + oth.y * c1.y; o.z = o.z * c2_.x + oth.z * c2_.y; o.w = o.w * c3.x + oth.w * c3.y; }
        }
    }
    if (nn > 254) o = (f32x4){0.f, 0.f, 0.f, 0.f};
    u32x2 pk; pk.x = pk2(o.x, o.y); pk.y = pk2(o.z, o.w);
    *(u32x2*)dst = pk;
    __syncthreads();
}

constexpr int KV_BUF = 17664, KV_VOFF = 9216, V_HALF = 4224;
constexpr int ATT_FLAGS = 35328, ATT_LINV = 35392, ATT_PW = 36416;

struct KVStage { u32x4 k, v; };
__device__ __forceinline__ void kv_load(KVStage& st, const bf16_t* Kb, int kpitch, const bf16_t* Vb, int vpitch, int key0, int tid) {
    const int key = tid >> 3, c = tid & 7;
    st.k = *(const u32x4*)(Kb + (size_t)(key0 + key) * kpitch + c * 8);
    st.v = *(const u32x4*)(Vb + (size_t)(key0 + key) * vpitch + c * 8);
}
__device__ __forceinline__ void kv_store(const KVStage& st, LAS unsigned char* buf, int tid) {
    const int key = tid >> 3, c = tid & 7;
    *(LAS u32x4*)(buf + key * 144 + c * 16) = st.k;
    *(LAS u32x4*)(buf + KV_VOFF + (c >> 2) * V_HALF + key * 64 + (c & 3) * 16) = st.v;
}
__device__ __forceinline__ void qk_tile(f32x16& p0, f32x16& p1, const f32x16& cinit, const LAS unsigned char* kb, const bf16x8* qr, int r32, int hi) {
    const LAS unsigned char* base = kb + r32 * 144 + hi * 16;
    { const bf16x8 a0 = *(const LAS bf16x8*)(base), a1 = *(const LAS bf16x8*)(base + 32 * 144);
      p0 = MFMA32(a0, qr[0], cinit); p1 = MFMA32(a1, qr[0], cinit); }
#pragma unroll
    for (int d0 = 1; d0 < 4; ++d0) { const bf16x8 a0 = *(const LAS bf16x8*)(base + d0 * 32), a1 = *(const LAS bf16x8*)(base + 32 * 144 + d0 * 32);
        p0 = MFMA32(a0, qr[d0], p0); p1 = MFMA32(a1, qr[d0], p1); }
}
typedef short v4i16_t __attribute__((ext_vector_type(4)));
__device__ __forceinline__ s16x4 vtr(const LAS unsigned char* p) { return __builtin_bit_cast(s16x4, __builtin_amdgcn_ds_read_tr16_b64_v4i16((LAS v4i16_t*)p)); }
__device__ __forceinline__ void pv_packed(f32x16* o, const LAS unsigned char* vb, const bf16x8* pa, int lane) {
    const int hi = lane >> 5;
    const LAS unsigned char* base = vb + ((lane >> 4) & 1) * 32 + (lane & 3) * 8 + (4 * hi + ((lane & 15) >> 2)) * 64;
#pragma unroll
    for (int d0 = 0; d0 < 2; ++d0)
#pragma unroll
        for (int s = 0; s < 4; ++s) {
            const s16x4 lo = vtr(base + d0 * V_HALF + s * 1024);
            const s16x4 hh = vtr(base + d0 * V_HALF + s * 1024 + 512);
            const bf16x8 vf = __builtin_shufflevector(lo, hh, 0, 1, 2, 3, 4, 5, 6, 7);
            o[d0] = MFMA32(vf, pa[s], o[d0]);
        }
}
__device__ __forceinline__ void pack_half(bf16x8* pa2, const f32x16& p) {
    u32x4 w0 = {pk2(p[0], p[1]), pk2(p[2], p[3]), pk2(p[4], p[5]), pk2(p[6], p[7])};
    u32x4 w1 = {pk2(p[8], p[9]), pk2(p[10], p[11]), pk2(p[12], p[13]), pk2(p[14], p[15])};
    pa2[0] = __builtin_bit_cast(bf16x8, w0); pa2[1] = __builtin_bit_cast(bf16x8, w1);
}
__device__ __forceinline__ void pv_tile(f32x16* o, const LAS unsigned char* vb, const f32x16& p0, const f32x16& p1, int lane) {
    bf16x8 pa[4]; pack_half(pa, p0); pack_half(pa + 2, p1);
    pv_packed(o, vb, pa, lane);
}
__device__ __forceinline__ f32x16 splat16(float v) { f32x16 r;
#pragma unroll
    for (int i = 0; i < 16; ++i) r[i] = v;
    return r; }
__device__ __forceinline__ int crow(int i, int hi) { return (i & 3) + 8 * (i >> 2) + 4 * hi; }

enum { M_WIN = 0, M_SLC = 1, M_SB = 2, M_CMP = 3 };

template <int MODE>
__device__ __forceinline__ void attn_item(const Args& A, LAS unsigned char* lds, int item, const int wv_) {
    int tid_l = TIDX; asm volatile("" : "+v"(tid_l));
    const int tid = tid_l, lane = tid & 63, r32 = lane & 31, hi = lane >> 5, w = __builtin_amdgcn_readfirstlane(tid >> 6);
    unsigned char* ws = A.ws;
    const bf16_t* P = (const bf16_t*)(ws + WS_P);
    int b, g = 0, hd, m, T0, trel;
    const bf16_t *Qrow, *Kb, *Vb; int kpitch, vpitch, kt_first, nt, kt_step = 1;
    if (MODE == M_SB) {
        b = item >> 7; hd = (item >> 4) & 7; m = item & 15; T0 = 256 * m; trel = 32 * w + r32;
        Qrow = P + (size_t)(b * SEQ + T0 + trel) * NCP + C_QSB + hd * 64;
        Kb = P + (size_t)(b * SEQ) * NCP + C_KSB + hd * 64; Vb = P + (size_t)(b * SEQ) * NCP + C_VSB + hd * 64; kpitch = NCP; vpitch = NCP;
        kt_first = 4 * m + 3; nt = 4 * m + 4; kt_step = -1;
    } else {
        if (MODE == M_SLC) { int bg; if (item < 256) { bg = item >> 5; m = 32 + (item & 31); } else { const int i2 = item - 256; bg = i2 >> 5; m = 31 - (i2 & 31); } b = bg >> 1; g = bg & 1; }
        else { b = item >> 7; g = (item >> 6) & 1; m = item & 63; }
        T0 = 64 * m; hd = 4 * g + (w & 3); trel = 32 * (w >> 2) + r32;
        Qrow = (const bf16_t*)(ws + WS_QN) + (size_t)(b * SEQ + T0 + trel) * 512 + hd * 64;
        if (MODE == M_WIN) { Kb = (const bf16_t*)(ws + WS_KWN) + (size_t)(b * SEQ) * 128 + g * 64; kpitch = 128; Vb = P + (size_t)(b * SEQ) * NCP + C_VW + g * 64; vpitch = NCP; kt_first = m >= 8 ? m - 8 : 0; nt = m - kt_first + 1; }
        else if (MODE == M_SLC) { Kb = (const bf16_t*)(ws + WS_KSN) + (size_t)(b * SEQ) * 128 + g * 64; kpitch = 128; Vb = P + (size_t)(b * SEQ) * NCP + C_VS + g * 64; vpitch = NCP; kt_first = 0; nt = m + 1; }
        else { Kb = (const bf16_t*)(ws + WS_KCMP) + (size_t)((b * 2 + g) * 256) * 64; kpitch = 64; Vb = (const bf16_t*)(ws + WS_VCMP) + (size_t)((b * 2 + g) * 256) * 64; vpitch = 64; kt_first = 0; nt = ((4 * m + 2) >> 6) + 1; }
    }
    const int t = T0 + trel;
    bf16x8 qr[4];
#pragma unroll
    for (int d0 = 0; d0 < 4; ++d0) qr[d0] = *(const bf16x8*)(Qrow + 16 * d0 + 8 * hi);
    if (MODE == M_SB) {
#pragma unroll
        for (int d0 = 0; d0 < 4; ++d0) { u32x4 u = __builtin_bit_cast(u32x4, qr[d0]);
            u.x = pk2(bflo(u.x) * C2, bfhi(u.x) * C2); u.y = pk2(bflo(u.y) * C2, bfhi(u.y) * C2); u.z = pk2(bflo(u.z) * C2, bfhi(u.z) * C2); u.w = pk2(bflo(u.w) * C2, bfhi(u.w) * C2);
            qr[d0] = __builtin_bit_cast(bf16x8, u); }
    }
    float negmb = 0.f;
    if (MODE != M_SB) negmb = -((const float*)(ws + WS_MB))[MODE == M_CMP ? 0 : (MODE == M_SLC ? 1 : 2)];
    unsigned sel_lo = 0, sel_hi = 0;
    if (MODE == M_SLC) { const u32x2 sm = *(const u32x2*)((const unsigned long long*)(ws + WS_SEL) + (size_t)(b * 2 + g) * SEQ + t); sel_lo = sm.x; sel_hi = sm.y; }
    const int nmax = (t - 31) >> 4;
    f32x16 o[2]; o[0] = splat16(0.f); o[1] = splat16(0.f);
    float lsum = 0.f, carry = (MODE == M_SB) ? 1.f : 0.f  ;
    bool done = false;
    LAS unsigned* flags = (LAS unsigned*)(lds + ATT_FLAGS);
    LAS float* pw = (LAS float*)(lds + ATT_PW) + (w * 32 + r32) * 65;
    if (MODE == M_CMP) {
#pragma unroll
        for (int j = 0; j < 32; ++j) pw[hi * 32 + j] = 0.f;
        if (hi) pw[64] = 0.f;
    }
    f32x16 cneg = splat16(negmb);
    if (MODE != M_SB) asm volatile("" : "+v"(cneg));
    KVStage sA, sB;
    kv_load(sA, Kb, kpitch, Vb, vpitch, kt_first * 64, tid);
    kv_store(sA, lds, tid);
    kv_load(sA, Kb, kpitch, Vb, vpitch, (kt_first + (nt > 1 ? kt_step : 0)) * 64, tid);
    __syncthreads();
    auto step = [&](const int it, KVStage& have, KVStage& recv) __attribute__((always_inline)) -> bool {
        const int kt = kt_first + it * kt_step;
        const LAS unsigned char* cur = lds + (it & 1) * KV_BUF;
        LAS unsigned char* nxt = lds + ((it & 1) ^ 1) * KV_BUF;
        const bool more = it + 1 < nt;
        { const int itn = it + 2 < nt ? it + 2 : nt - 1; kv_load(recv, Kb, kpitch, Vb, vpitch, (kt_first + itn * kt_step) * 64, tid); }
        if (MODE == M_WIN) {
            f32x16 p0, p1;
            qk_tile(p0, p1, cneg, cur, qr, r32, hi);
#pragma unroll
            for (int i = 0; i < 16; ++i) { p0[i] = ex2(p0[i]); p1[i] = ex2(p1[i]); }
            if (kt == m) {
#pragma unroll
                for (int i = 0; i < 16; ++i) { const int rel = crow(i, hi); if (rel > trel) p0[i] = 0.f; if (rel + 32 > trel) p1[i] = 0.f; }
            }
            if (kt == m - 8) {
#pragma unroll
                for (int i = 0; i < 16; ++i) { const int rel = crow(i, hi); if (rel <= trel) p0[i] = 0.f; if (rel + 32 <= trel) p1[i] = 0.f; }
            }
            float s = 0.f;
#pragma unroll
            for (int i = 0; i < 16; ++i) s += p0[i] + p1[i];
            lsum += s;
            pv_tile(o, cur + KV_VOFF, p0, p1, lane);
        } else if (MODE == M_SLC) {
            const unsigned bit = ((kt < 32 ? sel_lo : sel_hi) >> (kt & 31)) & 1u;
            if (__any((int)bit)) {
                f32x16 p0, p1;
                qk_tile(p0, p1, cneg, cur, qr, r32, hi);
                const float bf = bit ? 1.f : 0.f;
#pragma unroll
                for (int i = 0; i < 16; ++i) { p0[i] = ex2(p0[i]) * bf; p1[i] = ex2(p1[i]) * bf; }
                if (kt == m) {
#pragma unroll
                    for (int i = 0; i < 16; ++i) { const int rel = crow(i, hi); if (rel > trel) p0[i] = 0.f; if (rel + 32 > trel) p1[i] = 0.f; }
                }
                float s = 0.f;
#pragma unroll
                for (int i = 0; i < 16; ++i) s += p0[i] + p1[i];
                lsum += s;
                pv_tile(o, cur + KV_VOFF, p0, p1, lane);
            }
        } else if (MODE == M_CMP) {
            f32x16 p0, p1;
            qk_tile(p0, p1, cneg, cur, qr, r32, hi);
            const int lim = nmax - kt * 64;
#pragma unroll
            for (int i = 0; i < 16; ++i) { const int rel = crow(i, hi); p0[i] = rel <= lim ? ex2(p0[i]) : 0.f; p1[i] = rel + 32 <= lim ? ex2(p1[i]) : 0.f; }
            float s = 0.f;
#pragma unroll
            for (int i = 0; i < 16; ++i) s += p0[i] + p1[i];
            lsum += s;
#pragma unroll
            for (int q = 0; q < 8; ++q) {
                const f32x16& pq = q < 4 ? p0 : p1; const int qb = 4 * (q & 3); const float e0 = pq[qb], e1 = pq[qb + 1], e2 = pq[qb + 2], e3 = pq[qb + 3];
                float a = e0 + e1 + e2 + 0.5f * e3; const float bq = 0.5f * e3;
                const float pb = __shfl_xor(bq, 32);
                a += hi ? pb : carry;
                carry = pb;
                pw[kt * 16 + 2 * q + hi] = a;
            }
            pv_tile(o, cur + KV_VOFF, p0, p1, lane);
        } else {
            const int kbase = kt * 64 - T0;
            const bool skip = done || (kbase >= 32 * w + 31);
            if (!skip) {
                f32x16 pz[2];
                qk_tile(pz[0], pz[1], splat16(0.f), cur, qr, r32, hi);
                const bool partial = kbase + 63 >= 32 * w;
                const int lim = trel - kbase;
                bf16x8 pa[4];
                float run = carry;
#pragma unroll
                for (int h2 = 1; h2 >= 0; --h2) {
                    f32x16 om, be;
#pragma unroll
                    for (int i = 0; i < 16; ++i) { const float z = __builtin_amdgcn_fmed3f(pz[h2][i], -60.f, 60.f); const float e = ex2(-z); const float bb = __builtin_amdgcn_rcpf(1.f + e); be[i] = bb; om[i] = e * bb; }
                    if (partial) {
#pragma unroll
                        for (int i = 0; i < 16; ++i) { const int rel = crow(i, hi) + 32 * h2; if (rel >= lim) { om[i] = 1.f; be[i] = 0.f; } }
                    }
                    float gs[4], po[4];
#pragma unroll
                    for (int q = 0; q < 4; ++q) { gs[q] = (om[4 * q] * om[4 * q + 1]) * (om[4 * q + 2] * om[4 * q + 3]); po[q] = __shfl_xor(gs[q], 32); }
#pragma unroll
                    for (int q = 3; q >= 0; --q) {
                        const float ghi = hi ? gs[q] : po[q], glo = hi ? po[q] : gs[q];
                        const float t1 = run; run *= ghi; const float t0 = run; run *= glo;
                        float af = hi ? t1 : t0;
                        be[4 * q + 3] *= af; af *= om[4 * q + 3];
                        be[4 * q + 2] *= af; af *= om[4 * q + 2];
                        be[4 * q + 1] *= af; af *= om[4 * q + 1];
                        be[4 * q] *= af;
                    }
                    pack_half(pa + 2 * h2, be);
                }
                carry = run;
                pv_packed(o, cur + KV_VOFF, pa, lane);
                done = __all(carry < 3.5527e-15f);
            }
        }
        if (more) kv_store(have, nxt, tid);
        if (MODE == M_SB) { if (lane == 0) flags[(it & 1) * 8 + w] = done ? 1u : 0u; }
        __syncthreads();
        if (MODE == M_SB) {
            const u32x4 f0 = *(const LAS u32x4*)(flags + (it & 1) * 8), f1 = *(const LAS u32x4*)(flags + (it & 1) * 8 + 4);
            if ((f0.x & f0.y & f0.z & f0.w & f1.x & f1.y & f1.z & f1.w) != 0u) return true;
        }
        return false;
    };
    for (int it = 0; it < nt; it += 2) {
        if (step(it, sA, sB)) break;
        if (it + 1 >= nt) break;
        if (step(it + 1, sB, sA)) break;
    }
    if (MODE == M_SB) {
        const bf16_t* gp = P + (size_t)(b * SEQ + t) * NCP + C_GSB + hd * 64;
        bf16_t* dst = (bf16_t*)(ws + WS_XB) + (size_t)(b * SEQ + t) * DM + 512 + hd * 64;
        u32x2 gvv[8];
#pragma unroll
        for (int e = 0; e < 8; ++e) gvv[e] = *(const u32x2*)(gp + (e >> 2) * 32 + 8 * (e & 3) + 4 * hi);
#pragma unroll
        for (int d0 = 0; d0 < 2; ++d0)
#pragma unroll
            for (int q = 0; q < 4; ++q) { const int d = d0 * 32 + 8 * q + 4 * hi;
                const u32x2 gv = gvv[d0 * 4 + q];
                const float g0 = bflo(gv.x), g1 = bfhi(gv.x), g2 = bflo(gv.y), g3 = bfhi(gv.y);
                u32x2 pk; pk.x = pk2(o[d0][4 * q] * g0 * sigmoidf_(g0), o[d0][4 * q + 1] * g1 * sigmoidf_(g1)); pk.y = pk2(o[d0][4 * q + 2] * g2 * sigmoidf_(g2), o[d0][4 * q + 3] * g3 * sigmoidf_(g3));
                *(u32x2*)(dst + d) = pk; }
    } else {
        lsum += __shfl_xor(lsum, 32);
        const float inv = lsum > 0.f ? 1.f / lsum : 0.f;
        const int br = MODE == M_CMP ? 0 : (MODE == M_SLC ? 1 : 2);
        const float gate = sigmoidf_(bf1(P[(size_t)(b * SEQ + t) * NCP + C_GL + hd * 3 + br]));
        const float sc = inv * gate;
        const size_t orow = (size_t)(b * SEQ + t) * 512 + hd * 64;
        if (MODE == M_SLC) {
            const bf16_t* oc = (const bf16_t*)(ws + WS_OC) + orow; const bf16_t* ow = (const bf16_t*)(ws + WS_OW) + orow;
            const bf16_t* gp = P + (size_t)(b * SEQ + t) * NCP + C_GN + hd * 64;
            bf16_t* dst = (bf16_t*)(ws + WS_XB) + (size_t)(b * SEQ + t) * DM + hd * 64;
#pragma unroll
            for (int d0 = 0; d0 < 2; ++d0)
#pragma unroll
                for (int q = 0; q < 4; ++q) { const int d = d0 * 32 + 8 * q + 4 * hi;
                    const u32x2 gv = *(const u32x2*)(gp + d), cv = *(const u32x2*)(oc + d), wv = *(const u32x2*)(ow + d);
                    const float g0 = bflo(gv.x), g1 = bfhi(gv.x), g2 = bflo(gv.y), g3 = bfhi(gv.y);
                    const float v0 = o[d0][4 * q] * sc + bflo(cv.x) + bflo(wv.x), v1 = o[d0][4 * q + 1] * sc + bfhi(cv.x) + bfhi(wv.x);
                    const float v2 = o[d0][4 * q + 2] * sc + bflo(cv.y) + bflo(wv.y), v3 = o[d0][4 * q + 3] * sc + bfhi(cv.y) + bfhi(wv.y);
                    u32x2 pk; pk.x = pk2(v0 * g0 * sigmoidf_(g0), v1 * g1 * sigmoidf_(g1)); pk.y = pk2(v2 * g2 * sigmoidf_(g2), v3 * g3 * sigmoidf_(g3));
                    *(u32x2*)(dst + d) = pk; }
        } else {
            bf16_t* dst = (bf16_t*)(ws + (MODE == M_CMP ? WS_OC : WS_OW)) + orow;
#pragma unroll
            for (int d0 = 0; d0 < 2; ++d0)
#pragma unroll
                for (int q = 0; q < 4; ++q) { const int d = d0 * 32 + 8 * q + 4 * hi;
                    u32x2 pk; pk.x = pk2(o[d0][4 * q] * sc, o[d0][4 * q + 1] * sc); pk.y = pk2(o[d0][4 * q + 2] * sc, o[d0][4 * q + 3] * sc);
                    *(u32x2*)(dst + d) = pk; }
        }
        if (MODE == M_CMP) {
            LAS float* linv = (LAS float*)(lds + ATT_LINV);
            if (hi == 0) linv[w * 32 + r32] = inv;
            __syncthreads();
            const LAS float* pwb = (const LAS float*)(lds + ATT_PW);
            unsigned long long* sel = (unsigned long long*)(ws + WS_SEL) + (size_t)(b * 2 + g) * SEQ + T0;
            const int j = lane, blk = m;
            const bool valid = j <= blk, forced = (j == 0) || (j == blk) || (j == blk - 1);
            for (int i = 0; i < 8; ++i) {
                const int tok = w * 8 + i, half = tok >> 5, r = tok & 31;
                float sc2 = 0.f;
#pragma unroll
                for (int hh = 0; hh < 4; ++hh) sc2 += pwb[((half * 4 + hh) * 32 + r) * 65 + j] * linv[(half * 4 + hh) * 32 + r];
                const float s = valid ? (forced ? sc2 + 1.0e4f : sc2) : -INFINITY;
                int cnt = 0;
#pragma unroll
                for (int l2 = 0; l2 < 64; ++l2) { const float sl = __uint_as_float(__builtin_amdgcn_readlane(__float_as_uint(s), l2)); cnt += ((sl > s) || (sl == s && l2 < lane)) ? 1 : 0; }
                const unsigned long long mk = __ballot(valid && cnt < 16);
                if (lane == 0) sel[tok] = mk;
            }
        }
    }
    __syncthreads();
}


__device__ __forceinline__ void k_reads(bf16x8* kf, const LAS unsigned char* kb, int r32, int hi) {
    const LAS unsigned char* base = kb + r32 * 144 + hi * 16;
#pragma unroll
    for (int d0 = 0; d0 < 4; ++d0) { kf[2 * d0] = *(const LAS bf16x8*)(base + d0 * 32); kf[2 * d0 + 1] = *(const LAS bf16x8*)(base + 32 * 144 + d0 * 32); }
}
__device__ __forceinline__ void qk_mfma(f32x16& p0, f32x16& p1, const f32x16& cinit, const bf16x8* kf, const bf16x8* qr) {
    p0 = MFMA32(kf[0], qr[0], cinit); p1 = MFMA32(kf[1], qr[0], cinit);
#pragma unroll
    for (int d0 = 1; d0 < 4; ++d0) { p0 = MFMA32(kf[2 * d0], qr[d0], p0); p1 = MFMA32(kf[2 * d0 + 1], qr[d0], p1); }
}
__device__ __forceinline__ void v_reads(s16x4* vlo, s16x4* vhi, const LAS unsigned char* vb, int lane) {
    const int hi = lane >> 5;
    const LAS unsigned char* base = vb + ((lane >> 4) & 1) * 32 + (lane & 3) * 8 + (4 * hi + ((lane & 15) >> 2)) * 64;
#pragma unroll
    for (int d0 = 0; d0 < 2; ++d0)
#pragma unroll
        for (int s = 0; s < 4; ++s) { vlo[d0 * 4 + s] = vtr(base + d0 * V_HALF + s * 1024); vhi[d0 * 4 + s] = vtr(base + d0 * V_HALF + s * 1024 + 512); }
}
__device__ __forceinline__ void pv_mfma(f32x16* o, const s16x4* vlo, const s16x4* vhi, const bf16x8* pa) {
#pragma unroll
    for (int s = 0; s < 4; ++s)
#pragma unroll
        for (int d0 = 0; d0 < 2; ++d0) {
            const bf16x8 vf = __builtin_shufflevector(vlo[d0 * 4 + s], vhi[d0 * 4 + s], 0, 1, 2, 3, 4, 5, 6, 7);
            o[d0] = MFMA32(vf, pa[s], o[d0]);
        }
}
__device__ __forceinline__ float fadd_s(float a, float b) { float r; asm("v_add_f32_e32 %0, %1, %2" : "=v"(r) : "v"(a), "v"(b)); return r; }
typedef float f32x2v __attribute__((ext_vector_type(2)));
template <int MODE>
__device__ __forceinline__ void softmax_stage(f32x16& p0, f32x16& p1, bf16x8* pa, float& lsum, int kt, int m, int trel, int hi, unsigned bit) {
#pragma unroll
    for (int i = 0; i < 16; ++i) { p0[i] = ex2(p0[i]); p1[i] = ex2(p1[i]); }
    if (kt == m) {
#pragma unroll
        for (int i = 0; i < 16; ++i) { const int rel = crow(i, hi); if (rel > trel) p0[i] = 0.f; if (rel + 32 > trel) p1[i] = 0.f; }
    }
    if (MODE == M_WIN && kt == m - 8) {
#pragma unroll
        for (int i = 0; i < 16; ++i) { const int rel = crow(i, hi); if (rel <= trel) p0[i] = 0.f; if (rel + 32 <= trel) p1[i] = 0.f; }
    }
    f32x2v acc = {0.f, 0.f};
#pragma unroll
    for (int i = 0; i < 8; ++i) { acc += (f32x2v){p0[2 * i], p0[2 * i + 1]}; acc += (f32x2v){p1[2 * i], p1[2 * i + 1]}; }
    float sum = acc.x + acc.y;
    const unsigned mk = (MODE == M_SLC) ? (bit ? 0xffffffffu : 0u) : 0xffffffffu;
#pragma unroll
    for (int k = 0; k < 4; ++k) { const f32x16& p = k < 2 ? p0 : p1; const int bs = 8 * (k & 1);
        u32x4 wv = {pk2(p[bs], p[bs + 1]), pk2(p[bs + 2], p[bs + 3]), pk2(p[bs + 4], p[bs + 5]), pk2(p[bs + 6], p[bs + 7])};
        if (MODE == M_SLC) { wv.x &= mk; wv.y &= mk; wv.z &= mk; wv.w &= mk; }
        pa[k] = __builtin_bit_cast(bf16x8, wv); }
    if (MODE == M_SLC) sum = bit ? sum : 0.f;
    lsum += sum;
}

template <int MODE>
__device__ __forceinline__ void attn_item2(const Args& A, LAS unsigned char* lds, int item, const int wv_) {
    int tid_l = TIDX; asm volatile("" : "+v"(tid_l));
    const int tid = tid_l, lane = tid & 63, r32 = lane & 31, hi = lane >> 5, w = __builtin_amdgcn_readfirstlane(tid >> 6);
    unsigned char* ws = A.ws;
    const bf16_t* P = (const bf16_t*)(ws + WS_P);
    int b, g, m;
    if (MODE == M_SLC) { int bg; if (item < 256) { bg = item >> 5; m = 32 + (item & 31); } else { const int i2 = item - 256; bg = i2 >> 5; m = 31 - (i2 & 31); } b = bg >> 1; g = bg & 1; }
    else { b = item >> 7; g = (item >> 6) & 1; m = item & 63; }
    const int T0 = 64 * m, hd = 4 * g + (w & 3), trel = 32 * (w >> 2) + r32, t = T0 + trel;
    const bf16_t* Qrow = (const bf16_t*)(ws + WS_QN) + (size_t)(b * SEQ + t) * 512 + hd * 64;
    const bf16_t* Kb = (const bf16_t*)(ws + (MODE == M_WIN ? WS_KWN : WS_KSN)) + (size_t)(b * SEQ) * 128 + g * 64;
    const bf16_t* Vb = P + (size_t)(b * SEQ) * NCP + (MODE == M_WIN ? C_VW : C_VS) + g * 64;
    const int kpitch = 128, vpitch = NCP;
    const int kt_first = (MODE == M_WIN && m >= 8) ? m - 8 : 0, nt = m - kt_first + 1;
    bf16x8 qr[4];
#pragma unroll
    for (int d0 = 0; d0 < 4; ++d0) qr[d0] = *(const bf16x8*)(Qrow + 16 * d0 + 8 * hi);
    const float negmb = -((const float*)(ws + WS_MB))[MODE == M_SLC ? 1 : 2];
    unsigned sel_lo = 0xffffffffu, sel_hi = 0xffffffffu;
    if (MODE == M_SLC) { const u32x2 sm = *(const u32x2*)((const unsigned long long*)(ws + WS_SEL) + (size_t)(b * 2 + g) * SEQ + t); sel_lo = sm.x; sel_hi = sm.y; }
    f32x16 o[2]; o[0] = splat16(0.f); o[1] = splat16(0.f);
    float lsum = 0.f;
    f32x16 cneg = splat16(negmb);
    asm volatile("" : "+v"(cneg));
    const bool grpA = (w < 4);
    KVStage sA, sB;
#define TILE_CL(i) ((kt_first + ((i) < nt ? (i) : nt - 1)) * 64)
    kv_load(sA, Kb, kpitch, Vb, vpitch, TILE_CL(0), tid);
    kv_load(sB, Kb, kpitch, Vb, vpitch, TILE_CL(1), tid);
    kv_store(sA, lds, tid);
    kv_store(sB, lds + KV_BUF, tid);
    kv_load(sA, Kb, kpitch, Vb, vpitch, TILE_CL(2), tid);
    __syncthreads();
    f32x16 SA0, SA1, SB0, SB1;
    qk_tile(SA0, SA1, cneg, lds, qr, r32, hi);
    int s0 = 0, s1 = KV_BUF, s2 = 2 * KV_BUF;
    auto step = [&](const int it, KVStage& have, KVStage& recv, f32x16& c0, f32x16& c1, f32x16& n0, f32x16& n1) __attribute__((always_inline)) {
        const int kt = kt_first + it;
        kv_load(recv, Kb, kpitch, Vb, vpitch, TILE_CL(it + 3), tid);
        const unsigned bit = ((kt < 32 ? sel_lo : sel_hi) >> (kt & 31)) & 1u;
        bf16x8 pa[4];
        bf16x8 kf[8]; s16x4 vlo[8], vhi[8];
        if (grpA) {
            k_reads(kf, lds + s1, r32, hi);
            __builtin_amdgcn_sched_barrier(0);
            __builtin_amdgcn_s_setprio(1); qk_mfma(n0, n1, cneg, kf, qr); __builtin_amdgcn_s_setprio(0);
            v_reads(vlo, vhi, lds + s0 + KV_VOFF, lane);
            __builtin_amdgcn_sched_barrier(0);
            softmax_stage<MODE>(c0, c1, pa, lsum, kt, m, trel, hi, bit);
            __builtin_amdgcn_sched_barrier(0);
            __builtin_amdgcn_s_setprio(1); pv_mfma(o, vlo, vhi, pa); __builtin_amdgcn_s_setprio(0);
        } else {
            v_reads(vlo, vhi, lds + s0 + KV_VOFF, lane);
            __builtin_amdgcn_sched_barrier(0);
            softmax_stage<MODE>(c0, c1, pa, lsum, kt, m, trel, hi, bit);
            k_reads(kf, lds + s1, r32, hi);
            __builtin_amdgcn_sched_barrier(0);
            __builtin_amdgcn_s_setprio(1); pv_mfma(o, vlo, vhi, pa);
            __builtin_amdgcn_sched_barrier(0);
            qk_mfma(n0, n1, cneg, kf, qr); __builtin_amdgcn_s_setprio(0);
        }
        kv_store(have, lds + s2, tid);
        __syncthreads();
        const int tmp = s0; s0 = s1; s1 = s2; s2 = tmp;
    };
    for (int it = 0; it < nt; it += 2) {
        step(it, sA, sB, SA0, SA1, SB0, SB1);
        if (it + 1 >= nt) break;
        step(it + 1, sB, sA, SB0, SB1, SA0, SA1);
    }
#undef TILE_CL
    lsum += __shfl_xor(lsum, 32);
    const float inv = lsum > 0.f ? 1.f / lsum : 0.f;
    const int br = MODE == M_SLC ? 1 : 2;
    const float gate = sigmoidf_(bf1(P[(size_t)(b * SEQ + t) * NCP + C_GL + hd * 3 + br]));
    const float sc = inv * gate;
    const size_t orow = (size_t)(b * SEQ + t) * 512 + hd * 64;
    if (MODE == M_SLC) {
        const bf16_t* oc = (const bf16_t*)(ws + WS_OC) + orow; const bf16_t* ow = (const bf16_t*)(ws + WS_OW) + orow;
        const bf16_t* gp = P + (size_t)(b * SEQ + t) * NCP + C_GN + hd * 64;
        bf16_t* dst = (bf16_t*)(ws + WS_XB) + (size_t)(b * SEQ + t) * DM + hd * 64;
#pragma unroll
        for (int d0 = 0; d0 < 2; ++d0)
#pragma unroll
            for (int q = 0; q < 4; ++q) { const int d = d0 * 32 + 8 * q + 4 * hi;
                const u32x2 gv = *(const u32x2*)(gp + d), cv = *(const u32x2*)(oc + d), wv = *(const u32x2*)(ow + d);
                const float g0 = bflo(gv.x), g1 = bfhi(gv.x), g2 = bflo(gv.y), g3 = bfhi(gv.y);
                const float v0 = o[d0][4 * q] * sc + bflo(cv.x) + bflo(wv.x), v1 = o[d0][4 * q + 1] * sc + bfhi(cv.x) + bfhi(wv.x);
                const float v2 = o[d0][4 * q + 2] * sc + bflo(cv.y) + bflo(wv.y), v3 = o[d0][4 * q + 3] * sc + bfhi(cv.y) + bfhi(wv.y);
                u32x2 pk; pk.x = pk2(v0 * g0 * sigmoidf_(g0), v1 * g1 * sigmoidf_(g1)); pk.y = pk2(v2 * g2 * sigmoidf_(g2), v3 * g3 * sigmoidf_(g3));
                *(u32x2*)(dst + d) = pk; }
    } else {
        bf16_t* dst = (bf16_t*)(ws + WS_OW) + orow;
#pragma unroll
        for (int d0 = 0; d0 < 2; ++d0)
#pragma unroll
            for (int q = 0; q < 4; ++q) { const int d = d0 * 32 + 8 * q + 4 * hi;
                u32x2 pk; pk.x = pk2(o[d0][4 * q] * sc, o[d0][4 * q + 1] * sc); pk.y = pk2(o[d0][4 * q + 2] * sc, o[d0][4 * q + 3] * sc);
                *(u32x2*)(dst + d) = pk; }
    }
    __syncthreads();
}

constexpr int NS_LINV = 53056, NS_SEL = 54080, NS_PW = 54784, NS_GL = 121344;

template <int MODE>
__device__ __forceinline__ void nsa_softmax(f32x16& p0, f32x16& p1, bf16x8* pa, float& lsum, float negmb, int kt, int m, int trel, int hi, unsigned bit, int nmax, LAS float* pw, float& carry) {
    if (MODE == M_CMP) {
#pragma unroll
        for (int i = 0; i < 16; ++i) { p0[i] += negmb; p1[i] += negmb; }
    }
    if (MODE == M_CMP) {
        const int lim = nmax - kt * 64;
#pragma unroll
        for (int i = 0; i < 16; ++i) { const int rel = crow(i, hi); p0[i] = rel <= lim ? ex2(p0[i]) : 0.f; p1[i] = rel + 32 <= lim ? ex2(p1[i]) : 0.f; }
#pragma unroll
        for (int q = 0; q < 8; ++q) {
            const f32x16& pq = q < 4 ? p0 : p1; const int qb = 4 * (q & 3); const float e0 = pq[qb], e1 = pq[qb + 1], e2 = pq[qb + 2], e3 = pq[qb + 3];
            float a = e0 + e1 + e2 + 0.5f * e3; const float bq = 0.5f * e3;
            const float pb = __shfl_xor(bq, 32);
            a += hi ? pb : carry;
            carry = pb;
            pw[kt * 16 + 2 * q + hi] = a;
        }
    } else {
#pragma unroll
        for (int i = 0; i < 16; ++i) { p0[i] = ex2(p0[i]); p1[i] = ex2(p1[i]); }
        if (kt == m) {
            asm volatile("" ::: "memory");
#pragma unroll
            for (int i = 0; i < 16; ++i) { const int rel = crow(i, hi); if (rel > trel) p0[i] = 0.f; if (rel + 32 > trel) p1[i] = 0.f; }
        }
        if (MODE == M_WIN && kt == m - 8) {
            asm volatile("" ::: "memory");
#pragma unroll
            for (int i = 0; i < 16; ++i) { const int rel = crow(i, hi); if (rel <= trel) p0[i] = 0.f; if (rel + 32 <= trel) p1[i] = 0.f; }
        }
    }
    float sa = 0.f, sb = 0.f, sc_ = 0.f, sd = 0.f;
#pragma unroll
    for (int i = 0; i < 16; i += 2) { sa = fadd_s(sa, p0[i]); sb = fadd_s(sb, p0[i + 1]); sc_ = fadd_s(sc_, p1[i]); sd = fadd_s(sd, p1[i + 1]); }
    float sum = fadd_s(fadd_s(sa, sb), fadd_s(sc_, sd));
    const unsigned mk = (MODE == M_SLC) ? (bit ? 0xffffffffu : 0u) : 0xffffffffu;
#pragma unroll
    for (int k = 0; k < 4; ++k) { const f32x16& p = k < 2 ? p0 : p1; const int bs = 8 * (k & 1);
        u32x4 wv = {pk2(p[bs], p[bs + 1]), pk2(p[bs + 2], p[bs + 3]), pk2(p[bs + 4], p[bs + 5]), pk2(p[bs + 6], p[bs + 7])};
        if (MODE == M_SLC) { wv.x &= mk; wv.y &= mk; wv.z &= mk; wv.w &= mk; }
        pa[k] = __builtin_bit_cast(bf16x8, wv); }
    if (MODE == M_SLC) sum = bit ? sum : 0.f;
    lsum += sum;
}

template <int MODE>
__device__ __forceinline__ void nsa_branch(LAS unsigned char* lds, const bf16_t* Kb, const int kpitch, const bf16_t* Vb, const int vpitch, const int kt_first, const int nt,
                                           const bf16x8* qr, const float negmb, f32x16* o, float& lsum, const int m, const int trel, const int tid, const int w,
                                           const unsigned sel_lo, const unsigned sel_hi, const int nmax, LAS float* pw) {
    const int lane = tid & 63, r32 = lane & 31, hi = lane >> 5;
    f32x16 cneg = splat16(MODE == M_CMP ? 0.f : negmb);
    if (MODE != M_CMP) asm volatile("" : "+v"(cneg));
    const bool grpA = (w < 4);
    float carry = 0.f;
    KVStage sA;
#define TILE_CL(i) ((kt_first + ((i) < nt ? (i) : nt - 1)) * 64)
    {   KVStage sB;
        kv_load(sA, Kb, kpitch, Vb, vpitch, TILE_CL(0), tid);
        kv_load(sB, Kb, kpitch, Vb, vpitch, TILE_CL(1), tid);
        kv_store(sA, lds, tid);
        kv_store(sB, lds + KV_BUF, tid); }
    __syncthreads();
    int s0 = 0, s1 = KV_BUF, s2 = 2 * KV_BUF;
    (void)grpA;
    for (int it = 0; it < nt; ++it) {
        const int kt = kt_first + it;
        kv_load(sA, Kb, kpitch, Vb, vpitch, TILE_CL(it + 2), tid);
        const unsigned bit = ((kt < 32 ? sel_lo : sel_hi) >> (kt & 31)) & 1u;
        bf16x8 pa[4];
        bf16x8 kf[8]; s16x4 vlo[8], vhi[8];
        f32x16 c0, c1;
        k_reads(kf, lds + s0, r32, hi);
        v_reads(vlo, vhi, lds + s0 + KV_VOFF, lane);
        __builtin_amdgcn_sched_barrier(0);
        qk_mfma(c0, c1, cneg, kf, qr);
        __builtin_amdgcn_sched_barrier(0);
        nsa_softmax<MODE>(c0, c1, pa, lsum, negmb, kt, m, trel, hi, bit, nmax, pw, carry);
        __builtin_amdgcn_sched_barrier(0);
        pv_mfma(o, vlo, vhi, pa);
        kv_store(sA, lds + s2, tid);
        __syncthreads();
        const int tmp = s0; s0 = s1; s1 = s2; s2 = tmp;
    }
#undef TILE_CL
}

__device__ __forceinline__ void nsa_item(const Args& A, LAS unsigned char* lds, int item, const int wv_) {
    unsigned char* ws = A.ws;
    const bf16_t* P = (const bf16_t*)(ws + WS_P);
    const int bg = item >> 6, m = item & 63;
    const int b = bg >> 1, g = bg & 1, T0 = 64 * m, w = wv_;
#define NSA_LANE() int tid_l = TIDX; asm volatile("" : "+v"(tid_l)); const int tid = tid_l, lane = tid & 63, r32 = lane & 31, hi = lane >> 5, hd = 4 * g + (w & 3), trel = 32 * (w >> 2) + r32, t = T0 + trel; \
                   const size_t tokrow = (size_t)(b * SEQ + t); (void)hd; (void)hi; (void)tokrow; (void)lane
    const float* mbp = (const float*)(ws + WS_MB);
    bf16x8 qr[4];
    f32x16 o[2]; float lsum;
    {   NSA_LANE();
        {
            const bf16_t* Qraw = P + tokrow * NCP + C_QN + hd * 64;
            u32x4 raw[4];
#pragma unroll
            for (int d0 = 0; d0 < 4; ++d0) raw[d0] = *(const u32x4*)(Qraw + 16 * d0 + 8 * hi);
            float y[32];
#pragma unroll
            for (int d0 = 0; d0 < 4; ++d0) { y[8 * d0] = bflo(raw[d0].x); y[8 * d0 + 1] = bfhi(raw[d0].x); y[8 * d0 + 2] = bflo(raw[d0].y); y[8 * d0 + 3] = bfhi(raw[d0].y);
                y[8 * d0 + 4] = bflo(raw[d0].z); y[8 * d0 + 5] = bfhi(raw[d0].z); y[8 * d0 + 6] = bflo(raw[d0].w); y[8 * d0 + 7] = bfhi(raw[d0].w); }
            float ss = 0.f;
#pragma unroll
            for (int i = 0; i < 32; ++i) ss += y[i] * y[i];
            ss += __shfl_xor(ss, 32);
            const float r = 1.f / sqrtf(ss * (1.f / 64.f) + EPSN);
            const float* gq = A.in[3];
#pragma unroll
            for (int d0 = 0; d0 < 4; ++d0) { const f32x4 ga = *(const f32x4*)(gq + 16 * d0 + 8 * hi), gb = *(const f32x4*)(gq + 16 * d0 + 8 * hi + 4);
                y[8 * d0] *= r * ga.x; y[8 * d0 + 1] *= r * ga.y; y[8 * d0 + 2] *= r * ga.z; y[8 * d0 + 3] *= r * ga.w; y[8 * d0 + 4] *= r * gb.x; y[8 * d0 + 5] *= r * gb.y; y[8 * d0 + 6] *= r * gb.z; y[8 * d0 + 7] *= r * gb.w; }
            const float2* rope = (const float2*)(ws + WS_ROPE) + t * 8;
#pragma unroll
            for (int j = 0; j < 8; ++j) { const float oth = __shfl_xor(y[j], 32); const float2 cs = rope[j];
                y[j] = hi ? (y[j] * cs.x + oth * cs.y) : (y[j] * cs.x - oth * cs.y); }
#pragma unroll
            for (int d0 = 0; d0 < 4; ++d0) { u32x4 u = {pk2(y[8 * d0] * C2, y[8 * d0 + 1] * C2), pk2(y[8 * d0 + 2] * C2, y[8 * d0 + 3] * C2), pk2(y[8 * d0 + 4] * C2, y[8 * d0 + 5] * C2), pk2(y[8 * d0 + 6] * C2, y[8 * d0 + 7] * C2)};
                qr[d0] = __builtin_bit_cast(bf16x8, u); }
        }
        const bf16_t* glp = P + tokrow * NCP + C_GL + hd * 3;
        LAS float* gls = (LAS float*)(lds + NS_GL) + tid;
        gls[0] = sigmoidf_(bf1(glp[0])); gls[512] = sigmoidf_(bf1(glp[1])); gls[1024] = sigmoidf_(bf1(glp[2]));
        LAS float* pw = (LAS float*)(lds + NS_PW) + (w * 32 + r32) * 65;
#pragma unroll
        for (int j = 0; j < 32; ++j) pw[hi * 32 + j] = 0.f;
        if (hi) pw[64] = 0.f;
        o[0] = splat16(0.f); o[1] = splat16(0.f); lsum = 0.f;
        const bf16_t* Kc = (const bf16_t*)(ws + WS_KCMP) + (size_t)((b * 2 + g) * 256) * 64; const bf16_t* Vc = (const bf16_t*)(ws + WS_VCMP) + (size_t)((b * 2 + g) * 256) * 64;
        nsa_branch<M_CMP>(lds, Kc, 64, Vc, 64, 0, ((4 * m + 2) >> 6) + 1, qr, -mbp[0], o, lsum, m, trel, tid, w, 0u, 0u, (t - 31) >> 4, pw);
    }
    float inv_c;
    {   NSA_LANE();
        lsum += __shfl_xor(lsum, 32);
        inv_c = lsum > 0.f ? 1.f / lsum : 0.f;
        LAS float* linv = (LAS float*)(lds + NS_LINV);
        if (hi == 0) linv[w * 32 + r32] = inv_c;
    }
    __syncthreads();
    {
        NSA_LANE();
        const LAS float* pwb = (const LAS float*)(lds + NS_PW);
        const LAS float* linv = (const LAS float*)(lds + NS_LINV);
        LAS unsigned long long* sell = (LAS unsigned long long*)(lds + NS_SEL);
        const int j = lane, blk = m;
        const bool valid = j <= blk, forced = (j == 0) || (j == blk) || (j == blk - 1);
        if (blk < 16) {
            const unsigned long long mk = __ballot(valid);
            if (lane < 8) sell[w * 8 + lane] = mk;
        } else {
            unsigned key[8], v[8];
#pragma unroll
            for (int i = 0; i < 8; ++i) {
                const int tok = w * 8 + i, half = tok >> 5, r = tok & 31;
                float sc2 = 0.f;
#pragma unroll
                for (int hh = 0; hh < 4; ++hh) sc2 += pwb[((half * 4 + hh) * 32 + r) * 65 + j] * linv[(half * 4 + hh) * 32 + r];
                const float sv = forced ? sc2 + 1.0e4f : sc2;
                key[i] = valid ? ((__float_as_uint(sv) & ~63u) | (unsigned)(63 - j)) : 0u;
                v[i] = key[i];
            }
#pragma unroll
            for (int k = 2; k <= 64; k <<= 1)
#pragma unroll
                for (int jj = k >> 1; jj > 0; jj >>= 1) {
                    const bool takemax = ((lane & jj) == 0) == ((lane & k) == 0);
#pragma unroll
                    for (int i = 0; i < 8; ++i) { const unsigned p = (unsigned)__shfl_xor((int)v[i], jj); const unsigned hi_ = v[i] > p ? v[i] : p, lo_ = v[i] > p ? p : v[i]; v[i] = takemax ? hi_ : lo_; }
                }
#pragma unroll
            for (int i = 0; i < 8; ++i) {
                const unsigned thr = (unsigned)__builtin_amdgcn_readlane((int)v[i], 15);
                const unsigned long long mk = __ballot(valid && key[i] >= thr);
                if (lane == 0) sell[w * 8 + i] = mk;
            }
        }
    }
    __syncthreads();
    {   NSA_LANE();
        const u32x2 sm = *(const LAS u32x2*)(lds + NS_SEL + trel * 8);
        LAS float* omix = (LAS float*)(lds + NS_PW) + w * 2048 + lane;
        const float sc = inv_c * ((const LAS float*)(lds + NS_GL))[tid];
#pragma unroll
        for (int i = 0; i < 16; ++i) { omix[i * 64] = o[0][i] * sc; omix[(16 + i) * 64] = o[1][i] * sc; }
        o[0] = splat16(0.f); o[1] = splat16(0.f); lsum = 0.f;
        const bf16_t* Ks = (const bf16_t*)(ws + WS_KSN) + (size_t)(b * SEQ) * 128 + g * 64; const bf16_t* Vs = P + (size_t)(b * SEQ) * NCP + C_VS + g * 64;
        nsa_branch<M_SLC>(lds, Ks, 128, Vs, NCP, 0, m + 1, qr, -mbp[1], o, lsum, m, trel, tid, w, sm.x, sm.y, 0, nullptr);
    }
    {   NSA_LANE();
        lsum += __shfl_xor(lsum, 32);
        const float inv = lsum > 0.f ? 1.f / lsum : 0.f;
        LAS float* omix = (LAS float*)(lds + NS_PW) + w * 2048 + lane;
        const float sc = inv * ((const LAS float*)(lds + NS_GL))[512 + tid];
#pragma unroll
        for (int i = 0; i < 16; ++i) { omix[i * 64] += o[0][i] * sc; omix[(16 + i) * 64] += o[1][i] * sc; }
        o[0] = splat16(0.f); o[1] = splat16(0.f); lsum = 0.f;
        const bf16_t* Kw = (const bf16_t*)(ws + WS_KWN) + (size_t)(b * SEQ) * 128 + g * 64; const bf16_t* Vw = P + (size_t)(b * SEQ) * NCP + C_VW + g * 64;
        const int kf0 = m >= 8 ? m - 8 : 0;
        nsa_branch<M_WIN>(lds, Kw, 128, Vw, NCP, kf0, m - kf0 + 1, qr, -mbp[2], o, lsum, m, trel, tid, w, 0u, 0u, 0, nullptr);
    }
    {   NSA_LANE();
        lsum += __shfl_xor(lsum, 32);
        const float inv = lsum > 0.f ? 1.f / lsum : 0.f;
        const LAS float* omix = (const LAS float*)(lds + NS_PW) + w * 2048 + lane;
        const float sc = inv * ((const LAS float*)(lds + NS_GL))[1024 + tid];
        const bf16_t* gp = P + tokrow * NCP + C_GN + hd * 64;
        bf16_t* dst = (bf16_t*)(ws + WS_XB) + tokrow * DM + hd * 64;
        u32x2 gvv[8];
#pragma unroll
        for (int e = 0; e < 8; ++e) gvv[e] = *(const u32x2*)(gp + (e >> 2) * 32 + 8 * (e & 3) + 4 * hi);
#pragma unroll
        for (int d0 = 0; d0 < 2; ++d0)
#pragma unroll
            for (int q = 0; q < 4; ++q) { const int d = d0 * 32 + 8 * q + 4 * hi;
                const u32x2 gv = gvv[d0 * 4 + q];
                const float g0 = bflo(gv.x), g1 = bfhi(gv.x), g2 = bflo(gv.y), g3 = bfhi(gv.y);
                const float v0 = o[d0][4 * q] * sc + omix[(d0 * 16 + 4 * q) * 64], v1 = o[d0][4 * q + 1] * sc + omix[(d0 * 16 + 4 * q + 1) * 64];
                const float v2 = o[d0][4 * q + 2] * sc + omix[(d0 * 16 + 4 * q + 2) * 64], v3 = o[d0][4 * q + 3] * sc + omix[(d0 * 16 + 4 * q + 3) * 64];
                u32x2 pk; pk.x = pk2(v0 * g0 * sigmoidf_(g0), v1 * g1 * sigmoidf_(g1)); pk.y = pk2(v2 * g2 * sigmoidf_(g2), v3 * g3 * sigmoidf_(g3));
                *(u32x2*)(dst + d) = pk; }
    }
#undef NSA_LANE
    __syncthreads();
}

#define XB_TMO      128
#define XB_XCNT(j)  (256  + 64 * (j))
#define XB_XSUB(j)  (1280 + 64 * (j))
#define XB_XGEN(j)  (2304 + 64 * (j))
#define XB_TOP      3328
#define XB_TOPGEN   3392
#define XCD_BAR_WORDS 3456
#define XB_SPIN_CAP (1u << 18)

__device__ __forceinline__ unsigned xb_ld(unsigned* p)              { return __hip_atomic_load(p, __ATOMIC_RELAXED, __HIP_MEMORY_SCOPE_AGENT); }
__device__ __forceinline__ unsigned xb_add(unsigned* p, unsigned v) { return __hip_atomic_fetch_add(p, v, __ATOMIC_RELAXED, __HIP_MEMORY_SCOPE_AGENT); }
__device__ __forceinline__ unsigned xb_xcc_id() { return (unsigned)__builtin_amdgcn_s_getreg((3 << 11) | 20) & 0xFu; }
#define XB_SPIN(cond, bar) do { unsigned _sp = 0; while (cond) { __builtin_amdgcn_s_sleep(1); \
    if ((++_sp & 255u) == 0u) { if (xb_ld(&(bar)[XB_TMO])) break; if (_sp > XB_SPIN_CAP) { atomicAdd(&(bar)[XB_TMO], 1u); break; } } } } while (0)

struct XcdBarrier {
    unsigned* bar; unsigned x;
    volatile LAS unsigned* st;
};

__device__ __forceinline__ XcdBarrier xcd_barrier_post(unsigned* bar, volatile LAS unsigned* st, const int wv_) {
    XcdBarrier b; b.bar = bar; b.x = xb_xcc_id(); b.st = st;
    if (TIDX == 0) (void)xb_add(&bar[XB_XCNT(b.x)], 1u);
    return b;
}
__device__ __forceinline__ void xcd_barrier_complete(unsigned* bar, unsigned x, unsigned& nloc, unsigned& nx) {
    const unsigned G = gridDim.x * gridDim.y * gridDim.z;
    unsigned sum, cnt, mine, sp = 0u;
    for (;;) {
        sum = 0u; cnt = 0u; mine = 0u;
#pragma unroll
        for (unsigned j = 0; j < 16; ++j) { const unsigned c = xb_ld(&bar[XB_XCNT(j)]); sum += c; cnt += (c > 0u) ? 1u : 0u; mine = (j == x) ? c : mine; }
        if (sum == G) break;
        __builtin_amdgcn_s_sleep(1);
        if ((++sp & 255u) == 0u) { if (xb_ld(&bar[XB_TMO])) break; if (sp > XB_SPIN_CAP) { atomicAdd(&bar[XB_TMO], 1u); break; } }
    }
    nloc = mine > 0u ? mine : 1u; nx = cnt > 0u ? cnt : 1u;
}

__device__ __forceinline__ void xcd_barrier(const XcdBarrier& b, const int wv_) {
    asm volatile("s_waitcnt vmcnt(0)" ::: "memory");
    __syncthreads();
    if (TIDX == 0) {
        unsigned* bar = b.bar;
        __builtin_amdgcn_s_waitcnt(0);
        unsigned nloc = b.st[0], nx = b.st[1];
        if (nloc == 0u) { xcd_barrier_complete(bar, b.x, nloc, nx); b.st[0] = nloc; b.st[1] = nx; }
        const unsigned old = xb_add(&bar[XB_XSUB(b.x)], 1u);
        const unsigned gen = old / nloc;
        if (old + 1u == (gen + 1u) * nloc) {
            __builtin_amdgcn_fence(__ATOMIC_RELEASE, "agent");
            asm volatile("s_waitcnt vmcnt(0)" ::: "memory");
            const unsigned og = xb_add(&bar[XB_TOP], 1u);
            const unsigned tg = og / nx;
            if (og + 1u == (tg + 1u) * nx) xb_add(&bar[XB_TOPGEN], 1u);
            else XB_SPIN(xb_ld(&bar[XB_TOPGEN]) == tg, bar);
            __builtin_amdgcn_fence(__ATOMIC_ACQUIRE, "agent");
            xb_add(&bar[XB_XGEN(b.x)], 1u);
            asm volatile("s_waitcnt vmcnt(0)" ::: "memory");
        } else {
            XB_SPIN(xb_ld(&bar[XB_XGEN(b.x)]) == gen, bar);
            __builtin_amdgcn_fence(__ATOMIC_ACQUIRE, "agent");
            asm volatile("s_waitcnt vmcnt(0)" ::: "memory");
        }
    }
    __syncthreads();
}

#define REP_P0 1
#define REP_G1 1
#define REP_P2 1
#define REP_SB 1
#define REP_WIN 1
#define REP_CMP 1
#define REP_SLC 1
#define REP_G2 1
#define XSYNC 0
__global__ void __launch_bounds__(512, 2) hybrid_fwd(Args A) {
    extern __shared__ __attribute__((aligned(16))) unsigned char lds_raw[];
    LAS unsigned char* lds = (LAS unsigned char*)lds_raw;
    cg::grid_group grid = cg::this_grid();
    const int wv_ = __builtin_amdgcn_readfirstlane((int)threadIdx.x >> 6);
    volatile LAS unsigned* bst = (volatile LAS unsigned*)(lds + 131072 + 64);
    if (TIDX < 2) bst[TIDX] = 0u;
    __syncthreads();
    XcdBarrier xbar = xcd_barrier_post((unsigned*)(A.ws + WS_CTL), bst, wv_);
    if (A.ws == nullptr) grid.sync();
#define GSYNC() xcd_barrier(xbar, wv_)
    unsigned char* ws = A.ws;
    const int G = gridDim.x, bx = blockIdx.x;

    for (int rep = 0; rep < REP_P0; ++rep) phase0(A, lds, wv_);
    GSYNC();
    for (int rep = 0; rep < XSYNC; ++rep) GSYNC();
#pragma unroll 1
    for (int rep = 0; rep < REP_G1; ++rep) {
        pg8::Gemm g{(const pg8::bf16_t*)(ws + WS_XB), (const pg8::bf16_t*)(ws + WS_WIN), NTOK, NCP, DM}; pg8::StaticOrder S; S.init(NTOK, NCP, G, bx);
        pg8::EpiProj E{(pg8::bf16_t*)(ws + WS_P), NCP, (const float*)(ws + WS_RSTD)};
        pg8::gemm_phase<pg8::EpiProj, pg8::StaticOrder, true, true>(lds, g, S, E, wv_);
    }
    GSYNC();
    if (G != 256) {
        for (int it = bx; it < 128; it += G) compress_item(A, lds, it, wv_);
        phase2_normrope(A, wv_, bx * 8 + wv_, G * 8);
        GSYNC();
    }
    if (G == 256) {
        const int x = bx & 7, j = bx >> 3;
        if (j >= 16) compress_item(A, lds, ((j - 16) >> 3) * 64 + (x >> 1) * 16 + (x & 1) * 8 + (j & 7), wv_);
        else knorm_bg(A, wv_, x, j * 8 + wv_, 16 * 8);
        group_arrive((unsigned*)(ws + WS_CTL) + 3584 + 64 * x, wv_);
    }
    for (int rep = 0; rep < REP_SB; ++rep) for (int it = bx; it < 512; it += G) {
        int item = it;
        if (G == 256) { const int x = bx & 7, idx = (bx >> 3) * 2 + (it >> 8); item = (x * 4 + (idx >> 4)) * 16 + (idx & 15); }
        attn_item<M_SB>(A, lds, item, wv_);
    }
    if (G == 256) group_wait((unsigned*)(ws + WS_CTL) + 3584 + 64 * (bx & 7), 32u, wv_);
    for (int rep = 0; rep < REP_SLC; ++rep) for (int it = bx; it < 512; it += G) {
        int item;
        if (G == 256) { const int x = bx & 7, j = bx >> 3; item = x * 64 + ((it >> 8) ? 31 - j : 32 + j); }
        else { if (it < 256) item = (it >> 5) * 64 + 32 + (it & 31); else item = ((it - 256) >> 5) * 64 + 31 - ((it - 256) & 31); }
        nsa_item(A, lds, item, wv_);
    }
    GSYNC();
    for (int rep = 0; rep < REP_G2; ++rep) {
        pg8::Gemm g{(const pg8::bf16_t*)(ws + WS_XB), (const pg8::bf16_t*)(ws + WS_WOUT), NTOK, DM, DM}; pg8::StaticOrder S; S.init(NTOK, DM, G, bx);
        pg8::EpiOut E{A.in[0], A.out, DM};
        pg8::gemm_phase<pg8::EpiOut, pg8::StaticOrder, true, true>(lds, g, S, E, wv_);
    }
}

extern "C" void kernel_launch(void* const* d_in, const int* in_sizes, int n_in, void* d_out, int out_size, void* d_ws, size_t ws_size, hipStream_t stream) {
    static int grid = 0;
    if (grid == 0) {
        if (n_in != 16 || ws_size < WS_END) { fprintf(stderr, "kernel_launch: unexpected inputs (n_in %d, ws %zu)\n", n_in, ws_size); grid = -1; return; }
        int dev = 0, cus = 0, per_cu = 0;
        hipGetDevice(&dev);
        hipDeviceGetAttribute(&cus, hipDeviceAttributeMultiprocessorCount, dev);
        if (hipFuncSetAttribute((const void*)hybrid_fwd, hipFuncAttributeMaxDynamicSharedMemorySize, LDS_BYTES) != hipSuccess) { fprintf(stderr, "kernel_launch: hipFuncSetAttribute failed\n"); }
        hipOccupancyMaxActiveBlocksPerMultiprocessor(&per_cu, (const void*)hybrid_fwd, 512, LDS_BYTES);
        if (per_cu < 1) { fprintf(stderr, "kernel_launch: occupancy query says %d blocks/CU\n", per_cu); per_cu = 1; }
        (void)hipGetLastError();
        grid = cus * 1;
    }
    if (grid < 0) return;
    Args a{};
    for (int i = 0; i < 16; ++i) a.in[i] = (const float*)d_in[i];
    a.out = (float*)d_out; a.ws = (unsigned char*)d_ws;
    for (int i = 0; i < 8; ++i) a.invf[i] = std::pow(500000.0, -(double)(2 * i) / 16.0) / 6.283185307179586476925;
    if (hipMemsetAsync((char*)d_ws + WS_CTL, 0, 16384, stream) != hipSuccess) { fprintf(stderr, "kernel_launch: memset failed\n"); return; }
    void* args[] = {&a};
    hipError_t e = hipLaunchCooperativeKernel((const void*)hybrid_fwd, dim3(grid), dim3(512), args, LDS_BYTES, stream);
    if (e != hipSuccess) fprintf(stderr, "cooperative launch failed: %s (grid %d)\n", hipGetErrorString(e), grid);
}
```

```cpp
#include <hip/hip_runtime.h>
#include <hip/hip_cooperative_groups.h>
#include <cstdio>
#include <cstdint>
#include <cmath>
namespace cg = cooperative_groups;
__device__ __forceinline__ int lane_id_opaque_g() { int x; asm volatile("v_mbcnt_lo_u32_b32 %0, -1, 0\n\tv_mbcnt_hi_u32_b32 %0, -1, %0" : "=v"(x)); return x; }
#define TIDX_G ((wv_ << 6) + lane_id_opaque_g())
namespace pg8 {
#define PG8_LAS __attribute__((address_space(3)))
typedef unsigned short bf16_t;
typedef short bf16x8 __attribute__((ext_vector_type(8)));
typedef float f32x4 __attribute__((ext_vector_type(4)));
typedef unsigned u32x4 __attribute__((ext_vector_type(4)));
constexpr int BM = 256, BK = 64, HALF = 128, HTB = HALF * BK * 2  , STAGE_BYTES = 8 * HTB, NXCD = 8, WGM = 8;

__host__ __device__ __forceinline__ int lds_byte(int r, int c) { const int st = (r >> 4) * 2 + (c >> 5), rr = r & 15, cc = c & 31, ob = rr * 64 + cc * 2; return st * 1024 + (ob ^ (((ob >> 9) & 1) << 5)); }
__host__ __device__ __forceinline__ void stage_rc(int b, int& R, int& C) { const int st = b / 1024, sb = b % 1024, swz = sb ^ (((sb >> 9) & 1) << 5); R = (st >> 1) * 16 + swz / 64; C = (st & 1) * 32 + (swz % 64) / 2; }
__host__ __device__ __forceinline__ int perm32(int rho) { const int n = rho >> 4, i = rho & 15; return 8 * (i >> 2) + 4 * n + (i & 3); }

struct Unit { int pm, pn; };
struct Gemm { const bf16_t* A; const bf16_t* Bt; int M, N, K; };

struct StaticOrder {
    int nM, nN, nwg, G, c;
    __host__ __device__ void init(int M, int N, int G_, int c_) { nM = M / BM; nN = N / BM; nwg = nM * nN; G = G_; c = c_; }
    __host__ __device__ bool next(int i, Unit& u) const {
        const long L = (long)i * G + c; if (L >= nwg) return false;
        int wgid = (int)L; { const int q = nwg / NXCD, r = nwg % NXCD, xcd = wgid % NXCD, off = wgid / NXCD; wgid = (xcd < r ? xcd * (q + 1) : r * (q + 1) + (xcd - r) * q) + off; }
        const int nig = WGM * nN, gid = wgid / nig, fm = gid * WGM, gsz = (nM - fm) < WGM ? (nM - fm) : WGM;
        u.pm = fm + ((wgid % nig) % gsz); u.pn = (wgid % nig) / gsz; return true;
    }
    __device__ __forceinline__ void a_ready(const Unit&) const {}
    __device__ __forceinline__ void done(const Unit&) const {}
};

__device__ __forceinline__ unsigned cvt_pk_bf16(float lo, float hi) { unsigned r; asm volatile("v_cvt_pk_bf16_f32 %0, %1, %2" : "=v"(r) : "v"(lo), "v"(hi)); return r; }
struct EpiProj {
    static constexpr bool PERM = true, AFTER_DRAIN = false;
    bf16_t* O; int ldc; const float* rstd;
    __device__ __forceinline__ void operator()(const f32x4 (&acc)[2][2][4][2], const Unit& u, int wr, int wc, int fr, int fq) const {
        const int row0 = u.pm * BM + wr * 64 + fr; const int col0 = u.pn * BM + wc * 32 + 8 * fq;
        float sc[2][4];
#pragma unroll
        for (int ai = 0; ai < 2; ++ai)
#pragma unroll
            for (int m = 0; m < 4; ++m) sc[ai][m] = rstd[row0 + ai * HALF + m * 16];
#pragma unroll
        for (int ai = 0; ai < 2; ++ai)
#pragma unroll
            for (int m = 0; m < 4; ++m) { const int row = row0 + ai * HALF + m * 16; const float s = sc[ai][m]; bf16_t* rowp = O + (size_t)row * ldc + col0;
#pragma unroll
                for (int bj = 0; bj < 2; ++bj) { f32x4 v0 = acc[ai][bj][m][0] * s, v1 = acc[ai][bj][m][1] * s;
                    u32x4 w; w.x = cvt_pk_bf16(v0[0], v0[1]); w.y = cvt_pk_bf16(v0[2], v0[3]); w.z = cvt_pk_bf16(v1[0], v1[1]); w.w = cvt_pk_bf16(v1[2], v1[3]);
                    *(u32x4*)(rowp + bj * HALF) = w; } }
    }
};
struct EpiOut {
    static constexpr bool PERM = true, AFTER_DRAIN = false;
    const float* X; float* O; int ldc;
    __device__ __forceinline__ void operator()(const f32x4 (&acc)[2][2][4][2], const Unit& u, int wr, int wc, int fr, int fq) const {
        const int row0 = u.pm * BM + wr * 64 + fr; const int col0 = u.pn * BM + wc * 32 + 8 * fq;
#pragma unroll
        for (int ai = 0; ai < 2; ++ai) {
            f32x4 xa[4][2][2];
#pragma unroll
            for (int m = 0; m < 4; ++m)
#pragma unroll
                for (int bj = 0; bj < 2; ++bj) { const size_t off = (size_t)(row0 + ai * HALF + m * 16) * ldc + col0 + bj * HALF;
                    xa[m][bj][0] = *(const f32x4*)(X + off); xa[m][bj][1] = *(const f32x4*)(X + off + 4); }
#pragma unroll
            for (int m = 0; m < 4; ++m)
#pragma unroll
                for (int bj = 0; bj < 2; ++bj) { const size_t off = (size_t)(row0 + ai * HALF + m * 16) * ldc + col0 + bj * HALF;
                    *(f32x4*)(O + off) = xa[m][bj][0] + acc[ai][bj][m][0]; *(f32x4*)(O + off + 4) = xa[m][bj][1] + acc[ai][bj][m][1]; }
        }
    }
};
template <class Epi, class Sched, bool ALIGN_EPI = false, bool SP2 = false>
__device__ __forceinline__ void gemm_phase(PG8_LAS unsigned char* lds, const Gemm g, const Sched& S, const Epi& E, const int wv_) {
    int tid_l = TIDX_G; asm volatile("" : "+v"(tid_l));
    const int tid = tid_l, wid = __builtin_amdgcn_readfirstlane(tid >> 6), lane = tid & 63, wr = wid >> 2, wc = wid & 3, fr = lane & 15, fq = lane >> 4;
    const int K = g.K, nt = K / BK;
    unsigned voffA[2], voffB[2];
#pragma unroll
    for (int i = 0; i < 2; ++i) { int R, C; stage_rc(tid * 16 + i * 8192, R, C); const int Rb = Epi::PERM ? ((R & ~31) + perm32(R & 31)) : R;
        voffA[i] = (unsigned)(R * K + C) * 2u; voffB[i] = (unsigned)(Rb * K + C) * 2u; }
    const size_t kstep = (size_t)(BK * 2);
    const size_t hstep = (size_t)HALF * K * 2;
    const size_t tstep = 2 * hstep;
    const unsigned ldsw = (unsigned)wid * 1024u;
    const int aoff = lds_byte(wr * 64 + fr, fq * 8), boff = lds_byte(wc * 32 + fr, fq * 8);
#define PG8_SA(b, h) (((b) * 2 + (h)) * HTB)
#define PG8_SB(b, h) ((4 + (b) * 2 + (h)) * HTB)
#define PG8_STAGE(bufoff, gbase, voff) do { _Pragma("unroll") for (int _i = 0; _i < 2; ++_i) \
        __builtin_amdgcn_global_load_lds((const unsigned*)((const char*)(gbase) + (voff)[_i]), (PG8_LAS unsigned*)(lds + (bufoff) + ldsw + _i * 8192), 16, 0, 0); } while (0)
#define PG8_LDA(dst, b, h) do { _Pragma("unroll") for (int m = 0; m < 4; ++m) _Pragma("unroll") for (int k = 0; k < 2; ++k) dst[m][k] = *(const PG8_LAS bf16x8*)(lds + PG8_SA(b, h) + aoff + m * 2048 + k * 1024); } while (0)
#define PG8_LDB(dst, b, h) do { _Pragma("unroll") for (int n = 0; n < 2; ++n) _Pragma("unroll") for (int k = 0; k < 2; ++k) dst[n][k] = *(const PG8_LAS bf16x8*)(lds + PG8_SB(b, h) + boff + n * 2048 + k * 1024); } while (0)
#define PG8_MMA(ai, bj, At, Bt) do { __builtin_amdgcn_s_setprio(1); _Pragma("unroll") for (int m = 0; m < 4; ++m) _Pragma("unroll") for (int n = 0; n < 2; ++n) _Pragma("unroll") for (int k = 0; k < 2; ++k) \
        acc[ai][bj][m][n] = __builtin_amdgcn_mfma_f32_16x16x32_bf16(Bt[n][k], At[m][k], acc[ai][bj][m][n], 0, 0, 0); __builtin_amdgcn_s_setprio(0); } while (0)
#define PG8_WAIT_V(n) asm volatile("s_waitcnt vmcnt(" #n ")" ::: "memory")
#define PG8_WAIT_L(n) asm volatile("s_waitcnt lgkmcnt(" #n ")" ::: "memory")
#define PG8_BAR __builtin_amdgcn_s_barrier()
#define PG8_SCHED __builtin_amdgcn_sched_barrier(0)
    Unit cur, nxt; int ui = 0;
    if (!S.next(0, cur)) return;
    f32x4 acc[2][2][4][2];
#pragma unroll
    for (int a = 0; a < 2; ++a)
#pragma unroll
        for (int b = 0; b < 2; ++b)
#pragma unroll
            for (int m = 0; m < 4; ++m)
#pragma unroll
                for (int n = 0; n < 2; ++n) acc[a][b][m][n] = (f32x4){0.f, 0.f, 0.f, 0.f};
    bf16x8 At[4][2], B0[2][2], B1[2][2];
    const char* cA = (const char*)g.A + (size_t)cur.pm * tstep; const char* cB = (const char*)g.Bt + (size_t)cur.pn * tstep;
    S.a_ready(cur);
    if constexpr (SP2) {
        PG8_STAGE(PG8_SB(0, 0), cB, voffB); PG8_STAGE(PG8_SB(0, 1), cB + hstep, voffB); PG8_STAGE(PG8_SA(0, 0), cA, voffA); PG8_STAGE(PG8_SA(0, 1), cA + hstep, voffA);
        if (wr == 1) PG8_BAR;
        PG8_WAIT_V(2); PG8_BAR;
        PG8_STAGE(PG8_SB(1, 0), cB + kstep, voffB); PG8_STAGE(PG8_SA(1, 0), cA + kstep, voffA); PG8_STAGE(PG8_SB(1, 1), cB + hstep + kstep, voffB);
        PG8_WAIT_V(6); PG8_BAR;
    } else {
        PG8_STAGE(PG8_SB(0, 0), cB, voffB); PG8_STAGE(PG8_SA(0, 0), cA, voffA); PG8_STAGE(PG8_SB(0, 1), cB + hstep, voffB); PG8_STAGE(PG8_SA(0, 1), cA + hstep, voffA);
        if (wr == 1) PG8_BAR;
        PG8_WAIT_V(4); PG8_BAR;
        PG8_STAGE(PG8_SB(1, 0), cB + kstep, voffB); PG8_STAGE(PG8_SA(1, 0), cA + kstep, voffA); PG8_STAGE(PG8_SB(1, 1), cB + hstep + kstep, voffB);
        PG8_WAIT_V(6); PG8_BAR;
    }
    for (;;) {
        const bool has_next = S.next(ui + 1, nxt);
        const char* nA = has_next ? (const char*)g.A + (size_t)nxt.pm * tstep : cA; const char* nB = has_next ? (const char*)g.Bt + (size_t)nxt.pn * tstep : cB;
        for (int t = 0; t < nt; t += 2) {
            const bool last = (t == nt - 2);
            const char* a1 = cA + (size_t)(t + 1) * kstep;
            const char* a2 = last ? nA : cA + (size_t)(t + 2) * kstep; const char* b2 = last ? nB : cB + (size_t)(t + 2) * kstep;
            const char* a3 = a2 + kstep; const char* b3 = b2 + kstep;
            if (last && has_next) S.a_ready(nxt);
            if constexpr (SP2) {
            PG8_LDB(B0, 0, 0); PG8_LDB(B1, 0, 1); PG8_SCHED; PG8_LDA(At, 0, 0); PG8_STAGE(PG8_SA(1, 1), a1 + hstep, voffA);
            PG8_WAIT_V(8); PG8_WAIT_L(0); PG8_BAR; PG8_MMA(0, 0, At, B0); PG8_MMA(0, 1, At, B1); PG8_BAR; PG8_SCHED;
            PG8_LDA(At, 0, 1); PG8_STAGE(PG8_SB(0, 0), b2, voffB); PG8_STAGE(PG8_SB(0, 1), b2 + hstep, voffB); PG8_STAGE(PG8_SA(0, 0), a2, voffA);
            PG8_WAIT_V(8); PG8_WAIT_L(0); PG8_BAR; PG8_MMA(1, 0, At, B0); PG8_MMA(1, 1, At, B1); PG8_BAR; PG8_SCHED;
            PG8_LDB(B0, 1, 0); PG8_LDB(B1, 1, 1); PG8_SCHED; PG8_LDA(At, 1, 0); PG8_STAGE(PG8_SA(0, 1), a2 + hstep, voffA);
            PG8_WAIT_V(8); PG8_WAIT_L(0); PG8_BAR; PG8_MMA(0, 0, At, B0); PG8_MMA(0, 1, At, B1); PG8_BAR; PG8_SCHED;
            PG8_LDA(At, 1, 1); PG8_STAGE(PG8_SB(1, 0), b3, voffB); PG8_STAGE(PG8_SB(1, 1), b3 + hstep, voffB); PG8_STAGE(PG8_SA(1, 0), a3, voffA);
            PG8_WAIT_V(8); PG8_WAIT_L(0); PG8_BAR; PG8_MMA(1, 0, At, B0); PG8_MMA(1, 1, At, B1); PG8_BAR; PG8_SCHED;
            } else {
            PG8_LDB(B0, 0, 0); PG8_SCHED; PG8_LDA(At, 0, 0); PG8_STAGE(PG8_SA(1, 1), a1 + hstep, voffA);
            PG8_WAIT_L(8); PG8_BAR; PG8_WAIT_L(0); PG8_MMA(0, 0, At, B0); PG8_BAR; PG8_SCHED;
            PG8_LDB(B1, 0, 1); PG8_STAGE(PG8_SB(0, 0), b2, voffB);
            PG8_BAR; PG8_WAIT_L(0); PG8_MMA(0, 1, At, B1); PG8_BAR;
            PG8_LDA(At, 0, 1); PG8_STAGE(PG8_SA(0, 0), a2, voffA);
            PG8_BAR; PG8_WAIT_L(0); PG8_MMA(1, 0, At, B0); PG8_BAR; PG8_SCHED;
            PG8_STAGE(PG8_SB(0, 1), b2 + hstep, voffB);
            PG8_WAIT_V(6); PG8_BAR; PG8_MMA(1, 1, At, B1); PG8_BAR;
            PG8_LDB(B0, 1, 0); PG8_SCHED; PG8_LDA(At, 1, 0); PG8_STAGE(PG8_SA(0, 1), a2 + hstep, voffA);
            PG8_WAIT_L(8); PG8_BAR; PG8_WAIT_L(0); PG8_MMA(0, 0, At, B0); PG8_BAR; PG8_SCHED;
            PG8_LDB(B1, 1, 1); PG8_STAGE(PG8_SB(1, 0), b3, voffB);
            PG8_BAR; PG8_WAIT_L(0); PG8_MMA(0, 1, At, B1); PG8_BAR;
            PG8_LDA(At, 1, 1); PG8_STAGE(PG8_SA(1, 0), a3, voffA);
            PG8_BAR; PG8_WAIT_L(0); PG8_MMA(1, 0, At, B0); PG8_BAR; PG8_SCHED;
            PG8_STAGE(PG8_SB(1, 1), b3 + hstep, voffB);
            PG8_WAIT_V(6); PG8_BAR; PG8_MMA(1, 1, At, B1); PG8_BAR;
            }
        }
        if constexpr (ALIGN_EPI) { if (wr == 0) PG8_BAR; }
        if constexpr (!Epi::AFTER_DRAIN) { E(acc, cur, wr, wc, fr, fq); S.done(cur); }
        if (!has_next) break;
#pragma unroll
        for (int a = 0; a < 2; ++a)
#pragma unroll
            for (int b = 0; b < 2; ++b)
#pragma unroll
                for (int m = 0; m < 4; ++m)
#pragma unroll
                    for (int n = 0; n < 2; ++n) acc[a][b][m][n] = (f32x4){0.f, 0.f, 0.f, 0.f};
        cur = nxt; cA = nA; cB = nB; ++ui;
        if constexpr (ALIGN_EPI) { if (wr == 1) PG8_BAR; }
    }
    PG8_WAIT_V(0);
    if constexpr (!ALIGN_EPI) { if (wr == 0) PG8_BAR; }
    PG8_BAR;
    if constexpr (Epi::AFTER_DRAIN) { E.fused(acc, cur, wr, wc, fr, fq, lds, wid, lane); S.done(cur); }
#undef PG8_SA
#undef PG8_SB
#undef PG8_STAGE
#undef PG8_LDA
#undef PG8_LDB
#undef PG8_MMA
#undef PG8_WAIT_V
#undef PG8_WAIT_L
#undef PG8_BAR
#undef PG8_SCHED
}
}

#define LAS __attribute__((address_space(3)))
typedef unsigned short bf16_t;
typedef short bf16x8 __attribute__((ext_vector_type(8)));
typedef short s16x4 __attribute__((ext_vector_type(4)));
typedef float f32x4 __attribute__((ext_vector_type(4)));
typedef float f32x16 __attribute__((ext_vector_type(16)));
typedef unsigned u32x4 __attribute__((ext_vector_type(4)));
typedef unsigned u32x2 __attribute__((ext_vector_type(2)));

constexpr int NB = 4, SEQ = 4096, NTOK = NB * SEQ, DM = 1024, NCP = 4096, NCOLS = 3864;
constexpr int C_QN = 0, C_KC = 512, C_VC = 640, C_KS = 768, C_VS = 896, C_KW = 1024, C_VW = 1152, C_GN = 1280, C_QSB = 1792, C_KSB = 2304, C_VSB = 2816, C_GSB = 3328, C_GL = 3840;
constexpr size_t MiB = 1u << 20;
constexpr size_t WS_WIN = 0, WS_WOUT = 8 * MiB, WS_W1T = 10 * MiB, WS_RSTD = 11 * MiB, WS_ROPE = 11 * MiB + 64 * 1024, WS_CBIAS = 11 * MiB + 384 * 1024, WS_MB = 11 * MiB + 400 * 1024;
constexpr size_t WS_KCMP = 12 * MiB, WS_VCMP = 12 * MiB + 512 * 1024, WS_SEL = 13 * MiB, WS_CTL = 14 * MiB, WS_XB = 16 * MiB, WS_P = 48 * MiB, WS_QN = 176 * MiB, WS_KSN = 192 * MiB, WS_KWN = 196 * MiB, WS_OC = 200 * MiB, WS_OW = 216 * MiB, WS_END = 232 * MiB;
constexpr int LDS_BYTES = 135168;
constexpr float C2 = 0.125f * 1.4426950408889634f;
constexpr float EPSN = 1e-6f;

struct Args { const float* in[16]; float* out; unsigned char* ws; double invf[8]; };

__device__ __forceinline__ unsigned pk2(float lo, float hi) {
    typedef float f2_t __attribute__((ext_vector_type(2))); typedef __bf16 b2_t __attribute__((ext_vector_type(2)));
    f2_t v = {lo, hi}; b2_t b = __builtin_convertvector(v, b2_t); return __builtin_bit_cast(unsigned, b); }
__device__ __forceinline__ float bflo(unsigned u) { return __uint_as_float(u << 16); }
__device__ __forceinline__ float bfhi(unsigned u) { return __uint_as_float(u & 0xffff0000u); }
__device__ __forceinline__ float bf1(bf16_t h) { return __uint_as_float(((unsigned)h) << 16); }
__device__ __forceinline__ float ex2(float x) { return __builtin_amdgcn_exp2f(x); }
__device__ __forceinline__ float lg2(float x) { return __builtin_amdgcn_logf(x); }
__device__ __forceinline__ float sigmoidf_(float x) { return 1.f / (1.f + __expf(-x)); }
__device__ __forceinline__ float wave_sum(float v) {
#pragma unroll
    for (int o = 1; o < 64; o <<= 1) v += __shfl_xor(v, o);
    return v;
}
__device__ __forceinline__ float wave_max(float v) {
#pragma unroll
    for (int o = 1; o < 64; o <<= 1) v = fmaxf(v, __shfl_xor(v, o));
    return v;
}
#define LDS_WAIT() asm volatile("s_waitcnt lgkmcnt(0)" ::: "memory")
__device__ __forceinline__ int lane_id_opaque() { int x; asm volatile("v_mbcnt_lo_u32_b32 %0, -1, 0\n\tv_mbcnt_hi_u32_b32 %0, -1, %0" : "=v"(x)); return x; }
#define TIDX ((wv_ << 6) + lane_id_opaque())
#define MFMA32(a, b, c) __builtin_amdgcn_mfma_f32_32x32x16_bf16((a), (b), (c), 0, 0, 0)

template <int MODE>
__device__ __forceinline__ void transpose_item(const float* W, int ldw, const float* gain, bf16_t* WT, int Kd, LAS float* scr, int kb, int nb, int lane) {
    const int k0 = 64 * kb, n0 = 32 * nb, n = n0 + (lane & 31);
    int sc = n; bool ok = true;
    if (MODE == 0) { if (n < 1280) sc = n; else if (n < 3840) sc = n + 24; else if (n < NCOLS) sc = n - 3840 + 1280; else { sc = 0; ok = false; } }
    float tv[32];
#pragma unroll
    for (int i = 0; i < 32; ++i) { const int kk = 2 * i + (lane >> 5); tv[i] = ok ? W[(size_t)(k0 + kk) * ldw + sc] : 0.f; }
#pragma unroll
    for (int i = 0; i < 32; ++i) { const int kk = 2 * i + (lane >> 5); float v = tv[i]; if (MODE == 0) v *= gain[k0 + kk]; scr[kk * 33 + (lane & 31)] = v; }
    LDS_WAIT();
    const int c = lane & 7;
#pragma unroll
    for (int j = 0; j < 4; ++j) { const int nn = (lane >> 3) + 8 * j; const LAS float* s = scr + (8 * c) * 33 + nn;
        u32x4 o; o.x = pk2(s[0 * 33], s[1 * 33]); o.y = pk2(s[2 * 33], s[3 * 33]); o.z = pk2(s[4 * 33], s[5 * 33]); o.w = pk2(s[6 * 33], s[7 * 33]);
        *(u32x4*)(WT + (size_t)(n0 + nn) * Kd + k0 + 8 * c) = o; }
    LDS_WAIT();
}

__device__ __forceinline__ void phase0(const Args& A, LAS unsigned char* lds, const int wv_) {
    const int tid = TIDX, lane = tid & 63, wave = __builtin_amdgcn_readfirstlane(tid >> 6);
    const int gw = blockIdx.x * 8 + wave, NGW = gridDim.x * 8;
    unsigned char* ws = A.ws;
    LAS float* scr = (LAS float*)(lds + wave * 8704);
    bf16_t* WinT = (bf16_t*)(ws + WS_WIN); bf16_t* WoutT = (bf16_t*)(ws + WS_WOUT); bf16_t* W1T = (bf16_t*)(ws + WS_W1T);
    constexpr int I_IN = 16 * 128, I_OUT = 16 * 32, I_W1 = 32 * 2;
    for (int it = gw; it < I_IN + I_OUT + 2 * I_W1; it += NGW) {
        int r = it;
        if (r < I_IN) { transpose_item<0>(A.in[2], NCOLS, A.in[1], WinT, DM, scr, r / 128, r % 128, lane); continue; } r -= I_IN;
        if (r < I_OUT) { transpose_item<1>(A.in[15], DM, nullptr, WoutT, DM, scr, r / 32, r % 32, lane); continue; } r -= I_OUT;
        if (r < I_W1) { transpose_item<1>(A.in[8], 64, nullptr, W1T, 2048, scr, r / 2, r % 2, lane); continue; } r -= I_W1;
        transpose_item<1>(A.in[12], 64, nullptr, W1T + 64 * 2048, 2048, scr, r / 2, r % 2, lane);
    }
    const float* x = A.in[0]; bf16_t* xb = (bf16_t*)(ws + WS_XB); float* rstd = (float*)(ws + WS_RSTD);
    for (int m0 = gw; m0 < NTOK; m0 += 2 * NGW) {
        f32x4 v[2][4];
#pragma unroll
        for (int u = 0; u < 2; ++u) { const int m = m0 + u * NGW; const f32x4* xr = (const f32x4*)(x + (size_t)m * DM) + lane;
#pragma unroll
            for (int j = 0; j < 4; ++j) v[u][j] = xr[64 * j]; }
#pragma unroll
        for (int u = 0; u < 2; ++u) { const int m = m0 + u * NGW; float s = 0.f;
#pragma unroll
            for (int j = 0; j < 4; ++j) s += (v[u][j].x * v[u][j].x + v[u][j].y * v[u][j].y) + (v[u][j].z * v[u][j].z + v[u][j].w * v[u][j].w);
            s = wave_sum(s);
            if (lane == 0) rstd[m] = 1.f / sqrtf(s * (1.f / DM) + EPSN);
            unsigned long long* o8 = (unsigned long long*)(xb + (size_t)m * DM) + lane;
#pragma unroll
            for (int j = 0; j < 4; ++j) o8[64 * j] = (unsigned long long)pk2(v[u][j].x, v[u][j].y) | ((unsigned long long)pk2(v[u][j].z, v[u][j].w) << 32); }
    }
    float* cbias = (float*)(ws + WS_CBIAS);
    for (int it = NGW - 1 - gw; it < 128; it += NGW) {
        const int kv = it >> 6, n = it & 63;
        const float* pos = A.in[kv ? 11 : 7]; const float* w1 = A.in[kv ? 12 : 8]; const float* b1 = A.in[kv ? 13 : 9];
        float pv_[32], wv_l[32];
#pragma unroll
        for (int i = 0; i < 32; ++i) { const int k = lane + 64 * i; pv_[i] = pos[k]; wv_l[i] = w1[(size_t)k * 64 + n]; }
        float s = 0.f;
#pragma unroll
        for (int i = 0; i < 32; ++i) s += pv_[i] * wv_l[i];
        s = wave_sum(s);
        if (lane == 0) cbias[it] = s + b1[n];
    }
    float2* rope = (float2*)(ws + WS_ROPE);
    for (int e = (gridDim.x - 1 - blockIdx.x) * 512 + tid; e < SEQ * 8; e += gridDim.x * 512) {
        const int pos = e >> 3, i = e & 7;
        double rev = (double)pos * A.invf[i];
        rev -= floor(rev);
        const float rf = (float)rev;
        rope[e] = make_float2(__builtin_amdgcn_cosf(rf), __builtin_amdgcn_sinf(rf));
    }
    if (blockIdx.x == gridDim.x - 1 && wave == 7) {
        const float gq = wave_max(fabsf(A.in[3][lane]));
        const float gc = wave_max(fabsf(A.in[4][lane])), gs = wave_max(fabsf(A.in[5][lane])), gwn = wave_max(fabsf(A.in[6][lane]));
        float* mb = (float*)(ws + WS_MB);
        if (lane == 0) { mb[0] = 8.f * gq * gc * 1.4426950408889634f * 1.02f; mb[1] = 8.f * gq * gs * 1.4426950408889634f * 1.02f; mb[2] = 8.f * gq * gwn * 1.4426950408889634f * 1.02f; }
    }
}

__device__ __forceinline__ void phase2_normrope(const Args& A, const int wv_, const int gw0, const int ngw) {
    const int tid = TIDX, lane = tid & 63;
    unsigned char* ws = A.ws;
    const bf16_t* __restrict__ P = (const bf16_t*)(ws + WS_P);
    bf16_t* __restrict__ ksn = (bf16_t*)(ws + WS_KSN); bf16_t* __restrict__ kwn = (bf16_t*)(ws + WS_KWN);
    const float2* __restrict__ rope = (const float2*)(ws + WS_ROPE);
    const int sub = lane & 7;
#pragma unroll 4
    for (int vb = gw0 * 8; vb < NTOK * 4; vb += ngw * 8) {
        const int v = vb + (lane >> 3);
        const int t = v >> 2, which = v & 3;
        int scol; const float* gain; bf16_t* dst;
        if (which < 2) { scol = C_KS + which * 64; gain = A.in[5]; dst = ksn + (size_t)t * 128 + which * 64; }
        else { scol = C_KW + (which - 2) * 64; gain = A.in[6]; dst = kwn + (size_t)t * 128 + (which - 2) * 64; }
        const u32x4 raw = *(const u32x4*)(P + (size_t)t * NCP + scol + sub * 8);
        float y[8];
        y[0] = bflo(raw.x); y[1] = bfhi(raw.x); y[2] = bflo(raw.y); y[3] = bfhi(raw.y); y[4] = bflo(raw.z); y[5] = bfhi(raw.z); y[6] = bflo(raw.w); y[7] = bfhi(raw.w);
        float ss = 0.f;
#pragma unroll
        for (int i = 0; i < 8; ++i) ss += y[i] * y[i];
        ss += __shfl_xor(ss, 1); ss += __shfl_xor(ss, 2); ss += __shfl_xor(ss, 4);
        const float r = 1.f / sqrtf(ss * (1.f / 64.f) + EPSN);
        const f32x4 g0 = *(const f32x4*)(gain + sub * 8), g1 = *(const f32x4*)(gain + sub * 8 + 4);
        y[0] *= r * g0.x; y[1] *= r * g0.y; y[2] *= r * g0.z; y[3] *= r * g0.w; y[4] *= r * g1.x; y[5] *= r * g1.y; y[6] *= r * g1.z; y[7] *= r * g1.w;
        const int pos = t & (SEQ - 1);
#pragma unroll
        for (int i = 0; i < 8; ++i) {
            const float oth = __shfl_xor(y[i], 1);
            const float2 cs = rope[pos * 8 + i];
            if (sub == 0) y[i] = y[i] * cs.x - oth * cs.y;
            else if (sub == 1) y[i] = y[i] * cs.x + oth * cs.y;
        }
        u32x4 o; o.x = pk2(y[0], y[1]); o.y = pk2(y[2], y[3]); o.z = pk2(y[4], y[5]); o.w = pk2(y[6], y[7]);
        *(u32x4*)(dst + sub * 8) = o;
    }
}

__device__ __forceinline__ void knorm_bg(const Args& A, const int wv_, const int bg, const int gw0, const int ngw) {
    const int tid = TIDX, lane = tid & 63;
    unsigned char* ws = A.ws;
    const bf16_t* __restrict__ P = (const bf16_t*)(ws + WS_P);
    bf16_t* __restrict__ ksn = (bf16_t*)(ws + WS_KSN); bf16_t* __restrict__ kwn = (bf16_t*)(ws + WS_KWN);
    const float2* __restrict__ rope = (const float2*)(ws + WS_ROPE);
    const int sub = lane & 7, b = bg >> 1, g = bg & 1;
#pragma unroll 4
    for (int ub = gw0 * 8; ub < SEQ * 2; ub += ngw * 8) {
        const int u = ub + (lane >> 3);
        const int t = b * SEQ + (u >> 1), win = u & 1;
        const int scol = (win ? C_KW : C_KS) + g * 64; const float* gain = A.in[win ? 6 : 5]; bf16_t* dst = (win ? kwn : ksn) + (size_t)t * 128 + g * 64;
        const u32x4 raw = *(const u32x4*)(P + (size_t)t * NCP + scol + sub * 8);
        float y[8];
        y[0] = bflo(raw.x); y[1] = bfhi(raw.x); y[2] = bflo(raw.y); y[3] = bfhi(raw.y); y[4] = bflo(raw.z); y[5] = bfhi(raw.z); y[6] = bflo(raw.w); y[7] = bfhi(raw.w);
        float ss = 0.f;
#pragma unroll
        for (int i = 0; i < 8; ++i) ss += y[i] * y[i];
        ss += __shfl_xor(ss, 1); ss += __shfl_xor(ss, 2); ss += __shfl_xor(ss, 4);
        const float r = 1.f / sqrtf(ss * (1.f / 64.f) + EPSN);
        const f32x4 g0 = *(const f32x4*)(gain + sub * 8), g1 = *(const f32x4*)(gain + sub * 8 + 4);
        y[0] *= r * g0.x; y[1] *= r * g0.y; y[2] *= r * g0.z; y[3] *= r * g0.w; y[4] *= r * g1.x; y[5] *= r * g1.y; y[6] *= r * g1.z; y[7] *= r * g1.w;
        const int pos = t & (SEQ - 1);
#pragma unroll
        for (int i = 0; i < 8; ++i) {
            const float oth = __shfl_xor(y[i], 1);
            const float2 cs = rope[pos * 8 + i];
            if (sub == 0) y[i] = y[i] * cs.x - oth * cs.y;
            else if (sub == 1) y[i] = y[i] * cs.x + oth * cs.y;
        }
        u32x4 o; o.x = pk2(y[0], y[1]); o.y = pk2(y[2], y[3]); o.z = pk2(y[4], y[5]); o.w = pk2(y[6], y[7]);
        *(u32x4*)(dst + sub * 8) = o;
    }
}
__device__ __forceinline__ void group_arrive(unsigned* ctr, const int wv_) {
    asm volatile("s_waitcnt vmcnt(0)" ::: "memory");
    __syncthreads();
    if (TIDX == 0) {
        __builtin_amdgcn_fence(__ATOMIC_RELEASE, "agent");
        asm volatile("s_waitcnt vmcnt(0)" ::: "memory");
        __hip_atomic_fetch_add(ctr, 1u, __ATOMIC_RELAXED, __HIP_MEMORY_SCOPE_AGENT);
    }
}
__device__ __forceinline__ void group_wait(unsigned* ctr, const unsigned n, const int wv_) {
    if (TIDX == 0) {
        unsigned sp = 0;
        while (__hip_atomic_load(ctr, __ATOMIC_RELAXED, __HIP_MEMORY_SCOPE_AGENT) < n) { __builtin_amdgcn_s_sleep(1); if (++sp > (1u << 22)) break; }
        __builtin_amdgcn_fence(__ATOMIC_ACQUIRE, "agent");
        asm volatile("s_waitcnt vmcnt(0)" ::: "memory");
    }
    __syncthreads();
}

__device__ __forceinline__ void compress_item(const Args& A, LAS unsigned char* lds, int item, const int wv_) {
    const int tid = TIDX, lane = tid & 63, r32 = lane & 31, hi = lane >> 5, wave = __builtin_amdgcn_readfirstlane(tid >> 6);
    unsigned char* ws = A.ws;
    const int kv = item >> 6, b = (item >> 4) & 3, g = (item >> 3) & 1, nt = item & 7, n0 = 32 * nt;
    const bf16_t* P = (const bf16_t*)(ws + WS_P);
    const bf16_t* W1T = (const bf16_t*)(ws + WS_W1T) + (size_t)kv * 64 * 2048;
    const int col = (kv ? C_VC : C_KC) + g * 64;
    const int n = n0 + r32; const bool nok = n <= 254;
    f32x16 acc0 = {}, acc1 = {};
#pragma unroll 8
    for (int ks = 0; ks < 16; ++ks) {
        const int kk = 256 * wave + 16 * ks + 8 * hi;
        const int tok = 16 * n + (kk >> 6), d = kk & 63;
        bf16x8 a = {};
        if (nok) a = *(const bf16x8*)(P + (size_t)(b * SEQ + tok) * NCP + col + d);
        const bf16x8 b0 = *(const bf16x8*)(W1T + (size_t)r32 * 2048 + kk);
        const bf16x8 b1 = *(const bf16x8*)(W1T + (size_t)(32 + r32) * 2048 + kk);
        acc0 = MFMA32(a, b0, acc0); acc1 = MFMA32(a, b1, acc1);
    }
    LAS float* red = (LAS float*)lds;
    LAS float* hid = (LAS float*)(lds + 65536);
#pragma unroll
    for (int i = 0; i < 16; ++i) { const int row = (i & 3) + 8 * (i >> 2) + 4 * hi; red[(wave * 32 + row) * 64 + r32] = acc0[i]; red[(wave * 32 + row) * 64 + 32 + r32] = acc1[i]; }
    __syncthreads();
    const float* cbias = (const float*)(ws + WS_CBIAS) + kv * 64;
#pragma unroll
    for (int j = 0; j < 4; ++j) { const int e = tid + 512 * j, c = e & 63; float s = cbias[c];
#pragma unroll
        for (int w = 0; w < 8; ++w) s += red[w * 2048 + e];
        hid[e] = s * sigmoidf_(s); }
    __syncthreads();
    const float* w2 = A.in[kv ? 14 : 10];
    const int row = tid >> 4, c4 = (tid & 15) * 4;
    f32x4 o = {0.f, 0.f, 0.f, 0.f};
    for (int j = 0; j < 64; ++j) { const float hv = hid[row * 64 + j]; const f32x4 wv = *(const f32x4*)(w2 + j * 64 + c4); o += wv * hv; }
    const int nn = n0 + row;
    bf16_t* dst = (bf16_t*)(ws + (kv ? WS_VCMP : WS_KCMP)) + ((size_t)((b * 2 + g) * 256 + nn)) * 64 + c4;
    if (kv == 0) {
        float ss = o.x * o.x + o.y * o.y + o.z * o.z + o.w * o.w;
        ss += __shfl_xor(ss, 1); ss += __shfl_xor(ss, 2); ss += __shfl_xor(ss, 4); ss += __shfl_xor(ss, 8);
        const float r = 1.f / sqrtf(ss * (1.f / 64.f) + EPSN);
        const f32x4 gn = *(const f32x4*)(A.in[4] + c4);
        o = o * r * gn;
        const int pos = 16 * nn + 31;
        const f32x4 oth = {__shfl_xor(o.x, 2), __shfl_xor(o.y, 2), __shfl_xor(o.z, 2), __shfl_xor(o.w, 2)};
        const int cc = tid & 15;
        if (cc < 4 && nn <= 254) {
            const float2* rope = (const float2*)(ws + WS_ROPE) + pos * 8 + (cc & 1) * 4;
            const float2 c0 = rope[0], c1 = rope[1], c2_ = rope[2], c3 = rope[3];
            if (cc < 2) { o.x = o.x * c0.x - oth.x * c0.y; o.y = o.y * c1.x - oth.y * c1.y; o.z = o.z * c2_.x - oth.z * c2_.y; o.w = o.w * c3.x - oth.w * c3.y; }
            else        { o.x = o.x * c0.x + oth.x * c0.y; o.y = o.y * c1.x + oth.y * c1.y; o.z = o.z * c2_.x + oth.z * c2_.y; o.w = o.w * c3.x + oth.w * c3.y; }
        }
    }
    if (nn > 254) o = (f32x4){0.f, 0.f, 0.f, 0.f};
    u32x2 pk; pk.x = pk2(o.x, o.y); pk.y = pk2(o.z, o.w);
    *(u32x2*)dst = pk;
    __syncthreads();
}

constexpr int KV_BUF = 17664, KV_VOFF = 9216, V_HALF = 4224;
constexpr int ATT_FLAGS = 35328, ATT_LINV = 35392, ATT_PW = 36416;

struct KVStage { u32x4 k, v; };
__device__ __forceinline__ void kv_load(KVStage& st, const bf16_t* Kb, int kpitch, const bf16_t* Vb, int vpitch, int key0, int tid) {
    const int key = tid >> 3, c = tid & 7;
    st.k = *(const u32x4*)(Kb + (size_t)(key0 + key) * kpitch + c * 8);
    st.v = *(const u32x4*)(Vb + (size_t)(key0 + key) * vpitch + c * 8);
}
__device__ __forceinline__ void kv_store(const KVStage& st, LAS unsigned char* buf, int tid) {
    const int key = tid >> 3, c = tid & 7;
    *(LAS u32x4*)(buf + key * 144 + c * 16) = st.k;
    *(LAS u32x4*)(buf + KV_VOFF + (c >> 2) * V_HALF + key * 64 + (c & 3) * 16) = st.v;
}
__device__ __forceinline__ void qk_tile(f32x16& p0, f32x16& p1, const f32x16& cinit, const LAS unsigned char* kb, const bf16x8* qr, int r32, int hi) {
    const LAS unsigned char* base = kb + r32 * 144 + hi * 16;
    { const bf16x8 a0 = *(const LAS bf16x8*)(base), a1 = *(const LAS bf16x8*)(base + 32 * 144);
      p0 = MFMA32(a0, qr[0], cinit); p1 = MFMA32(a1, qr[0], cinit); }
#pragma unroll
    for (int d0 = 1; d0 < 4; ++d0) { const bf16x8 a0 = *(const LAS bf16x8*)(base + d0 * 32), a1 = *(const LAS bf16x8*)(base + 32 * 144 + d0 * 32);
        p0 = MFMA32(a0, qr[d0], p0); p1 = MFMA32(a1, qr[d0], p1); }
}
typedef short v4i16_t __attribute__((ext_vector_type(4)));
__device__ __forceinline__ s16x4 vtr(const LAS unsigned char* p) { return __builtin_bit_cast(s16x4, __builtin_amdgcn_ds_read_tr16_b64_v4i16((LAS v4i16_t*)p)); }
__device__ __forceinline__ void pv_packed(f32x16* o, const LAS unsigned char* vb, const bf16x8* pa, int lane) {
    const int hi = lane >> 5;
    const LAS unsigned char* base = vb + ((lane >> 4) & 1) * 32 + (lane & 3) * 8 + (4 * hi + ((lane & 15) >> 2)) * 64;
#pragma unroll
    for (int d0 = 0; d0 < 2; ++d0)
#pragma unroll
        for (int s = 0; s < 4; ++s) {
            const s16x4 lo = vtr(base + d0 * V_HALF + s * 1024);
            const s16x4 hh = vtr(base + d0 * V_HALF + s * 1024 + 512);
            const bf16x8 vf = __builtin_shufflevector(lo, hh, 0, 1, 2, 3, 4, 5, 6, 7);
            o[d0] = MFMA32(vf, pa[s], o[d0]);
        }
}
__device__ __forceinline__ void pack_half(bf16x8* pa2, const f32x16& p) {
    u32x4 w0 = {pk2(p[0], p[1]), pk2(p[2], p[3]), pk2(p[4], p[5]), pk2(p[6], p[7])};
    u32x4 w1 = {pk2(p[8], p[9]), pk2(p[10], p[11]), pk2(p[12], p[13]), pk2(p[14], p[15])};
    pa2[0] = __builtin_bit_cast(bf16x8, w0); pa2[1] = __builtin_bit_cast(bf16x8, w1);
}
__device__ __forceinline__ void pv_tile(f32x16* o, const LAS unsigned char* vb, const f32x16& p0, const f32x16& p1, int lane) {
    bf16x8 pa[4]; pack_half(pa, p0); pack_half(pa + 2, p1);
    pv_packed(o, vb, pa, lane);
}
__device__ __forceinline__ f32x16 splat16(float v) { f32x16 r;
#pragma unroll
    for (int i = 0; i < 16; ++i) r[i] = v;
    return r; }
__device__ __forceinline__ int crow(int i, int hi) { return (i & 3) + 8 * (i >> 2) + 4 * hi; }

enum { M_WIN = 0, M_SLC = 1, M_SB = 2, M_CMP = 3 };

template <int MODE>
__device__ __forceinline__ void attn_item(const Args& A, LAS unsigned char* lds, int item, const int wv_) {
    int tid_l = TIDX; asm volatile("" : "+v"(tid_l));
    const int tid = tid_l, lane = tid & 63, r32 = lane & 31, hi = lane >> 5, w = __builtin_amdgcn_readfirstlane(tid >> 6);
    unsigned char* ws = A.ws;
    const bf16_t* P = (const bf16_t*)(ws + WS_P);
    int b, g = 0, hd, m, T0, trel;
    const bf16_t *Qrow, *Kb, *Vb; int kpitch, vpitch, kt_first, nt, kt_step = 1;
    if (MODE == M_SB) {
        b = item >> 7; hd = (item >> 4) & 7; m = item & 15; T0 = 256 * m; trel = 32 * w + r32;
        Qrow = P + (size_t)(b * SEQ + T0 + trel) * NCP + C_QSB + hd * 64;
        Kb = P + (size_t)(b * SEQ) * NCP + C_KSB + hd * 64; Vb = P + (size_t)(b * SEQ) * NCP + C_VSB + hd * 64; kpitch = NCP; vpitch = NCP;
        kt_first = 4 * m + 3; nt = 4 * m + 4; kt_step = -1;
    } else {
        if (MODE == M_SLC) { int bg; if (item < 256) { bg = item >> 5; m = 32 + (item & 31); } else { const int i2 = item - 256; bg = i2 >> 5; m = 31 - (i2 & 31); } b = bg >> 1; g = bg & 1; }
        else { b = item >> 7; g = (item >> 6) & 1; m = item & 63; }
        T0 = 64 * m; hd = 4 * g + (w & 3); trel = 32 * (w >> 2) + r32;
        Qrow = (const bf16_t*)(ws + WS_QN) + (size_t)(b * SEQ + T0 + trel) * 512 + hd * 64;
        if (MODE == M_WIN) { Kb = (const bf16_t*)(ws + WS_KWN) + (size_t)(b * SEQ) * 128 + g * 64; kpitch = 128; Vb = P + (size_t)(b * SEQ) * NCP + C_VW + g * 64; vpitch = NCP; kt_first = m >= 8 ? m - 8 : 0; nt = m - kt_first + 1; }
        else if (MODE == M_SLC) { Kb = (const bf16_t*)(ws + WS_KSN) + (size_t)(b * SEQ) * 128 + g * 64; kpitch = 128; Vb = P + (size_t)(b * SEQ) * NCP + C_VS + g * 64; vpitch = NCP; kt_first = 0; nt = m + 1; }
        else { Kb = (const bf16_t*)(ws + WS_KCMP) + (size_t)((b * 2 + g) * 256) * 64; kpitch = 64; Vb = (const bf16_t*)(ws + WS_VCMP) + (size_t)((b * 2 + g) * 256) * 64; vpitch = 64; kt_first = 0; nt = ((4 * m + 2) >> 6) + 1; }
    }
    const int t = T0 + trel;
    bf16x8 qr[4];
#pragma unroll
    for (int d0 = 0; d0 < 4; ++d0) qr[d0] = *(const bf16x8*)(Qrow + 16 * d0 + 8 * hi);
    if (MODE == M_SB) {
#pragma unroll
        for (int d0 = 0; d0 < 4; ++d0) { u32x4 u = __builtin_bit_cast(u32x4, qr[d0]);
            u.x = pk2(bflo(u.x) * C2, bfhi(u.x) * C2); u.y = pk2(bflo(u.y) * C2, bfhi(u.y) * C2); u.z = pk2(bflo(u.z) * C2, bfhi(u.z) * C2); u.w = pk2(bflo(u.w) * C2, bfhi(u.w) * C2);
            qr[d0] = __builtin_bit_cast(bf16x8, u); }
    }
    float negmb = 0.f;
    if (MODE != M_SB) negmb = -((const float*)(ws + WS_MB))[MODE == M_CMP ? 0 : (MODE == M_SLC ? 1 : 2)];
    unsigned sel_lo = 0, sel_hi = 0;
    if (MODE == M_SLC) { const u32x2 sm = *(const u32x2*)((const unsigned long long*)(ws + WS_SEL) + (size_t)(b * 2 + g) * SEQ + t); sel_lo = sm.x; sel_hi = sm.y; }
    const int nmax = (t - 31) >> 4;
    f32x16 o[2]; o[0] = splat16(0.f); o[1] = splat16(0.f);
    float lsum = 0.f, carry = (MODE == M_SB) ? 1.f : 0.f  ;
    bool done = false;
    LAS unsigned* flags = (LAS unsigned*)(lds + ATT_FLAGS);
    LAS float* pw = (LAS float*)(lds + ATT_PW) + (w * 32 + r32) * 65;
    if (MODE == M_CMP) {
#pragma unroll
        for (int j = 0; j < 32; ++j) pw[hi * 32 + j] = 0.f;
        if (hi) pw[64] = 0.f;
    }
    f32x16 cneg = splat16(negmb);
    if (MODE != M_SB) asm volatile("" : "+v"(cneg));
    KVStage sA, sB;
    kv_load(sA, Kb, kpitch, Vb, vpitch, kt_first * 64, tid);
    kv_store(sA, lds, tid);
    kv_load(sA, Kb, kpitch, Vb, vpitch, (kt_first + (nt > 1 ? kt_step : 0)) * 64, tid);
    __syncthreads();
    auto step = [&](const int it, KVStage& have, KVStage& recv) __attribute__((always_inline)) -> bool {
        const int kt = kt_first + it * kt_step;
        const LAS unsigned char* cur = lds + (it & 1) * KV_BUF;
        LAS unsigned char* nxt = lds + ((it & 1) ^ 1) * KV_BUF;
        const bool more = it + 1 < nt;
        { const int itn = it + 2 < nt ? it + 2 : nt - 1; kv_load(recv, Kb, kpitch, Vb, vpitch, (kt_first + itn * kt_step) * 64, tid); }
        if (MODE == M_WIN) {
            f32x16 p0, p1;
            qk_tile(p0, p1, cneg, cur, qr, r32, hi);
#pragma unroll
            for (int i = 0; i < 16; ++i) { p0[i] = ex2(p0[i]); p1[i] = ex2(p1[i]); }
            if (kt == m) {
#pragma unroll
                for (int i = 0; i < 16; ++i) { const int rel = crow(i, hi); if (rel > trel) p0[i] = 0.f; if (rel + 32 > trel) p1[i] = 0.f; }
            }
            if (kt == m - 8) {
#pragma unroll
                for (int i = 0; i < 16; ++i) { const int rel = crow(i, hi); if (rel <= trel) p0[i] = 0.f; if (rel + 32 <= trel) p1[i] = 0.f; }
            }
            float s = 0.f;
#pragma unroll
            for (int i = 0; i < 16; ++i) s += p0[i] + p1[i];
            lsum += s;
            pv_tile(o, cur + KV_VOFF, p0, p1, lane);
        } else if (MODE == M_SLC) {
            const unsigned bit = ((kt < 32 ? sel_lo : sel_hi) >> (kt & 31)) & 1u;
            if (__any((int)bit)) {
                f32x16 p0, p1;
                qk_tile(p0, p1, cneg, cur, qr, r32, hi);
                const float bf = bit ? 1.f : 0.f;
#pragma unroll
                for (int i = 0; i < 16; ++i) { p0[i] = ex2(p0[i]) * bf; p1[i] = ex2(p1[i]) * bf; }
                if (kt == m) {
#pragma unroll
                    for (int i = 0; i < 16; ++i) { const int rel = crow(i, hi); if (rel > trel) p0[i] = 0.f; if (rel + 32 > trel) p1[i] = 0.f; }
                }
                float s = 0.f;
#pragma unroll
                for (int i = 0; i < 16; ++i) s += p0[i] + p1[i];
                lsum += s;
                pv_tile(o, cur + KV_VOFF, p0, p1, lane);
            }
        } else if (MODE == M_CMP) {
            f32x16 p0, p1;
            qk_tile(p0, p1, cneg, cur, qr, r32, hi);
            const int lim = nmax - kt * 64;
#pragma unroll
            for (int i = 0; i < 16; ++i) { const int rel = crow(i, hi); p0[i] = rel <= lim ? ex2(p0[i]) : 0.f; p1[i] = rel + 32 <= lim ? ex2(p1[i]) : 0.f; }
            float s = 0.f;
#pragma unroll
            for (int i = 0; i < 16; ++i) s += p0[i] + p1[i];
            lsum += s;
#pragma unroll
            for (int q = 0; q < 8; ++q) {
                const f32x16& pq = q < 4 ? p0 : p1; const int qb = 4 * (q & 3); const float e0 = pq[qb], e1 = pq[qb + 1], e2 = pq[qb + 2], e3 = pq[qb + 3];
                float a = e0 + e1 + e2 + 0.5f * e3; const float bq = 0.5f * e3;
                const float pb = __shfl_xor(bq, 32);
                a += hi ? pb : carry;
                carry = pb;
                pw[kt * 16 + 2 * q + hi] = a;
            }
            pv_tile(o, cur + KV_VOFF, p0, p1, lane);
        } else {
            const int kbase = kt * 64 - T0;
            const bool skip = done || (kbase >= 32 * w + 31);
            if (!skip) {
                f32x16 pz[2];
                qk_tile(pz[0], pz[1], splat16(0.f), cur, qr, r32, hi);
                const bool partial = kbase + 63 >= 32 * w;
                const int lim = trel - kbase;
                bf16x8 pa[4];
                float run = carry;
#pragma unroll
                for (int h2 = 1; h2 >= 0; --h2) {
                    f32x16 om, be;
#pragma unroll
                    for (int i = 0; i < 16; ++i) { const float z = __builtin_amdgcn_fmed3f(pz[h2][i], -60.f, 60.f); const float e = ex2(-z); const float bb = __builtin_amdgcn_rcpf(1.f + e); be[i] = bb; om[i] = e * bb; }
                    if (partial) {
#pragma unroll
                        for (int i = 0; i < 16; ++i) { const int rel = crow(i, hi) + 32 * h2; if (rel >= lim) { om[i] = 1.f; be[i] = 0.f; } }
                    }
                    float gs[4], po[4];
#pragma unroll
                    for (int q = 0; q < 4; ++q) { gs[q] = (om[4 * q] * om[4 * q + 1]) * (om[4 * q + 2] * om[4 * q + 3]); po[q] = __shfl_xor(gs[q], 32); }
#pragma unroll
                    for (int q = 3; q >= 0; --q) {
                        const float ghi = hi ? gs[q] : po[q], glo = hi ? po[q] : gs[q];
                        const float t1 = run; run *= ghi; const float t0 = run; run *= glo;
                        float af = hi ? t1 : t0;
                        be[4 * q + 3] *= af; af *= om[4 * q + 3];
                        be[4 * q + 2] *= af; af *= om[4 * q + 2];
                        be[4 * q + 1] *= af; af *= om[4 * q + 1];
                        be[4 * q] *= af;
                    }
                    pack_half(pa + 2 * h2, be);
                }
                carry = run;
                pv_packed(o, cur + KV_VOFF, pa, lane);
                done = __all(carry < 3.5527e-15f);
            }
        }
        if (more) kv_store(have, nxt, tid);
        if (MODE == M_SB) { if (lane == 0) flags[(it & 1) * 8 + w] = done ? 1u : 0u; }
        __syncthreads();
        if (MODE == M_SB) {
            const u32x4 f0 = *(const LAS u32x4*)(flags + (it & 1) * 8), f1 = *(const LAS u32x4*)(flags + (it & 1) * 8 + 4);
            if ((f0.x & f0.y & f0.z & f0.w & f1.x & f1.y & f1.z & f1.w) != 0u) return true;
        }
        return false;
    };
    for (int it = 0; it < nt; it += 2) {
        if (step(it, sA, sB)) break;
        if (it + 1 >= nt) break;
        if (step(it + 1, sB, sA)) break;
    }
    if (MODE == M_SB) {
        const bf16_t* gp = P + (size_t)(b * SEQ + t) * NCP + C_GSB + hd * 64;
        bf16_t* dst = (bf16_t*)(ws + WS_XB) + (size_t)(b * SEQ + t) * DM + 512 + hd * 64;
        u32x2 gvv[8];
#pragma unroll
        for (int e = 0; e < 8; ++e) gvv[e] = *(const u32x2*)(gp + (e >> 2) * 32 + 8 * (e & 3) + 4 * hi);
#pragma unroll
        for (int d0 = 0; d0 < 2; ++d0)
#pragma unroll
            for (int q = 0; q < 4; ++q) { const int d = d0 * 32 + 8 * q + 4 * hi;
                const u32x2 gv = gvv[d0 * 4 + q];
                const float g0 = bflo(gv.x), g1 = bfhi(gv.x), g2 = bflo(gv.y), g3 = bfhi(gv.y);
                u32x2 pk; pk.x = pk2(o[d0][4 * q] * g0 * sigmoidf_(g0), o[d0][4 * q + 1] * g1 * sigmoidf_(g1)); pk.y = pk2(o[d0][4 * q + 2] * g2 * sigmoidf_(g2), o[d0][4 * q + 3] * g3 * sigmoidf_(g3));
                *(u32x2*)(dst + d) = pk; }
    } else {
        lsum += __shfl_xor(lsum, 32);
        const float inv = lsum > 0.f ? 1.f / lsum : 0.f;
        const int br = MODE == M_CMP ? 0 : (MODE == M_SLC ? 1 : 2);
        const float gate = sigmoidf_(bf1(P[(size_t)(b * SEQ + t) * NCP + C_GL + hd * 3 + br]));
        const float sc = inv * gate;
        const size_t orow = (size_t)(b * SEQ + t) * 512 + hd * 64;
        if (MODE == M_SLC) {
            const bf16_t* oc = (const bf16_t*)(ws + WS_OC) + orow; const bf16_t* ow = (const bf16_t*)(ws + WS_OW) + orow;
            const bf16_t* gp = P + (size_t)(b * SEQ + t) * NCP + C_GN + hd * 64;
            bf16_t* dst = (bf16_t*)(ws + WS_XB) + (size_t)(b * SEQ + t) * DM + hd * 64;
#pragma unroll
            for (int d0 = 0; d0 < 2; ++d0)
#pragma unroll
                for (int q = 0; q < 4; ++q) { const int d = d0 * 32 + 8 * q + 4 * hi;
                    const u32x2 gv = *(const u32x2*)(gp + d), cv = *(const u32x2*)(oc + d), wv = *(const u32x2*)(ow + d);
                    const float g0 = bflo(gv.x), g1 = bfhi(gv.x), g2 = bflo(gv.y), g3 = bfhi(gv.y);
                    const float v0 = o[d0][4 * q] * sc + bflo(cv.x) + bflo(wv.x), v1 = o[d0][4 * q + 1] * sc + bfhi(cv.x) + bfhi(wv.x);
                    const float v2 = o[d0][4 * q + 2] * sc + bflo(cv.y) + bflo(wv.y), v3 = o[d0][4 * q + 3] * sc + bfhi(cv.y) + bfhi(wv.y);
                    u32x2 pk; pk.x = pk2(v0 * g0 * sigmoidf_(g0), v1 * g1 * sigmoidf_(g1)); pk.y = pk2(v2 * g2 * sigmoidf_(g2), v3 * g3 * sigmoidf_(g3));
                    *(u32x2*)(dst + d) = pk; }
        } else {
            bf16_t* dst = (bf16_t*)(ws + (MODE == M_CMP ? WS_OC : WS_OW)) + orow;
#pragma unroll
            for (int d0 = 0; d0 < 2; ++d0)
#pragma unroll
                for (int q = 0; q < 4; ++q) { const int d = d0 * 32 + 8 * q + 4 * hi;
                    u32x2 pk; pk.x = pk2(o[d0][4 * q] * sc, o[d0][4 * q + 1] * sc); pk.y = pk2(o[d0][4 * q + 2] * sc, o[d0][4 * q + 3] * sc);
                    *(u32x2*)(dst + d) = pk; }
        }
        if (MODE == M_CMP) {
            LAS float* linv = (LAS float*)(lds + ATT_LINV);
            if (hi == 0) linv[w * 32 + r32] = inv;
            __syncthreads();
            const LAS float* pwb = (const LAS float*)(lds + ATT_PW);
            unsigned long long* sel = (unsigned long long*)(ws + WS_SEL) + (size_t)(b * 2 + g) * SEQ + T0;
            const int j = lane, blk = m;
            const bool valid = j <= blk, forced = (j == 0) || (j == blk) || (j == blk - 1);
            for (int i = 0; i < 8; ++i) {
                const int tok = w * 8 + i, half = tok >> 5, r = tok & 31;
                float sc2 = 0.f;
#pragma unroll
                for (int hh = 0; hh < 4; ++hh) sc2 += pwb[((half * 4 + hh) * 32 + r) * 65 + j] * linv[(half * 4 + hh) * 32 + r];
                const float s = valid ? (forced ? sc2 + 1.0e4f : sc2) : -INFINITY;
                int cnt = 0;
#pragma unroll
                for (int l2 = 0; l2 < 64; ++l2) { const float sl = __uint_as_float(__builtin_amdgcn_readlane(__float_as_uint(s), l2)); cnt += ((sl > s) || (sl == s && l2 < lane)) ? 1 : 0; }
                const unsigned long long mk = __ballot(valid && cnt < 16);
                if (lane == 0) sel[tok] = mk;
            }
        }
    }
    __syncthreads();
}


__device__ __forceinline__ void k_reads(bf16x8* kf, const LAS unsigned char* kb, int r32, int hi) {
    const LAS unsigned char* base = kb + r32 * 144 + hi * 16;
#pragma unroll
    for (int d0 = 0; d0 < 4; ++d0) { kf[2 * d0] = *(const LAS bf16x8*)(base + d0 * 32); kf[2 * d0 + 1] = *(const LAS bf16x8*)(base + 32 * 144 + d0 * 32); }
}
__device__ __forceinline__ void qk_mfma(f32x16& p0, f32x16& p1, const f32x16& cinit, const bf16x8* kf, const bf16x8* qr) {
    p0 = MFMA32(kf[0], qr[0], cinit); p1 = MFMA32(kf[1], qr[0], cinit);
#pragma unroll
    for (int d0 = 1; d0 < 4; ++d0) { p0 = MFMA32(kf[2 * d0], qr[d0], p0); p1 = MFMA32(kf[2 * d0 + 1], qr[d0], p1); }
}
__device__ __forceinline__ void v_reads(s16x4* vlo, s16x4* vhi, const LAS unsigned char* vb, int lane) {
    const int hi = lane >> 5;
    const LAS unsigned char* base = vb + ((lane >> 4) & 1) * 32 + (lane & 3) * 8 + (4 * hi + ((lane & 15) >> 2)) * 64;
#pragma unroll
    for (int d0 = 0; d0 < 2; ++d0)
#pragma unroll
        for (int s = 0; s < 4; ++s) { vlo[d0 * 4 + s] = vtr(base + d0 * V_HALF + s * 1024); vhi[d0 * 4 + s] = vtr(base + d0 * V_HALF + s * 1024 + 512); }
}
__device__ __forceinline__ void pv_mfma(f32x16* o, const s16x4* vlo, const s16x4* vhi, const bf16x8* pa) {
#pragma unroll
    for (int s = 0; s < 4; ++s)
#pragma unroll
        for (int d0 = 0; d0 < 2; ++d0) {
            const bf16x8 vf = __builtin_shufflevector(vlo[d0 * 4 + s], vhi[d0 * 4 + s], 0, 1, 2, 3, 4, 5, 6, 7);
            o[d0] = MFMA32(vf, pa[s], o[d0]);
        }
}
__device__ __forceinline__ float fadd_s(float a, float b) { float r; asm("v_add_f32_e32 %0, %1, %2" : "=v"(r) : "v"(a), "v"(b)); return r; }
typedef float f32x2v __attribute__((ext_vector_type(2)));
template <int MODE>
__device__ __forceinline__ void softmax_stage(f32x16& p0, f32x16& p1, bf16x8* pa, float& lsum, int kt, int m, int trel, int hi, unsigned bit) {
#pragma unroll
    for (int i = 0; i < 16; ++i) { p0[i] = ex2(p0[i]); p1[i] = ex2(p1[i]); }
    if (kt == m) {
#pragma unroll
        for (int i = 0; i < 16; ++i) { const int rel = crow(i, hi); if (rel > trel) p0[i] = 0.f; if (rel + 32 > trel) p1[i] = 0.f; }
    }
    if (MODE == M_WIN && kt == m - 8) {
#pragma unroll
        for (int i = 0; i < 16; ++i) { const int rel = crow(i, hi); if (rel <= trel) p0[i] = 0.f; if (rel + 32 <= trel) p1[i] = 0.f; }
    }
    f32x2v acc = {0.f, 0.f};
#pragma unroll
    for (int i = 0; i < 8; ++i) { acc += (f32x2v){p0[2 * i], p0[2 * i + 1]}; acc += (f32x2v){p1[2 * i], p1[2 * i + 1]}; }
    float sum = acc.x + acc.y;
    const unsigned mk = (MODE == M_SLC) ? (bit ? 0xffffffffu : 0u) : 0xffffffffu;
#pragma unroll
    for (int k = 0; k < 4; ++k) { const f32x16& p = k < 2 ? p0 : p1; const int bs = 8 * (k & 1);
        u32x4 wv = {pk2(p[bs], p[bs + 1]), pk2(p[bs + 2], p[bs + 3]), pk2(p[bs + 4], p[bs + 5]), pk2(p[bs + 6], p[bs + 7])};
        if (MODE == M_SLC) { wv.x &= mk; wv.y &= mk; wv.z &= mk; wv.w &= mk; }
        pa[k] = __builtin_bit_cast(bf16x8, wv); }
    if (MODE == M_SLC) sum = bit ? sum : 0.f;
    lsum += sum;
}

template <int MODE>
__device__ __forceinline__ void attn_item2(const Args& A, LAS unsigned char* lds, int item, const int wv_) {
    int tid_l = TIDX; asm volatile("" : "+v"(tid_l));
    const int tid = tid_l, lane = tid & 63, r32 = lane & 31, hi = lane >> 5, w = __builtin_amdgcn_readfirstlane(tid >> 6);
    unsigned char* ws = A.ws;
    const bf16_t* P = (const bf16_t*)(ws + WS_P);
    int b, g, m;
    if (MODE == M_SLC) { int bg; if (item < 256) { bg = item >> 5; m = 32 + (item & 31); } else { const int i2 = item - 256; bg = i2 >> 5; m = 31 - (i2 & 31); } b = bg >> 1; g = bg & 1; }
    else { b = item >> 7; g = (item >> 6) & 1; m = item & 63; }
    const int T0 = 64 * m, hd = 4 * g + (w & 3), trel = 32 * (w >> 2) + r32, t = T0 + trel;
    const bf16_t* Qrow = (const bf16_t*)(ws + WS_QN) + (size_t)(b * SEQ + t) * 512 + hd * 64;
    const bf16_t* Kb = (const bf16_t*)(ws + (MODE == M_WIN ? WS_KWN : WS_KSN)) + (size_t)(b * SEQ) * 128 + g * 64;
    const bf16_t* Vb = P + (size_t)(b * SEQ) * NCP + (MODE == M_WIN ? C_VW : C_VS) + g * 64;
    const int kpitch = 128, vpitch = NCP;
    const int kt_first = (MODE == M_WIN && m >= 8) ? m - 8 : 0, nt = m - kt_first + 1;
    bf16x8 qr[4];
#pragma unroll
    for (int d0 = 0; d0 < 4; ++d0) qr[d0] = *(const bf16x8*)(Qrow + 16 * d0 + 8 * hi);
    const float negmb = -((const float*)(ws + WS_MB))[MODE == M_SLC ? 1 : 2];
    unsigned sel_lo = 0xffffffffu, sel_hi = 0xffffffffu;
    if (MODE == M_SLC) { const u32x2 sm = *(const u32x2*)((const unsigned long long*)(ws + WS_SEL) + (size_t)(b * 2 + g) * SEQ + t); sel_lo = sm.x; sel_hi = sm.y; }
    f32x16 o[2]; o[0] = splat16(0.f); o[1] = splat16(0.f);
    float lsum = 0.f;
    f32x16 cneg = splat16(negmb);
    asm volatile("" : "+v"(cneg));
    const bool grpA = (w < 4);
    KVStage sA, sB;
#define TILE_CL(i) ((kt_first + ((i) < nt ? (i) : nt - 1)) * 64)
    kv_load(sA, Kb, kpitch, Vb, vpitch, TILE_CL(0), tid);
    kv_load(sB, Kb, kpitch, Vb, vpitch, TILE_CL(1), tid);
    kv_store(sA, lds, tid);
    kv_store(sB, lds + KV_BUF, tid);
    kv_load(sA, Kb, kpitch, Vb, vpitch, TILE_CL(2), tid);
    __syncthreads();
    f32x16 SA0, SA1, SB0, SB1;
    qk_tile(SA0, SA1, cneg, lds, qr, r32, hi);
    int s0 = 0, s1 = KV_BUF, s2 = 2 * KV_BUF;
    auto step = [&](const int it, KVStage& have, KVStage& recv, f32x16& c0, f32x16& c1, f32x16& n0, f32x16& n1) __attribute__((always_inline)) {
        const int kt = kt_first + it;
        kv_load(recv, Kb, kpitch, Vb, vpitch, TILE_CL(it + 3), tid);
        const unsigned bit = ((kt < 32 ? sel_lo : sel_hi) >> (kt & 31)) & 1u;
        bf16x8 pa[4];
        bf16x8 kf[8]; s16x4 vlo[8], vhi[8];
        if (grpA) {
            k_reads(kf, lds + s1, r32, hi);
            __builtin_amdgcn_sched_barrier(0);
            __builtin_amdgcn_s_setprio(1); qk_mfma(n0, n1, cneg, kf, qr); __builtin_amdgcn_s_setprio(0);
            v_reads(vlo, vhi, lds + s0 + KV_VOFF, lane);
            __builtin_amdgcn_sched_barrier(0);
            softmax_stage<MODE>(c0, c1, pa, lsum, kt, m, trel, hi, bit);
            __builtin_amdgcn_sched_barrier(0);
            __builtin_amdgcn_s_setprio(1); pv_mfma(o, vlo, vhi, pa); __builtin_amdgcn_s_setprio(0);
        } else {
            v_reads(vlo, vhi, lds + s0 + KV_VOFF, lane);
            __builtin_amdgcn_sched_barrier(0);
            softmax_stage<MODE>(c0, c1, pa, lsum, kt, m, trel, hi, bit);
            k_reads(kf, lds + s1, r32, hi);
            __builtin_amdgcn_sched_barrier(0);
            __builtin_amdgcn_s_setprio(1); pv_mfma(o, vlo, vhi, pa);
            __builtin_amdgcn_sched_barrier(0);
            qk_mfma(n0, n1, cneg, kf, qr); __builtin_amdgcn_s_setprio(0);
        }
        kv_store(have, lds + s2, tid);
        __syncthreads();
        const int tmp = s0; s0 = s1; s1 = s2; s2 = tmp;
    };
    for (int it = 0; it < nt; it += 2) {
        step(it, sA, sB, SA0, SA1, SB0, SB1);
        if (it + 1 >= nt) break;
        step(it + 1, sB, sA, SB0, SB1, SA0, SA1);
    }
#undef TILE_CL
    lsum += __shfl_xor(lsum, 32);
    const float inv = lsum > 0.f ? 1.f / lsum : 0.f;
    const int br = MODE == M_SLC ? 1 : 2;
    const float gate = sigmoidf_(bf1(P[(size_t)(b * SEQ + t) * NCP + C_GL + hd * 3 + br]));
    const float sc = inv * gate;
    const size_t orow = (size_t)(b * SEQ + t) * 512 + hd * 64;
    if (MODE == M_SLC) {
        const bf16_t* oc = (const bf16_t*)(ws + WS_OC) + orow; const bf16_t* ow = (const bf16_t*)(ws + WS_OW) + orow;
        const bf16_t* gp = P + (size_t)(b * SEQ + t) * NCP + C_GN + hd * 64;
        bf16_t* dst = (bf16_t*)(ws + WS_XB) + (size_t)(b * SEQ + t) * DM + hd * 64;
#pragma unroll
        for (int d0 = 0; d0 < 2; ++d0)
#pragma unroll
            for (int q = 0; q < 4; ++q) { const int d = d0 * 32 + 8 * q + 4 * hi;
                const u32x2 gv = *(const u32x2*)(gp + d), cv = *(const u32x2*)(oc + d), wv = *(const u32x2*)(ow + d);
                const float g0 = bflo(gv.x), g1 = bfhi(gv.x), g2 = bflo(gv.y), g3 = bfhi(gv.y);
                const float v0 = o[d0][4 * q] * sc + bflo(cv.x) + bflo(wv.x), v1 = o[d0][4 * q + 1] * sc + bfhi(cv.x) + bfhi(wv.x);
                const float v2 = o[d0][4 * q + 2] * sc + bflo(cv.y) + bflo(wv.y), v3 = o[d0][4 * q + 3] * sc + bfhi(cv.y) + bfhi(wv.y);
                u32x2 pk; pk.x = pk2(v0 * g0 * sigmoidf_(g0), v1 * g1 * sigmoidf_(g1)); pk.y = pk2(v2 * g2 * sigmoidf_(g2), v3 * g3 * sigmoidf_(g3));
                *(u32x2*)(dst + d) = pk; }
    } else {
        bf16_t* dst = (bf16_t*)(ws + WS_OW) + orow;
#pragma unroll
        for (int d0 = 0; d0 < 2; ++d0)
#pragma unroll
            for (int q = 0; q < 4; ++q) { const int d = d0 * 32 + 8 * q + 4 * hi;
                u32x2 pk; pk.x = pk2(o[d0][4 * q] * sc, o[d0][4 * q + 1] * sc); pk.y = pk2(o[d0][4 * q + 2] * sc, o[d0][4 * q + 3] * sc);
                *(u32x2*)(dst + d) = pk; }
    }
    __syncthreads();
}

constexpr int NS_LINV = 53056, NS_SEL = 54080, NS_PW = 54784, NS_GL = 121344;

template <int MODE>
__device__ __forceinline__ void nsa_softmax(f32x16& p0, f32x16& p1, bf16x8* pa, float& lsum, float negmb, int kt, int m, int trel, int hi, unsigned bit, int nmax, LAS float* pw, float& carry) {
    if (MODE == M_CMP) {
#pragma unroll
        for (int i = 0; i < 16; ++i) { p0[i] += negmb; p1[i] += negmb; }
    }
    if (MODE == M_CMP) {
        const int lim = nmax - kt * 64;
#pragma unroll
        for (int i = 0; i < 16; ++i) { const int rel = crow(i, hi); p0[i] = rel <= lim ? ex2(p0[i]) : 0.f; p1[i] = rel + 32 <= lim ? ex2(p1[i]) : 0.f; }
#pragma unroll
        for (int q = 0; q < 8; ++q) {
            const f32x16& pq = q < 4 ? p0 : p1; const int qb = 4 * (q & 3); const float e0 = pq[qb], e1 = pq[qb + 1], e2 = pq[qb + 2], e3 = pq[qb + 3];
            float a = e0 + e1 + e2 + 0.5f * e3; const float bq = 0.5f * e3;
            const float pb = __shfl_xor(bq, 32);
            a += hi ? pb : carry;
            carry = pb;
            pw[kt * 16 + 2 * q + hi] = a;
        }
    } else {
#pragma unroll
        for (int i = 0; i < 16; ++i) { p0[i] = ex2(p0[i]); p1[i] = ex2(p1[i]); }
        if (kt == m) {
            asm volatile("" ::: "memory");
#pragma unroll
            for (int i = 0; i < 16; ++i) { const int rel = crow(i, hi); if (rel > trel) p0[i] = 0.f; if (rel + 32 > trel) p1[i] = 0.f; }
        }
        if (MODE == M_WIN && kt == m - 8) {
            asm volatile("" ::: "memory");
#pragma unroll
            for (int i = 0; i < 16; ++i) { const int rel = crow(i, hi); if (rel <= trel) p0[i] = 0.f; if (rel + 32 <= trel) p1[i] = 0.f; }
        }
    }
    float sa = 0.f, sb = 0.f, sc_ = 0.f, sd = 0.f;
#pragma unroll
    for (int i = 0; i < 16; i += 2) { sa = fadd_s(sa, p0[i]); sb = fadd_s(sb, p0[i + 1]); sc_ = fadd_s(sc_, p1[i]); sd = fadd_s(sd, p1[i + 1]); }
    float sum = fadd_s(fadd_s(sa, sb), fadd_s(sc_, sd));
    const unsigned mk = (MODE == M_SLC) ? (bit ? 0xffffffffu : 0u) : 0xffffffffu;
#pragma unroll
    for (int k = 0; k < 4; ++k) { const f32x16& p = k < 2 ? p0 : p1; const int bs = 8 * (k & 1);
        u32x4 wv = {pk2(p[bs], p[bs + 1]), pk2(p[bs + 2], p[bs + 3]), pk2(p[bs + 4], p[bs + 5]), pk2(p[bs + 6], p[bs + 7])};
        if (MODE == M_SLC) { wv.x &= mk; wv.y &= mk; wv.z &= mk; wv.w &= mk; }
        pa[k] = __builtin_bit_cast(bf16x8, wv); }
    if (MODE == M_SLC) sum = bit ? sum : 0.f;
    lsum += sum;
}

template <int MODE>
__device__ __forceinline__ void nsa_branch(LAS unsigned char* lds, const bf16_t* Kb, const int kpitch, const bf16_t* Vb, const int vpitch, const int kt_first, const int nt,
                                           const bf16x8* qr, const float negmb, f32x16* o, float& lsum, const int m, const int trel, const int tid, const int w,
                                           const unsigned sel_lo, const unsigned sel_hi, const int nmax, LAS float* pw) {
    const int lane = tid & 63, r32 = lane & 31, hi = lane >> 5;
    f32x16 cneg = splat16(MODE == M_CMP ? 0.f : negmb);
    if (MODE != M_CMP) asm volatile("" : "+v"(cneg));
    const bool grpA = (w < 4);
    float carry = 0.f;
    KVStage sA;
#define TILE_CL(i) ((kt_first + ((i) < nt ? (i) : nt - 1)) * 64)
    {   KVStage sB;
        kv_load(sA, Kb, kpitch, Vb, vpitch, TILE_CL(0), tid);
        kv_load(sB, Kb, kpitch, Vb, vpitch, TILE_CL(1), tid);
        kv_store(sA, lds, tid);
        kv_store(sB, lds + KV_BUF, tid); }
    __syncthreads();
    int s0 = 0, s1 = KV_BUF, s2 = 2 * KV_BUF;
    (void)grpA;
    for (int it = 0; it < nt; ++it) {
        const int kt = kt_first + it;
        kv_load(sA, Kb, kpitch, Vb, vpitch, TILE_CL(it + 2), tid);
        const unsigned bit = ((kt < 32 ? sel_lo : sel_hi) >> (kt & 31)) & 1u;
        bf16x8 pa[4];
        bf16x8 kf[8]; s16x4 vlo[8], vhi[8];
        f32x16 c0, c1;
        k_reads(kf, lds + s0, r32, hi);
        v_reads(vlo, vhi, lds + s0 + KV_VOFF, lane);
        __builtin_amdgcn_sched_barrier(0);
        qk_mfma(c0, c1, cneg, kf, qr);
        __builtin_amdgcn_sched_barrier(0);
        nsa_softmax<MODE>(c0, c1, pa, lsum, negmb, kt, m, trel, hi, bit, nmax, pw, carry);
        __builtin_amdgcn_sched_barrier(0);
        pv_mfma(o, vlo, vhi, pa);
        kv_store(sA, lds + s2, tid);
        __syncthreads();
        const int tmp = s0; s0 = s1; s1 = s2; s2 = tmp;
    }
#undef TILE_CL
}

__device__ __forceinline__ void nsa_item(const Args& A, LAS unsigned char* lds, int item, const int wv_) {
    unsigned char* ws = A.ws;
    const bf16_t* P = (const bf16_t*)(ws + WS_P);
    const int bg = item >> 6, m = item & 63;
    const int b = bg >> 1, g = bg & 1, T0 = 64 * m, w = wv_;
#define NSA_LANE() int tid_l = TIDX; asm volatile("" : "+v"(tid_l)); const int tid = tid_l, lane = tid & 63, r32 = lane & 31, hi = lane >> 5, hd = 4 * g + (w & 3), trel = 32 * (w >> 2) + r32, t = T0 + trel; \
                   const size_t tokrow = (size_t)(b * SEQ + t); (void)hd; (void)hi; (void)tokrow; (void)lane
    const float* mbp = (const float*)(ws + WS_MB);
    bf16x8 qr[4];
    f32x16 o[2]; float lsum;
    {   NSA_LANE();
        {
            const bf16_t* Qraw = P + tokrow * NCP + C_QN + hd * 64;
            u32x4 raw[4];
#pragma unroll
            for (int d0 = 0; d0 < 4; ++d0) raw[d0] = *(const u32x4*)(Qraw + 16 * d0 + 8 * hi);
            float y[32];
#pragma unroll
            for (int d0 = 0; d0 < 4; ++d0) { y[8 * d0] = bflo(raw[d0].x); y[8 * d0 + 1] = bfhi(raw[d0].x); y[8 * d0 + 2] = bflo(raw[d0].y); y[8 * d0 + 3] = bfhi(raw[d0].y);
                y[8 * d0 + 4] = bflo(raw[d0].z); y[8 * d0 + 5] = bfhi(raw[d0].z); y[8 * d0 + 6] = bflo(raw[d0].w); y[8 * d0 + 7] = bfhi(raw[d0].w); }
            float ss = 0.f;
#pragma unroll
            for (int i = 0; i < 32; ++i) ss += y[i] * y[i];
            ss += __shfl_xor(ss, 32);
            const float r = 1.f / sqrtf(ss * (1.f / 64.f) + EPSN);
            const float* gq = A.in[3];
#pragma unroll
            for (int d0 = 0; d0 < 4; ++d0) { const f32x4 ga = *(const f32x4*)(gq + 16 * d0 + 8 * hi), gb = *(const f32x4*)(gq + 16 * d0 + 8 * hi + 4);
                y[8 * d0] *= r * ga.x; y[8 * d0 + 1] *= r * ga.y; y[8 * d0 + 2] *= r * ga.z; y[8 * d0 + 3] *= r * ga.w; y[8 * d0 + 4] *= r * gb.x; y[8 * d0 + 5] *= r * gb.y; y[8 * d0 + 6] *= r * gb.z; y[8 * d0 + 7] *= r * gb.w; }
            const float2* rope = (const float2*)(ws + WS_ROPE) + t * 8;
#pragma unroll
            for (int j = 0; j < 8; ++j) { const float oth = __shfl_xor(y[j], 32); const float2 cs = rope[j];
                y[j] = hi ? (y[j] * cs.x + oth * cs.y) : (y[j] * cs.x - oth * cs.y); }
#pragma unroll
            for (int d0 = 0; d0 < 4; ++d0) { u32x4 u = {pk2(y[8 * d0] * C2, y[8 * d0 + 1] * C2), pk2(y[8 * d0 + 2] * C2, y[8 * d0 + 3] * C2), pk2(y[8 * d0 + 4] * C2, y[8 * d0 + 5] * C2), pk2(y[8 * d0 + 6] * C2, y[8 * d0 + 7] * C2)};
                qr[d0] = __builtin_bit_cast(bf16x8, u); }
        }
        const bf16_t* glp = P + tokrow * NCP + C_GL + hd * 3;
        LAS float* gls = (LAS float*)(lds + NS_GL) + tid;
        gls[0] = sigmoidf_(bf1(glp[0])); gls[512] = sigmoidf_(bf1(glp[1])); gls[1024] = sigmoidf_(bf1(glp[2]));
        LAS float* pw = (LAS float*)(lds + NS_PW) + (w * 32 + r32) * 65;
#pragma unroll
        for (int j = 0; j < 32; ++j) pw[hi * 32 + j] = 0.f;
        if (hi) pw[64] = 0.f;
        o[0] = splat16(0.f); o[1] = splat16(0.f); lsum = 0.f;
        const bf16_t* Kc = (const bf16_t*)(ws + WS_KCMP) + (size_t)((b * 2 + g) * 256) * 64; const bf16_t* Vc = (const bf16_t*)(ws + WS_VCMP) + (size_t)((b * 2 + g) * 256) * 64;
        nsa_branch<M_CMP>(lds, Kc, 64, Vc, 64, 0, ((4 * m + 2) >> 6) + 1, qr, -mbp[0], o, lsum, m, trel, tid, w, 0u, 0u, (t - 31) >> 4, pw);
    }
    float inv_c;
    {   NSA_LANE();
        lsum += __shfl_xor(lsum, 32);
        inv_c = lsum > 0.f ? 1.f / lsum : 0.f;
        LAS float* linv = (LAS float*)(lds + NS_LINV);
        if (hi == 0) linv[w * 32 + r32] = inv_c;
    }
    __syncthreads();
    {
        NSA_LANE();
        const LAS float* pwb = (const LAS float*)(lds + NS_PW);
        const LAS float* linv = (const LAS float*)(lds + NS_LINV);
        LAS unsigned long long* sell = (LAS unsigned long long*)(lds + NS_SEL);
        const int j = lane, blk = m;
        const bool valid = j <= blk, forced = (j == 0) || (j == blk) || (j == blk - 1);
        if (blk < 16) {
            const unsigned long long mk = __ballot(valid);
            if (lane < 8) sell[w * 8 + lane] = mk;
        } else {
            unsigned key[8], v[8];
#pragma unroll
            for (int i = 0; i < 8; ++i) {
                const int tok = w * 8 + i, half = tok >> 5, r = tok & 31;
                float sc2 = 0.f;
#pragma unroll
                for (int hh = 0; hh < 4; ++hh) sc2 += pwb[((half * 4 + hh) * 32 + r) * 65 + j] * linv[(half * 4 + hh) * 32 + r];
                const float sv = forced ? sc2 + 1.0e4f : sc2;
                key[i] = valid ? ((__float_as_uint(sv) & ~63u) | (unsigned)(63 - j)) : 0u;
                v[i] = key[i];
            }
#pragma unroll
            for (int k = 2; k <= 64; k <<= 1)
#pragma unroll
                for (int jj = k >> 1; jj > 0; jj >>= 1) {
                    const bool takemax = ((lane & jj) == 0) == ((lane & k) == 0);
#pragma unroll
                    for (int i = 0; i < 8; ++i) { const unsigned p = (unsigned)__shfl_xor((int)v[i], jj); const unsigned hi_ = v[i] > p ? v[i] : p, lo_ = v[i] > p ? p : v[i]; v[i] = takemax ? hi_ : lo_; }
                }
#pragma unroll
            for (int i = 0; i < 8; ++i) {
                const unsigned thr = (unsigned)__builtin_amdgcn_readlane((int)v[i], 15);
                const unsigned long long mk = __ballot(valid && key[i] >= thr);
                if (lane == 0) sell[w * 8 + i] = mk;
            }
        }
    }
    __syncthreads();
    {   NSA_LANE();
        const u32x2 sm = *(const LAS u32x2*)(lds + NS_SEL + trel * 8);
        LAS float* omix = (LAS float*)(lds + NS_PW) + w * 2048 + lane;
        const float sc = inv_c * ((const LAS float*)(lds + NS_GL))[tid];
#pragma unroll
        for (int i = 0; i < 16; ++i) { omix[i * 64] = o[0][i] * sc; omix[(16 + i) * 64] = o[1][i] * sc; }
        o[0] = splat16(0.f); o[1] = splat16(0.f); lsum = 0.f;
        const bf16_t* Ks = (const bf16_t*)(ws + WS_KSN) + (size_t)(b * SEQ) * 128 + g * 64; const bf16_t* Vs = P + (size_t)(b * SEQ) * NCP + C_VS + g * 64;
        nsa_branch<M_SLC>(lds, Ks, 128, Vs, NCP, 0, m + 1, qr, -mbp[1], o, lsum, m, trel, tid, w, sm.x, sm.y, 0, nullptr);
    }
    {   NSA_LANE();
        lsum += __shfl_xor(lsum, 32);
        const float inv = lsum > 0.f ? 1.f / lsum : 0.f;
        LAS float* omix = (LAS float*)(lds + NS_PW) + w * 2048 + lane;
        const float sc = inv * ((const LAS float*)(lds + NS_GL))[512 + tid];
#pragma unroll
        for (int i = 0; i < 16; ++i) { omix[i * 64] += o[0][i] * sc; omix[(16 + i) * 64] += o[1][i] * sc; }
        o[0] = splat16(0.f); o[1] = splat16(0.f); lsum = 0.f;
        const bf16_t* Kw = (const bf16_t*)(ws + WS_KWN) + (size_t)(b * SEQ) * 128 + g * 64; const bf16_t* Vw = P + (size_t)(b * SEQ) * NCP + C_VW + g * 64;
        const int kf0 = m >= 8 ? m - 8 : 0;
        nsa_branch<M_WIN>(lds, Kw, 128, Vw, NCP, kf0, m - kf0 + 1, qr, -mbp[2], o, lsum, m, trel, tid, w, 0u, 0u, 0, nullptr);
    }
    {   NSA_LANE();
        lsum += __shfl_xor(lsum, 32);
        const float inv = lsum > 0.f ? 1.f / lsum : 0.f;
        const LAS float* omix = (const LAS float*)(lds + NS_PW) + w * 2048 + lane;
        const float sc = inv * ((const LAS float*)(lds + NS_GL))[1024 + tid];
        const bf16_t* gp = P + tokrow * NCP + C_GN + hd * 64;
        bf16_t* dst = (bf16_t*)(ws + WS_XB) + tokrow * DM + hd * 64;
        u32x2 gvv[8];
#pragma unroll
        for (int e = 0; e < 8; ++e) gvv[e] = *(const u32x2*)(gp + (e >> 2) * 32 + 8 * (e & 3) + 4 * hi);
#pragma unroll
        for (int d0 = 0; d0 < 2; ++d0)
#pragma unroll
            for (int q = 0; q < 4; ++q) { const int d = d0 * 32 + 8 * q + 4 * hi;
                const u32x2 gv = gvv[d0 * 4 + q];
                const float g0 = bflo(gv.x), g1 = bfhi(gv.x), g2 = bflo(gv.y), g3 = bfhi(gv.y);
                const float v0 = o[d0][4 * q] * sc + omix[(d0 * 16 + 4 * q) * 64], v1 = o[d0][4 * q + 1] * sc + omix[(d0 * 16 + 4 * q + 1) * 64];
                const float v2 = o[d0][4 * q + 2] * sc + omix[(d0 * 16 + 4 * q + 2) * 64], v3 = o[d0][4 * q + 3] * sc + omix[(d0 * 16 + 4 * q + 3) * 64];
                u32x2 pk; pk.x = pk2(v0 * g0 * sigmoidf_(g0), v1 * g1 * sigmoidf_(g1)); pk.y = pk2(v2 * g2 * sigmoidf_(g2), v3 * g3 * sigmoidf_(g3));
                *(u32x2*)(dst + d) = pk; }
    }
#undef NSA_LANE
    __syncthreads();
}

#define XB_TMO      128
#define XB_XCNT(j)  (256  + 64 * (j))
#define XB_XSUB(j)  (1280 + 64 * (j))
#define XB_XGEN(j)  (2304 + 64 * (j))
#define XB_TOP      3328
#define XB_TOPGEN   3392
#define XCD_BAR_WORDS 3456
#define XB_SPIN_CAP (1u << 18)

__device__ __forceinline__ unsigned xb_ld(unsigned* p)              { return __hip_atomic_load(p, __ATOMIC_RELAXED, __HIP_MEMORY_SCOPE_AGENT); }
__device__ __forceinline__ unsigned xb_add(unsigned* p, unsigned v) { return __hip_atomic_fetch_add(p, v, __ATOMIC_RELAXED, __HIP_MEMORY_SCOPE_AGENT); }
__device__ __forceinline__ unsigned xb_xcc_id() { return (unsigned)__builtin_amdgcn_s_getreg((3 << 11) | 20) & 0xFu; }
#define XB_SPIN(cond, bar) do { unsigned _sp = 0; while (cond) { __builtin_amdgcn_s_sleep(1); \
    if ((++_sp & 255u) == 0u) { if (xb_ld(&(bar)[XB_TMO])) break; if (_sp > XB_SPIN_CAP) { atomicAdd(&(bar)[XB_TMO], 1u); break; } } } } while (0)

struct XcdBarrier {
    unsigned* bar; unsigned x;
    volatile LAS unsigned* st;
};

__device__ __forceinline__ XcdBarrier xcd_barrier_post(unsigned* bar, volatile LAS unsigned* st, const int wv_) {
    XcdBarrier b; b.bar = bar; b.x = xb_xcc_id(); b.st = st;
    if (TIDX == 0) (void)xb_add(&bar[XB_XCNT(b.x)], 1u);
    return b;
}
__device__ __forceinline__ void xcd_barrier_complete(unsigned* bar, unsigned x, unsigned& nloc, unsigned& nx) {
    const unsigned G = gridDim.x * gridDim.y * gridDim.z;
    unsigned sum, cnt, mine, sp = 0u;
    for (;;) {
        sum = 0u; cnt = 0u; mine = 0u;
#pragma unroll
        for (unsigned j = 0; j < 16; ++j) { const unsigned c = xb_ld(&bar[XB_XCNT(j)]); sum += c; cnt += (c > 0u) ? 1u : 0u; mine = (j == x) ? c : mine; }
        if (sum == G) break;
        __builtin_amdgcn_s_sleep(1);
        if ((++sp & 255u) == 0u) { if (xb_ld(&bar[XB_TMO])) break; if (sp > XB_SPIN_CAP) { atomicAdd(&bar[XB_TMO], 1u); break; } }
    }
    nloc = mine > 0u ? mine : 1u; nx = cnt > 0u ? cnt : 1u;
}

__device__ __forceinline__ void xcd_barrier(const XcdBarrier& b, const int wv_) {
    asm volatile("s_waitcnt vmcnt(0)" ::: "memory");
    __syncthreads();
    if (TIDX == 0) {
        unsigned* bar = b.bar;
        __builtin_amdgcn_s_waitcnt(0);
        unsigned nloc = b.st[0], nx = b.st[1];
        if (nloc == 0u) { xcd_barrier_complete(bar, b.x, nloc, nx); b.st[0] = nloc; b.st[1] = nx; }
        const unsigned old = xb_add(&bar[XB_XSUB(b.x)], 1u);
        const unsigned gen = old / nloc;
        if (old + 1u == (gen + 1u) * nloc) {
            __builtin_amdgcn_fence(__ATOMIC_RELEASE, "agent");
            asm volatile("s_waitcnt vmcnt(0)" ::: "memory");
            const unsigned og = xb_add(&bar[XB_TOP], 1u);
            const unsigned tg = og / nx;
            if (og + 1u == (tg + 1u) * nx) xb_add(&bar[XB_TOPGEN], 1u);
            else XB_SPIN(xb_ld(&bar[XB_TOPGEN]) == tg, bar);
            __builtin_amdgcn_fence(__ATOMIC_ACQUIRE, "agent");
            xb_add(&bar[XB_XGEN(b.x)], 1u);
            asm volatile("s_waitcnt vmcnt(0)" ::: "memory");
        } else {
            XB_SPIN(xb_ld(&bar[XB_XGEN(b.x)]) == gen, bar);
            __builtin_amdgcn_fence(__ATOMIC_ACQUIRE, "agent");
            asm volatile("s_waitcnt vmcnt(0)" ::: "memory");
        }
    }
    __syncthreads();
}

#define REP_P0 1
#define REP_G1 1
#define REP_P2 1
#define REP_SB 1
#define REP_WIN 1
#define REP_CMP 1
#define REP_SLC 1
#define REP_G2 1
#define XSYNC 0
__global__ void __launch_bounds__(512, 2) hybrid_fwd(Args A) {
    extern __shared__ __attribute__((aligned(16))) unsigned char lds_raw[];
    LAS unsigned char* lds = (LAS unsigned char*)lds_raw;
    cg::grid_group grid = cg::this_grid();
    const int wv_ = __builtin_amdgcn_readfirstlane((int)threadIdx.x >> 6);
    volatile LAS unsigned* bst = (volatile LAS unsigned*)(lds + 131072 + 64);
    if (TIDX < 2) bst[TIDX] = 0u;
    __syncthreads();
    XcdBarrier xbar = xcd_barrier_post((unsigned*)(A.ws + WS_CTL), bst, wv_);
    if (A.ws == nullptr) grid.sync();
#define GSYNC() xcd_barrier(xbar, wv_)
    unsigned char* ws = A.ws;
    const int G = gridDim.x, bx = blockIdx.x;

    for (int rep = 0; rep < REP_P0; ++rep) phase0(A, lds, wv_);
    GSYNC();
    for (int rep = 0; rep < XSYNC; ++rep) GSYNC();
#pragma unroll 1
    for (int rep = 0; rep < REP_G1; ++rep) {
        pg8::Gemm g{(const pg8::bf16_t*)(ws + WS_XB), (const pg8::bf16_t*)(ws + WS_WIN), NTOK, NCP, DM}; pg8::StaticOrder S; S.init(NTOK, NCP, G, bx);
        pg8::EpiProj E{(pg8::bf16_t*)(ws + WS_P), NCP, (const float*)(ws + WS_RSTD)};
        pg8::gemm_phase<pg8::EpiProj, pg8::StaticOrder, true, true>(lds, g, S, E, wv_);
    }
    GSYNC();
    if (G != 256) {
        for (int it = bx; it < 128; it += G) compress_item(A, lds, it, wv_);
        phase2_normrope(A, wv_, bx * 8 + wv_, G * 8);
        GSYNC();
    }
    if (G == 256) {
        const int x = bx & 7, j = bx >> 3;
        if (j >= 16) compress_item(A, lds, ((j - 16) >> 3) * 64 + (x >> 1) * 16 + (x & 1) * 8 + (j & 7), wv_);
        else knorm_bg(A, wv_, x, j * 8 + wv_, 16 * 8);
        group_arrive((unsigned*)(ws + WS_CTL) + 3584 + 64 * x, wv_);
    }
    for (int rep = 0; rep < REP_SB; ++rep) for (int it = bx; it < 512; it += G) {
        int item = it;
        if (G == 256) { const int x = bx & 7, idx = (bx >> 3) * 2 + (it >> 8); item = (x * 4 + (idx >> 4)) * 16 + (idx & 15); }
        attn_item<M_SB>(A, lds, item, wv_);
    }
    if (G == 256) group_wait((unsigned*)(ws + WS_CTL) + 3584 + 64 * (bx & 7), 32u, wv_);
    for (int rep = 0; rep < REP_SLC; ++rep) for (int it = bx; it < 512; it += G) {
        int item;
        if (G == 256) { const int x = bx & 7, j = bx >> 3; item = x * 64 + ((it >> 8) ? 31 - j : 32 + j); }
        else { if (it < 256) item = (it >> 5) * 64 + 32 + (it & 31); else item = ((it - 256) >> 5) * 64 + 31 - ((it - 256) & 31); }
        nsa_item(A, lds, item, wv_);
    }
    GSYNC();
    for (int rep = 0; rep < REP_G2; ++rep) {
        pg8::Gemm g{(const pg8::bf16_t*)(ws + WS_XB), (const pg8::bf16_t*)(ws + WS_WOUT), NTOK, DM, DM}; pg8::StaticOrder S; S.init(NTOK, DM, G, bx);
        pg8::EpiOut E{A.in[0], A.out, DM};
        pg8::gemm_phase<pg8::EpiOut, pg8::StaticOrder, true, true>(lds, g, S, E, wv_);
    }
}

extern "C" void kernel_launch(void* const* d_in, const int* in_sizes, int n_in, void* d_out, int out_size, void* d_ws, size_t ws_size, hipStream_t stream) {
    static int grid = 0;
    if (grid == 0) {
        if (n_in != 16 || ws_size < WS_END) { fprintf(stderr, "kernel_launch: unexpected inputs (n_in %d, ws %zu)\n", n_in, ws_size); grid = -1; return; }
        int dev = 0, cus = 0, per_cu = 0;
        hipGetDevice(&dev);
        hipDeviceGetAttribute(&cus, hipDeviceAttributeMultiprocessorCount, dev);
        if (hipFuncSetAttribute((const void*)hybrid_fwd, hipFuncAttributeMaxDynamicSharedMemorySize, LDS_BYTES) != hipSuccess) { fprintf(stderr, "kernel_launch: hipFuncSetAttribute failed\n"); }
        hipOccupancyMaxActiveBlocksPerMultiprocessor(&per_cu, (const void*)hybrid_fwd, 512, LDS_BYTES);
        if (per_cu < 1) { fprintf(stderr, "kernel_launch: occupancy query says %d blocks/CU\n", per_cu); per_cu = 1; }
        (void)hipGetLastError();
        grid = cus * 1;
    }
    if (grid < 0) return;
    Args a{};
    for (int i = 0; i < 16; ++i) a.in[i] = (const float*)d_in[i];
    a.out = (float*)d_out; a.ws = (unsigned char*)d_ws;
    for (int i = 0; i < 8; ++i) a.invf[i] = std::pow(500000.0, -(double)(2 * i) / 16.0) / 6.283185307179586476925;
    if (hipMemsetAsync((char*)d_ws + WS_CTL, 0, 16384, stream) != hipSuccess) { fprintf(stderr, "kernel_launch: memset failed\n"); return; }
    void* args[] = {&a};
    hipError_t e = hipLaunchCooperativeKernel((const void*)hybrid_fwd, dim3(grid), dim3(512), args, LDS_BYTES, stream);
    if (e != hipSuccess) fprintf(stderr, "cooperative launch failed: %s (grid %d)\n", hipGetErrorString(e), grid);
}
```

```cpp
#include <hip/hip_runtime.h>
#include <hip/hip_cooperative_groups.h>
#include <cstdio>
#include <cstdint>
#include <cmath>
namespace cg = cooperative_groups;
__device__ __forceinline__ int lane_id_opaque_g() { int x; asm volatile("v_mbcnt_lo_u32_b32 %0, -1, 0\n\tv_mbcnt_hi_u32_b32 %0, -1, %0" : "=v"(x)); return x; }
#define TIDX_G ((wv_ << 6) + lane_id_opaque_g())
namespace pg8 {
#define PG8_LAS __attribute__((address_space(3)))
typedef unsigned short bf16_t;
typedef short bf16x8 __attribute__((ext_vector_type(8)));
typedef float f32x4 __attribute__((ext_vector_type(4)));
typedef unsigned u32x4 __attribute__((ext_vector_type(4)));
constexpr int BM = 256, BK = 64, HALF = 128, HTB = HALF * BK * 2  , STAGE_BYTES = 8 * HTB, NXCD = 8, WGM = 8;

__host__ __device__ __forceinline__ int lds_byte(int r, int c) { const int st = (r >> 4) * 2 + (c >> 5), rr = r & 15, cc = c & 31, ob = rr * 64 + cc * 2; return st * 1024 + (ob ^ (((ob >> 9) & 1) << 5)); }
__host__ __device__ __forceinline__ void stage_rc(int b, int& R, int& C) { const int st = b / 1024, sb = b % 1024, swz = sb ^ (((sb >> 9) & 1) << 5); R = (st >> 1) * 16 + swz / 64; C = (st & 1) * 32 + (swz % 64) / 2; }
__host__ __device__ __forceinline__ int perm32(int rho) { const int n = rho >> 4, i = rho & 15; return 8 * (i >> 2) + 4 * n + (i & 3); }

struct Unit { int pm, pn; };
struct Gemm { const bf16_t* A; const bf16_t* Bt; int M, N, K; };

struct StaticOrder {
    int nM, nN, nwg, G, c;
    __host__ __device__ void init(int M, int N, int G_, int c_) { nM = M / BM; nN = N / BM; nwg = nM * nN; G = G_; c = c_; }
    __host__ __device__ bool next(int i, Unit& u) const {
        const long L = (long)i * G + c; if (L >= nwg) return false;
        int wgid = (int)L; { const int q = nwg / NXCD, r = nwg % NXCD, xcd = wgid % NXCD, off = wgid / NXCD; wgid = (xcd < r ? xcd * (q + 1) : r * (q + 1) + (xcd - r) * q) + off; }
        const int nig = WGM * nN, gid = wgid / nig, fm = gid * WGM, gsz = (nM - fm) < WGM ? (nM - fm) : WGM;
        u.pm = fm + ((wgid % nig) % gsz); u.pn = (wgid % nig) / gsz; return true;
    }
    __device__ __forceinline__ void a_ready(const Unit&) const {}
    __device__ __forceinline__ void done(const Unit&) const {}
};

__device__ __forceinline__ unsigned cvt_pk_bf16(float lo, float hi) { unsigned r; asm volatile("v_cvt_pk_bf16_f32 %0, %1, %2" : "=v"(r) : "v"(lo), "v"(hi)); return r; }
struct EpiProj {
    static constexpr bool PERM = true, AFTER_DRAIN = false;
    bf16_t* O; int ldc; const float* rstd;
    __device__ __forceinline__ void operator()(const f32x4 (&acc)[2][2][4][2], const Unit& u, int wr, int wc, int fr, int fq) const {
        const int row0 = u.pm * BM + wr * 64 + fr; const int col0 = u.pn * BM + wc * 32 + 8 * fq;
        float sc[2][4];
#pragma unroll
        for (int ai = 0; ai < 2; ++ai)
#pragma unroll
            for (int m = 0; m < 4; ++m) sc[ai][m] = rstd[row0 + ai * HALF + m * 16];
#pragma unroll
        for (int ai = 0; ai < 2; ++ai)
#pragma unroll
            for (int m = 0; m < 4; ++m) { const int row = row0 + ai * HALF + m * 16; const float s = sc[ai][m]; bf16_t* rowp = O + (size_t)row * ldc + col0;
#pragma unroll
                for (int bj = 0; bj < 2; ++bj) { f32x4 v0 = acc[ai][bj][m][0] * s, v1 = acc[ai][bj][m][1] * s;
                    u32x4 w; w.x = cvt_pk_bf16(v0[0], v0[1]); w.y = cvt_pk_bf16(v0[2], v0[3]); w.z = cvt_pk_bf16(v1[0], v1[1]); w.w = cvt_pk_bf16(v1[2], v1[3]);
                    *(u32x4*)(rowp + bj * HALF) = w; } }
    }
};
struct EpiOut {
    static constexpr bool PERM = true, AFTER_DRAIN = false;
    const float* X; float* O; int ldc;
    __device__ __forceinline__ void operator()(const f32x4 (&acc)[2][2][4][2], const Unit& u, int wr, int wc, int fr, int fq) const {
        const int row0 = u.pm * BM + wr * 64 + fr; const int col0 = u.pn * BM + wc * 32 + 8 * fq;
#pragma unroll
        for (int ai = 0; ai < 2; ++ai) {
            f32x4 xa[4][2][2];
#pragma unroll
            for (int m = 0; m < 4; ++m)
#pragma unroll
                for (int bj = 0; bj < 2; ++bj) { const size_t off = (size_t)(row0 + ai * HALF + m * 16) * ldc + col0 + bj * HALF;
                    xa[m][bj][0] = *(const f32x4*)(X + off); xa[m][bj][1] = *(const f32x4*)(X + off + 4); }
#pragma unroll
            for (int m = 0; m < 4; ++m)
#pragma unroll
                for (int bj = 0; bj < 2; ++bj) { const size_t off = (size_t)(row0 + ai * HALF + m * 16) * ldc + col0 + bj * HALF;
                    *(f32x4*)(O + off) = xa[m][bj][0] + acc[ai][bj][m][0]; *(f32x4*)(O + off + 4) = xa[m][bj][1] + acc[ai][bj][m][1]; }
        }
    }
};
template <class Epi, class Sched, bool ALIGN_EPI = false, bool SP2 = false>
__device__ __forceinline__ void gemm_phase(PG8_LAS unsigned char* lds, const Gemm g, const Sched& S, const Epi& E, const int wv_) {
    int tid_l = TIDX_G; asm volatile("" : "+v"(tid_l));
    const int tid = tid_l, wid = __builtin_amdgcn_readfirstlane(tid >> 6), lane = tid & 63, wr = wid >> 2, wc = wid & 3, fr = lane & 15, fq = lane >> 4;
    const int K = g.K, nt = K / BK;
    unsigned voffA[2], voffB[2];
#pragma unroll
    for (int i = 0; i < 2; ++i) { int R, C; stage_rc(tid * 16 + i * 8192, R, C); const int Rb = Epi::PERM ? ((R & ~31) + perm32(R & 31)) : R;
        voffA[i] = (unsigned)(R * K + C) * 2u; voffB[i] = (unsigned)(Rb * K + C) * 2u; }
    const size_t kstep = (size_t)(BK * 2);
    const size_t hstep = (size_t)HALF * K * 2;
    const size_t tstep = 2 * hstep;
    const unsigned ldsw = (unsigned)wid * 1024u;
    const int aoff = lds_byte(wr * 64 + fr, fq * 8), boff = lds_byte(wc * 32 + fr, fq * 8);
#define PG8_SA(b, h) (((b) * 2 + (h)) * HTB)
#define PG8_SB(b, h) ((4 + (b) * 2 + (h)) * HTB)
#define PG8_STAGE(bufoff, gbase, voff) do { _Pragma("unroll") for (int _i = 0; _i < 2; ++_i) \
        __builtin_amdgcn_global_load_lds((const unsigned*)((const char*)(gbase) + (voff)[_i]), (PG8_LAS unsigned*)(lds + (bufoff) + ldsw + _i * 8192), 16, 0, 0); } while (0)
#define PG8_LDA(dst, b, h) do { _Pragma("unroll") for (int m = 0; m < 4; ++m) _Pragma("unroll") for (int k = 0; k < 2; ++k) dst[m][k] = *(const PG8_LAS bf16x8*)(lds + PG8_SA(b, h) + aoff + m * 2048 + k * 1024); } while (0)
#define PG8_LDB(dst, b, h) do { _Pragma("unroll") for (int n = 0; n < 2; ++n) _Pragma("unroll") for (int k = 0; k < 2; ++k) dst[n][k] = *(const PG8_LAS bf16x8*)(lds + PG8_SB(b, h) + boff + n * 2048 + k * 1024); } while (0)
#define PG8_MMA(ai, bj, At, Bt) do { __builtin_amdgcn_s_setprio(1); _Pragma("unroll") for (int m = 0; m < 4; ++m) _Pragma("unroll") for (int n = 0; n < 2; ++n) _Pragma("unroll") for (int k = 0; k < 2; ++k) \
        acc[ai][bj][m][n] = __builtin_amdgcn_mfma_f32_16x16x32_bf16(Bt[n][k], At[m][k], acc[ai][bj][m][n], 0, 0, 0); __builtin_amdgcn_s_setprio(0); } while (0)
#define PG8_WAIT_V(n) asm volatile("s_waitcnt vmcnt(" #n ")" ::: "memory")
#define PG8_WAIT_L(n) asm volatile("s_waitcnt lgkmcnt(" #n ")" ::: "memory")
#define PG8_BAR __builtin_amdgcn_s_barrier()
#define PG8_SCHED __builtin_amdgcn_sched_barrier(0)
    Unit cur, nxt; int ui = 0;
    if (!S.next(0, cur)) return;
    f32x4 acc[2][2][4][2];
#pragma unroll
    for (int a = 0; a < 2; ++a)
#pragma unroll
        for (int b = 0; b < 2; ++b)
#pragma unroll
            for (int m = 0; m < 4; ++m)
#pragma unroll
                for (int n = 0; n < 2; ++n) acc[a][b][m][n] = (f32x4){0.f, 0.f, 0.f, 0.f};
    bf16x8 At[4][2], B0[2][2], B1[2][2];
    const char* cA = (const char*)g.A + (size_t)cur.pm * tstep; const char* cB = (const char*)g.Bt + (size_t)cur.pn * tstep;
    S.a_ready(cur);
    if constexpr (SP2) {
        PG8_STAGE(PG8_SB(0, 0), cB, voffB); PG8_STAGE(PG8_SB(0, 1), cB + hstep, voffB); PG8_STAGE(PG8_SA(0, 0), cA, voffA); PG8_STAGE(PG8_SA(0, 1), cA + hstep, voffA);
        if (wr == 1) PG8_BAR;
        PG8_WAIT_V(2); PG8_BAR;
        PG8_STAGE(PG8_SB(1, 0), cB + kstep, voffB); PG8_STAGE(PG8_SA(1, 0), cA + kstep, voffA); PG8_STAGE(PG8_SB(1, 1), cB + hstep + kstep, voffB);
        PG8_WAIT_V(6); PG8_BAR;
    } else {
        PG8_STAGE(PG8_SB(0, 0), cB, voffB); PG8_STAGE(PG8_SA(0, 0), cA, voffA); PG8_STAGE(PG8_SB(0, 1), cB + hstep, voffB); PG8_STAGE(PG8_SA(0, 1), cA + hstep, voffA);
        if (wr == 1) PG8_BAR;
        PG8_WAIT_V(4); PG8_BAR;
        PG8_STAGE(PG8_SB(1, 0), cB + kstep, voffB); PG8_STAGE(PG8_SA(1, 0), cA + kstep, voffA); PG8_STAGE(PG8_SB(1, 1), cB + hstep + kstep, voffB);
        PG8_WAIT_V(6); PG8_BAR;
    }
    for (;;) {
        const bool has_next = S.next(ui + 1, nxt);
        const char* nA = has_next ? (const char*)g.A + (size_t)nxt.pm * tstep : cA; const char* nB = has_next ? (const char*)g.Bt + (size_t)nxt.pn * tstep : cB;
        for (int t = 0; t < nt; t += 2) {
            const bool last = (t == nt - 2);
            const char* a1 = cA + (size_t)(t + 1) * kstep;
            const char* a2 = last ? nA : cA + (size_t)(t + 2) * kstep; const char* b2 = last ? nB : cB + (size_t)(t + 2) * kstep;
            const char* a3 = a2 + kstep; const char* b3 = b2 + kstep;
            if (last && has_next) S.a_ready(nxt);
            if constexpr (SP2) {
            PG8_LDB(B0, 0, 0); PG8_LDB(B1, 0, 1); PG8_SCHED; PG8_LDA(At, 0, 0); PG8_STAGE(PG8_SA(1, 1), a1 + hstep, voffA);
            PG8_WAIT_V(8); PG8_WAIT_L(0); PG8_BAR; PG8_MMA(0, 0, At, B0); PG8_MMA(0, 1, At, B1); PG8_BAR; PG8_SCHED;
            PG8_LDA(At, 0, 1); PG8_STAGE(PG8_SB(0, 0), b2, voffB); PG8_STAGE(PG8_SB(0, 1), b2 + hstep, voffB); PG8_STAGE(PG8_SA(0, 0), a2, voffA);
            PG8_WAIT_V(8); PG8_WAIT_L(0); PG8_BAR; PG8_MMA(1, 0, At, B0); PG8_MMA(1, 1, At, B1); PG8_BAR; PG8_SCHED;
            PG8_LDB(B0, 1, 0); PG8_LDB(B1, 1, 1); PG8_SCHED; PG8_LDA(At, 1, 0); PG8_STAGE(PG8_SA(0, 1), a2 + hstep, voffA);
            PG8_WAIT_V(8); PG8_WAIT_L(0); PG8_BAR; PG8_MMA(0, 0, At, B0); PG8_MMA(0, 1, At, B1); PG8_BAR; PG8_SCHED;
            PG8_LDA(At, 1, 1); PG8_STAGE(PG8_SB(1, 0), b3, voffB); PG8_STAGE(PG8_SB(1, 1), b3 + hstep, voffB); PG8_STAGE(PG8_SA(1, 0), a3, voffA);
            PG8_WAIT_V(8); PG8_WAIT_L(0); PG8_BAR; PG8_MMA(1, 0, At, B0); PG8_MMA(1, 1, At, B1); PG8_BAR; PG8_SCHED;
            } else {
            PG8_LDB(B0, 0, 0); PG8_SCHED; PG8_LDA(At, 0, 0); PG8_STAGE(PG8_SA(1, 1), a1 + hstep, voffA);
            PG8_WAIT_L(8); PG8_BAR; PG8_WAIT_L(0); PG8_MMA(0, 0, At, B0); PG8_BAR; PG8_SCHED;
            PG8_LDB(B1, 0, 1); PG8_STAGE(PG8_SB(0, 0), b2, voffB);
            PG8_BAR; PG8_WAIT_L(0); PG8_MMA(0, 1, At, B1); PG8_BAR;
            PG8_LDA(At, 0, 1); PG8_STAGE(PG8_SA(0, 0), a2, voffA);
            PG8_BAR; PG8_WAIT_L(0); PG8_MMA(1, 0, At, B0); PG8_BAR; PG8_SCHED;
            PG8_STAGE(PG8_SB(0, 1), b2 + hstep, voffB);
            PG8_WAIT_V(6); PG8_BAR; PG8_MMA(1, 1, At, B1); PG8_BAR;
            PG8_LDB(B0, 1, 0); PG8_SCHED; PG8_LDA(At, 1, 0); PG8_STAGE(PG8_SA(0, 1), a2 + hstep, voffA);
            PG8_WAIT_L(8); PG8_BAR; PG8_WAIT_L(0); PG8_MMA(0, 0, At, B0); PG8_BAR; PG8_SCHED;
            PG8_LDB(B1, 1, 1); PG8_STAGE(PG8_SB(1, 0), b3, voffB);
            PG8_BAR; PG8_WAIT_L(0); PG8_MMA(0, 1, At, B1); PG8_BAR;
            PG8_LDA(At, 1, 1); PG8_STAGE(PG8_SA(1, 0), a3, voffA);
            PG8_BAR; PG8_WAIT_L(0); PG8_MMA(1, 0, At, B0); PG8_BAR; PG8_SCHED;
            PG8_STAGE(PG8_SB(1, 1), b3 + hstep, voffB);
            PG8_WAIT_V(6); PG8_BAR; PG8_MMA(1, 1, At, B1); PG8_BAR;
            }
        }
        if constexpr (ALIGN_EPI) { if (wr == 0) PG8_BAR; }
        if constexpr (!Epi::AFTER_DRAIN) { E(acc, cur, wr, wc, fr, fq); S.done(cur); }
        if (!has_next) break;
#pragma unroll
        for (int a = 0; a < 2; ++a)
#pragma unroll
            for (int b = 0; b < 2; ++b)
#pragma unroll
                for (int m = 0; m < 4; ++m)
#pragma unroll
                    for (int n = 0; n < 2; ++n) acc[a][b][m][n] = (f32x4){0.f, 0.f, 0.f, 0.f};
        cur = nxt; cA = nA; cB = nB; ++ui;
        if constexpr (ALIGN_EPI) { if (wr == 1) PG8_BAR; }
    }
    PG8_WAIT_V(0);
    if constexpr (!ALIGN_EPI) { if (wr == 0) PG8_BAR; }
    PG8_BAR;
    if constexpr (Epi::AFTER_DRAIN) { E.fused(acc, cur, wr, wc, fr, fq, lds, wid, lane); S.done(cur); }
#undef PG8_SA
#undef PG8_SB
#undef PG8_STAGE
#undef PG8_LDA
#undef PG8_LDB
#undef PG8_MMA
#undef PG8_WAIT_V
#undef PG8_WAIT_L
#undef PG8_BAR
#undef PG8_SCHED
}
}

#define LAS __attribute__((address_space(3)))
typedef unsigned short bf16_t;
typedef short bf16x8 __attribute__((ext_vector_type(8)));
typedef short s16x4 __attribute__((ext_vector_type(4)));
typedef float f32x4 __attribute__((ext_vector_type(4)));
typedef float f32x16 __attribute__((ext_vector_type(16)));
typedef unsigned u32x4 __attribute__((ext_vector_type(4)));
typedef unsigned u32x2 __attribute__((ext_vector_type(2)));

constexpr int NB = 4, SEQ = 4096, NTOK = NB * SEQ, DM = 1024, NCP = 4096, NCOLS = 3864;
constexpr int C_QN = 0, C_KC = 512, C_VC = 640, C_KS = 768, C_VS = 896, C_KW = 1024, C_VW = 1152, C_GN = 1280, C_QSB = 1792, C_KSB = 2304, C_VSB = 2816, C_GSB = 3328, C_GL = 3840;
constexpr size_t MiB = 1u << 20;
constexpr size_t WS_WIN = 0, WS_WOUT = 8 * MiB, WS_W1T = 10 * MiB, WS_RSTD = 11 * MiB, WS_ROPE = 11 * MiB + 64 * 1024, WS_CBIAS = 11 * MiB + 384 * 1024, WS_MB = 11 * MiB + 400 * 1024;
constexpr size_t WS_KCMP = 12 * MiB, WS_VCMP = 12 * MiB + 512 * 1024, WS_SEL = 13 * MiB, WS_CTL = 14 * MiB, WS_XB = 16 * MiB, WS_P = 48 * MiB, WS_QN = 176 * MiB, WS_KSN = 192 * MiB, WS_KWN = 196 * MiB, WS_OC = 200 * MiB, WS_OW = 216 * MiB, WS_END = 232 * MiB;
constexpr int LDS_BYTES = 135168;
constexpr float C2 = 0.125f * 1.4426950408889634f;
constexpr float EPSN = 1e-6f;

struct Args { const float* in[16]; float* out; unsigned char* ws; double invf[8]; };

__device__ __forceinline__ unsigned pk2(float lo, float hi) {
    typedef float f2_t __attribute__((ext_vector_type(2))); typedef __bf16 b2_t __attribute__((ext_vector_type(2)));
    f2_t v = {lo, hi}; b2_t b = __builtin_convertvector(v, b2_t); return __builtin_bit_cast(unsigned, b); }
__device__ __forceinline__ float bflo(unsigned u) { return __uint_as_float(u << 16); }
__device__ __forceinline__ float bfhi(unsigned u) { return __uint_as_float(u & 0xffff0000u); }
__device__ __forceinline__ float bf1(bf16_t h) { return __uint_as_float(((unsigned)h) << 16); }
__device__ __forceinline__ float ex2(float x) { return __builtin_amdgcn_exp2f(x); }
__device__ __forceinline__ float lg2(float x) { return __builtin_amdgcn_logf(x); }
__device__ __forceinline__ float sigmoidf_(float x) { return 1.f / (1.f + __expf(-x)); }
__device__ __forceinline__ float wave_sum(float v) {
#pragma unroll
    for (int o = 1; o < 64; o <<= 1) v += __shfl_xor(v, o);
    return v;
}
__device__ __forceinline__ float wave_max(float v) {
#pragma unroll
    for (int o = 1; o < 64; o <<= 1) v = fmaxf(v, __shfl_xor(v, o));
    return v;
}
#define LDS_WAIT() asm volatile("s_waitcnt lgkmcnt(0)" ::: "memory")
__device__ __forceinline__ int lane_id_opaque() { int x; asm volatile("v_mbcnt_lo_u32_b32 %0, -1, 0\n\tv_mbcnt_hi_u32_b32 %0, -1, %0" : "=v"(x)); return x; }
#define TIDX ((wv_ << 6) + lane_id_opaque())
#define MFMA32(a, b, c) __builtin_amdgcn_mfma_f32_32x32x16_bf16((a), (b), (c), 0, 0, 0)

template <int MODE>
__device__ __forceinline__ void transpose_item(const float* W, int ldw, const float* gain, bf16_t* WT, int Kd, LAS float* scr, int kb, int nb, int lane) {
    const int k0 = 64 * kb, n0 = 32 * nb, n = n0 + (lane & 31);
    int sc = n; bool ok = true;
    if (MODE == 0) { if (n < 1280) sc = n; else if (n < 3840) sc = n + 24; else if (n < NCOLS) sc = n - 3840 + 1280; else { sc = 0; ok = false; } }
    float tv[32];
#pragma unroll
    for (int i = 0; i < 32; ++i) { const int kk = 2 * i + (lane >> 5); tv[i] = ok ? W[(size_t)(k0 + kk) * ldw + sc] : 0.f; }
#pragma unroll
    for (int i = 0; i < 32; ++i) { const int kk = 2 * i + (lane >> 5); float v = tv[i]; if (MODE == 0) v *= gain[k0 + kk]; scr[kk * 33 + (lane & 31)] = v; }
    LDS_WAIT();
    const int c = lane & 7;
#pragma unroll
    for (int j = 0; j < 4; ++j) { const int nn = (lane >> 3) + 8 * j; const LAS float* s = scr + (8 * c) * 33 + nn;
        u32x4 o; o.x = pk2(s[0 * 33], s[1 * 33]); o.y = pk2(s[2 * 33], s[3 * 33]); o.z = pk2(s[4 * 33], s[5 * 33]); o.w = pk2(s[6 * 33], s[7 * 33]);
        *(u32x4*)(WT + (size_t)(n0 + nn) * Kd + k0 + 8 * c) = o; }
    LDS_WAIT();
}

__device__ __forceinline__ void phase0(const Args& A, LAS unsigned char* lds, const int wv_) {
    const int tid = TIDX, lane = tid & 63, wave = __builtin_amdgcn_readfirstlane(tid >> 6);
    const int gw = blockIdx.x * 8 + wave, NGW = gridDim.x * 8;
    unsigned char* ws = A.ws;
    LAS float* scr = (LAS float*)(lds + wave * 8704);
    bf16_t* WinT = (bf16_t*)(ws + WS_WIN); bf16_t* WoutT = (bf16_t*)(ws + WS_WOUT); bf16_t* W1T = (bf16_t*)(ws + WS_W1T);
    constexpr int I_IN = 16 * 128, I_OUT = 16 * 32, I_W1 = 32 * 2;
    for (int it = gw; it < I_IN + I_OUT + 2 * I_W1; it += NGW) {
        int r = it;
        if (r < I_IN) { transpose_item<0>(A.in[2], NCOLS, A.in[1], WinT, DM, scr, r / 128, r % 128, lane); continue; } r -= I_IN;
        if (r < I_OUT) { transpose_item<1>(A.in[15], DM, nullptr, WoutT, DM, scr, r / 32, r % 32, lane); continue; } r -= I_OUT;
        if (r < I_W1) { transpose_item<1>(A.in[8], 64, nullptr, W1T, 2048, scr, r / 2, r % 2, lane); continue; } r -= I_W1;
        transpose_item<1>(A.in[12], 64, nullptr, W1T + 64 * 2048, 2048, scr, r / 2, r % 2, lane);
    }
    const float* x = A.in[0]; bf16_t* xb = (bf16_t*)(ws + WS_XB); float* rstd = (float*)(ws + WS_RSTD);
    for (int m0 = gw; m0 < NTOK; m0 += 2 * NGW) {
        f32x4 v[2][4];
#pragma unroll
        for (int u = 0; u < 2; ++u) { const int m = m0 + u * NGW; const f32x4* xr = (const f32x4*)(x + (size_t)m * DM) + lane;
#pragma unroll
            for (int j = 0; j < 4; ++j) v[u][j] = __builtin_nontemporal_load(xr + 64 * j); }
#pragma unroll
        for (int u = 0; u < 2; ++u) { const int m = m0 + u * NGW; float s = 0.f;
#pragma unroll
            for (int j = 0; j < 4; ++j) s += (v[u][j].x * v[u][j].x + v[u][j].y * v[u][j].y) + (v[u][j].z * v[u][j].z + v[u][j].w * v[u][j].w);
            s = wave_sum(s);
            if (lane == 0) rstd[m] = 1.f / sqrtf(s * (1.f / DM) + EPSN);
            unsigned long long* o8 = (unsigned long long*)(xb + (size_t)m * DM) + lane;
#pragma unroll
            for (int j = 0; j < 4; ++j) o8[64 * j] = (unsigned long long)pk2(v[u][j].x, v[u][j].y) | ((unsigned long long)pk2(v[u][j].z, v[u][j].w) << 32); }
    }
    float* cbias = (float*)(ws + WS_CBIAS);
    for (int it = NGW - 1 - gw; it < 128; it += NGW) {
        const int kv = it >> 6, n = it & 63;
        const float* pos = A.in[kv ? 11 : 7]; const float* w1 = A.in[kv ? 12 : 8]; const float* b1 = A.in[kv ? 13 : 9];
        float pv_[32], wv_l[32];
#pragma unroll
        for (int i = 0; i < 32; ++i) { const int k = lane + 64 * i; pv_[i] = pos[k]; wv_l[i] = w1[(size_t)k * 64 + n]; }
        float s = 0.f;
#pragma unroll
        for (int i = 0; i < 32; ++i) s += pv_[i] * wv_l[i];
        s = wave_sum(s);
        if (lane == 0) cbias[it] = s + b1[n];
    }
    float2* rope = (float2*)(ws + WS_ROPE);
    for (int e = (gridDim.x - 1 - blockIdx.x) * 512 + tid; e < SEQ * 8; e += gridDim.x * 512) {
        const int pos = e >> 3, i = e & 7;
        double rev = (double)pos * A.invf[i];
        rev -= floor(rev);
        const float rf = (float)rev;
        rope[e] = make_float2(__builtin_amdgcn_cosf(rf), __builtin_amdgcn_sinf(rf));
    }
    if (blockIdx.x == gridDim.x - 1 && wave == 7) {
        const float gq = wave_max(fabsf(A.in[3][lane]));
        const float gc = wave_max(fabsf(A.in[4][lane])), gs = wave_max(fabsf(A.in[5][lane])), gwn = wave_max(fabsf(A.in[6][lane]));
        float* mb = (float*)(ws + WS_MB);
        if (lane == 0) { mb[0] = 8.f * gq * gc * 1.4426950408889634f * 1.02f; mb[1] = 8.f * gq * gs * 1.4426950408889634f * 1.02f; mb[2] = 8.f * gq * gwn * 1.4426950408889634f * 1.02f; }
    }
}

__device__ __forceinline__ void phase2_normrope(const Args& A, const int wv_, const int gw0, const int ngw) {
    const int tid = TIDX, lane = tid & 63;
    unsigned char* ws = A.ws;
    const bf16_t* __restrict__ P = (const bf16_t*)(ws + WS_P);
    bf16_t* __restrict__ ksn = (bf16_t*)(ws + WS_KSN); bf16_t* __restrict__ kwn = (bf16_t*)(ws + WS_KWN);
    const float2* __restrict__ rope = (const float2*)(ws + WS_ROPE);
    const int sub = lane & 7;
#pragma unroll 4
    for (int vb = gw0 * 8; vb < NTOK * 4; vb += ngw * 8) {
        const int v = vb + (lane >> 3);
        const int t = v >> 2, which = v & 3;
        int scol; const float* gain; bf16_t* dst;
        if (which < 2) { scol = C_KS + which * 64; gain = A.in[5]; dst = ksn + (size_t)t * 128 + which * 64; }
        else { scol = C_KW + (which - 2) * 64; gain = A.in[6]; dst = kwn + (size_t)t * 128 + (which - 2) * 64; }
        const u32x4 raw = *(const u32x4*)(P + (size_t)t * NCP + scol + sub * 8);
        float y[8];
        y[0] = bflo(raw.x); y[1] = bfhi(raw.x); y[2] = bflo(raw.y); y[3] = bfhi(raw.y); y[4] = bflo(raw.z); y[5] = bfhi(raw.z); y[6] = bflo(raw.w); y[7] = bfhi(raw.w);
        float ss = 0.f;
#pragma unroll
        for (int i = 0; i < 8; ++i) ss += y[i] * y[i];
        ss += __shfl_xor(ss, 1); ss += __shfl_xor(ss, 2); ss += __shfl_xor(ss, 4);
        const float r = 1.f / sqrtf(ss * (1.f / 64.f) + EPSN);
        const f32x4 g0 = *(const f32x4*)(gain + sub * 8), g1 = *(const f32x4*)(gain + sub * 8 + 4);
        y[0] *= r * g0.x; y[1] *= r * g0.y; y[2] *= r * g0.z; y[3] *= r * g0.w; y[4] *= r * g1.x; y[5] *= r * g1.y; y[6] *= r * g1.z; y[7] *= r * g1.w;
        const int pos = t & (SEQ - 1);
#pragma unroll
        for (int i = 0; i < 8; ++i) {
            const float oth = __shfl_xor(y[i], 1);
            const float2 cs = rope[pos * 8 + i];
            if (sub == 0) y[i] = y[i] * cs.x - oth * cs.y;
            else if (sub == 1) y[i] = y[i] * cs.x + oth * cs.y;
        }
        u32x4 o; o.x = pk2(y[0], y[1]); o.y = pk2(y[2], y[3]); o.z = pk2(y[4], y[5]); o.w = pk2(y[6], y[7]);
        *(u32x4*)(dst + sub * 8) = o;
    }
}

__device__ __forceinline__ void knorm_bg(const Args& A, const int wv_, const int bg, const int gw0, const int ngw) {
    const int tid = TIDX, lane = tid & 63;
    unsigned char* ws = A.ws;
    const bf16_t* __restrict__ P = (const bf16_t*)(ws + WS_P);
    bf16_t* __restrict__ ksn = (bf16_t*)(ws + WS_KSN); bf16_t* __restrict__ kwn = (bf16_t*)(ws + WS_KWN);
    const float2* __restrict__ rope = (const float2*)(ws + WS_ROPE);
    const int sub = lane & 7, b = bg >> 1, g = bg & 1;
#pragma unroll 4
    for (int ub = gw0 * 8; ub < SEQ * 2; ub += ngw * 8) {
        const int u = ub + (lane >> 3);
        const int t = b * SEQ + (u >> 1), win = u & 1;
        const int scol = (win ? C_KW : C_KS) + g * 64; const float* gain = A.in[win ? 6 : 5]; bf16_t* dst = (win ? kwn : ksn) + (size_t)t * 128 + g * 64;
        const u32x4 raw = *(const u32x4*)(P + (size_t)t * NCP + scol + sub * 8);
        float y[8];
        y[0] = bflo(raw.x); y[1] = bfhi(raw.x); y[2] = bflo(raw.y); y[3] = bfhi(raw.y); y[4] = bflo(raw.z); y[5] = bfhi(raw.z); y[6] = bflo(raw.w); y[7] = bfhi(raw.w);
        float ss = 0.f;
#pragma unroll
        for (int i = 0; i < 8; ++i) ss += y[i] * y[i];
        ss += __shfl_xor(ss, 1); ss += __shfl_xor(ss, 2); ss += __shfl_xor(ss, 4);
        const float r = 1.f / sqrtf(ss * (1.f / 64.f) + EPSN);
        const f32x4 g0 = *(const f32x4*)(gain + sub * 8), g1 = *(const f32x4*)(gain + sub * 8 + 4);
        y[0] *= r * g0.x; y[1] *= r * g0.y; y[2] *= r * g0.z; y[3] *= r * g0.w; y[4] *= r * g1.x; y[5] *= r * g1.y; y[6] *= r * g1.z; y[7] *= r * g1.w;
        const int pos = t & (SEQ - 1);
#pragma unroll
        for (int i = 0; i < 8; ++i) {
            const float oth = __shfl_xor(y[i], 1);
            const float2 cs = rope[pos * 8 + i];
            if (sub == 0) y[i] = y[i] * cs.x - oth * cs.y;
            else if (sub == 1) y[i] = y[i] * cs.x + oth * cs.y;
        }
        u32x4 o; o.x = pk2(y[0], y[1]); o.y = pk2(y[2], y[3]); o.z = pk2(y[4], y[5]); o.w = pk2(y[6], y[7]);
        *(u32x4*)(dst + sub * 8) = o;
    }
}
__device__ __forceinline__ void group_arrive(unsigned* ctr, const int wv_) {
    asm volatile("s_waitcnt vmcnt(0)" ::: "memory");
    __syncthreads();
    if (TIDX == 0) {
        __builtin_amdgcn_fence(__ATOMIC_RELEASE, "agent");
        asm volatile("s_waitcnt vmcnt(0)" ::: "memory");
        __hip_atomic_fetch_add(ctr, 1u, __ATOMIC_RELAXED, __HIP_MEMORY_SCOPE_AGENT);
    }
}
__device__ __forceinline__ void group_wait(unsigned* ctr, const unsigned n, const int wv_) {
    if (TIDX == 0) {
        unsigned sp = 0;
        while (__hip_atomic_load(ctr, __ATOMIC_RELAXED, __HIP_MEMORY_SCOPE_AGENT) < n) { __builtin_amdgcn_s_sleep(1); if (++sp > (1u << 22)) break; }
        __builtin_amdgcn_fence(__ATOMIC_ACQUIRE, "agent");
        asm volatile("s_waitcnt vmcnt(0)" ::: "memory");
    }
    __syncthreads();
}

__device__ __forceinline__ void compress_item(const Args& A, LAS unsigned char* lds, int item, const int wv_) {
    const int tid = TIDX, lane = tid & 63, r32 = lane & 31, hi = lane >> 5, wave = __builtin_amdgcn_readfirstlane(tid >> 6);
    unsigned char* ws = A.ws;
    const int kv = item >> 6, b = (item >> 4) & 3, g = (item >> 3) & 1, nt = item & 7, n0 = 32 * nt;
    const bf16_t* P = (const bf16_t*)(ws + WS_P);
    const bf16_t* W1T = (const bf16_t*)(ws + WS_W1T) + (size_t)kv * 64 * 2048;
    const int col = (kv ? C_VC : C_KC) + g * 64;
    const int n = n0 + r32; const bool nok = n <= 254;
    f32x16 acc0 = {}, acc1 = {};
#pragma unroll 8
    for (int ks = 0; ks < 16; ++ks) {
        const int kk = 256 * wave + 16 * ks + 8 * hi;
        const int tok = 16 * n + (kk >> 6), d = kk & 63;
        bf16x8 a = {};
        if (nok) a = *(const bf16x8*)(P + (size_t)(b * SEQ + tok) * NCP + col + d);
        const bf16x8 b0 = *(const bf16x8*)(W1T + (size_t)r32 * 2048 + kk);
        const bf16x8 b1 = *(const bf16x8*)(W1T + (size_t)(32 + r32) * 2048 + kk);
        acc0 = MFMA32(a, b0, acc0); acc1 = MFMA32(a, b1, acc1);
    }
    LAS float* red = (LAS float*)lds;
    LAS float* hid = (LAS float*)(lds + 65536);
#pragma unroll
    for (int i = 0; i < 16; ++i) { const int row = (i & 3) + 8 * (i >> 2) + 4 * hi; red[(wave * 32 + row) * 64 + r32] = acc0[i]; red[(wave * 32 + row) * 64 + 32 + r32] = acc1[i]; }
    __syncthreads();
    const float* cbias = (const float*)(ws + WS_CBIAS) + kv * 64;
#pragma unroll
    for (int j = 0; j < 4; ++j) { const int e = tid + 512 * j, c = e & 63; float s = cbias[c];
#pragma unroll
        for (int w = 0; w < 8; ++w) s += red[w * 2048 + e];
        hid[e] = s * sigmoidf_(s); }
    __syncthreads();
    const float* w2 = A.in[kv ? 14 : 10];
    const int row = tid >> 4, c4 = (tid & 15) * 4;
    f32x4 o = {0.f, 0.f, 0.f, 0.f};
    for (int j = 0; j < 64; ++j) { const float hv = hid[row * 64 + j]; const f32x4 wv = *(const f32x4*)(w2 + j * 64 + c4); o += wv * hv; }
    const int nn = n0 + row;
    bf16_t* dst = (bf16_t*)(ws + (kv ? WS_VCMP : WS_KCMP)) + ((size_t)((b * 2 + g) * 256 + nn)) * 64 + c4;
    if (kv == 0) {
        float ss = o.x * o.x + o.y * o.y + o.z * o.z + o.w * o.w;
        ss += __shfl_xor(ss, 1); ss += __shfl_xor(ss, 2); ss += __shfl_xor(ss, 4); ss += __shfl_xor(ss, 8);
        const float r = 1.f / sqrtf(ss * (1.f / 64.f) + EPSN);
        const f32x4 gn = *(const f32x4*)(A.in[4] + c4);
        o = o * r * gn;
        const int pos = 16 * nn + 31;
        const f32x4 oth = {__shfl_xor(o.x, 2), __shfl_xor(o.y, 2), __shfl_xor(o.z, 2), __shfl_xor(o.w, 2)};
        const int cc = tid & 15;
        if (cc < 4 && nn <= 254) {
            const float2* rope = (const float2*)(ws + WS_ROPE) + pos * 8 + (cc & 1) * 4;
            const float2 c0 = rope[0], c1 = rope[1], c2_ = rope[2], c3 = rope[3];
            if (cc < 2) { o.x = o.x * c0.x - oth.x * c0.y; o.y = o.y * c1.x - oth.y * c1.y; o.z = o.z * c2_.x - oth.z * c2_.y; o.w = o.w * c3.x - oth.w * c3.y; }
            else        { o.x = o.x * c0.x + oth.x * c0.y; o.y = o.y * c1.x + oth.y * c1.y; o.z = o.z * c2_.x + oth.z * c2_.y; o.w = o.w * c3.x + oth.w * c3.y; }
        }
    }
    if (nn > 254) o = (f32x4){0.f, 0.f, 0.f, 0.f};
    u32x2 pk; pk.x = pk2(o.x, o.y); pk.y = pk2(o.z, o.w);
    *(u32x2*)dst = pk;
    __syncthreads();
}

constexpr int KV_BUF = 17664, KV_VOFF = 9216, V_HALF = 4224;
constexpr int ATT_FLAGS = 35328, ATT_LINV = 35392, ATT_PW = 36416;

struct KVStage { u32x4 k, v; };
__device__ __forceinline__ void kv_load(KVStage& st, const bf16_t* Kb, int kpitch, const bf16_t* Vb, int vpitch, int key0, int tid) {
    const int key = tid >> 3, c = tid & 7;
    st.k = *(const u32x4*)(Kb + (size_t)(key0 + key) * kpitch + c * 8);
    st.v = *(const u32x4*)(Vb + (size_t)(key0 + key) * vpitch + c * 8);
}
__device__ __forceinline__ void kv_store(const KVStage& st, LAS unsigned char* buf, int tid) {
    const int key = tid >> 3, c = tid & 7;
    *(LAS u32x4*)(buf + key * 144 + c * 16) = st.k;
    *(LAS u32x4*)(buf + KV_VOFF + (c >> 2) * V_HALF + key * 64 + (c & 3) * 16) = st.v;
}
__device__ __forceinline__ void qk_tile(f32x16& p0, f32x16& p1, const f32x16& cinit, const LAS unsigned char* kb, const bf16x8* qr, int r32, int hi) {
    const LAS unsigned char* base = kb + r32 * 144 + hi * 16;
    { const bf16x8 a0 = *(const LAS bf16x8*)(base), a1 = *(const LAS bf16x8*)(base + 32 * 144);
      p0 = MFMA32(a0, qr[0], cinit); p1 = MFMA32(a1, qr[0], cinit); }
#pragma unroll
    for (int d0 = 1; d0 < 4; ++d0) { const bf16x8 a0 = *(const LAS bf16x8*)(base + d0 * 32), a1 = *(const LAS bf16x8*)(base + 32 * 144 + d0 * 32);
        p0 = MFMA32(a0, qr[d0], p0); p1 = MFMA32(a1, qr[d0], p1); }
}
typedef short v4i16_t __attribute__((ext_vector_type(4)));
__device__ __forceinline__ s16x4 vtr(const LAS unsigned char* p) { return __builtin_bit_cast(s16x4, __builtin_amdgcn_ds_read_tr16_b64_v4i16((LAS v4i16_t*)p)); }
__device__ __forceinline__ void pv_packed(f32x16* o, const LAS unsigned char* vb, const bf16x8* pa, int lane) {
    const int hi = lane >> 5;
    const LAS unsigned char* base = vb + ((lane >> 4) & 1) * 32 + (lane & 3) * 8 + (4 * hi + ((lane & 15) >> 2)) * 64;
#pragma unroll
    for (int d0 = 0; d0 < 2; ++d0)
#pragma unroll
        for (int s = 0; s < 4; ++s) {
            const s16x4 lo = vtr(base + d0 * V_HALF + s * 1024);
            const s16x4 hh = vtr(base + d0 * V_HALF + s * 1024 + 512);
            const bf16x8 vf = __builtin_shufflevector(lo, hh, 0, 1, 2, 3, 4, 5, 6, 7);
            o[d0] = MFMA32(vf, pa[s], o[d0]);
        }
}
__device__ __forceinline__ void pack_half(bf16x8* pa2, const f32x16& p) {
    u32x4 w0 = {pk2(p[0], p[1]), pk2(p[2], p[3]), pk2(p[4], p[5]), pk2(p[6], p[7])};
    u32x4 w1 = {pk2(p[8], p[9]), pk2(p[10], p[11]), pk2(p[12], p[13]), pk2(p[14], p[15])};
    pa2[0] = __builtin_bit_cast(bf16x8, w0); pa2[1] = __builtin_bit_cast(bf16x8, w1);
}
__device__ __forceinline__ void pv_tile(f32x16* o, const LAS unsigned char* vb, const f32x16& p0, const f32x16& p1, int lane) {
    bf16x8 pa[4]; pack_half(pa, p0); pack_half(pa + 2, p1);
    pv_packed(o, vb, pa, lane);
}
__device__ __forceinline__ f32x16 splat16(float v) { f32x16 r;
#pragma unroll
    for (int i = 0; i < 16; ++i) r[i] = v;
    return r; }
__device__ __forceinline__ int crow(int i, int hi) { return (i & 3) + 8 * (i >> 2) + 4 * hi; }

enum { M_WIN = 0, M_SLC = 1, M_SB = 2, M_CMP = 3 };

template <int MODE>
__device__ __forceinline__ void attn_item(const Args& A, LAS unsigned char* lds, int item, const int wv_) {
    int tid_l = TIDX; asm volatile("" : "+v"(tid_l));
    const int tid = tid_l, lane = tid & 63, r32 = lane & 31, hi = lane >> 5, w = __builtin_amdgcn_readfirstlane(tid >> 6);
    unsigned char* ws = A.ws;
    const bf16_t* P = (const bf16_t*)(ws + WS_P);
    int b, g = 0, hd, m, T0, trel;
    const bf16_t *Qrow, *Kb, *Vb; int kpitch, vpitch, kt_first, nt, kt_step = 1;
    if (MODE == M_SB) {
        b = item >> 7; hd = (item >> 4) & 7; m = item & 15; T0 = 256 * m; trel = 32 * w + r32;
        Qrow = P + (size_t)(b * SEQ + T0 + trel) * NCP + C_QSB + hd * 64;
        Kb = P + (size_t)(b * SEQ) * NCP + C_KSB + hd * 64; Vb = P + (size_t)(b * SEQ) * NCP + C_VSB + hd * 64; kpitch = NCP; vpitch = NCP;
        kt_first = 4 * m + 3; nt = 4 * m + 4; kt_step = -1;
    } else {
        if (MODE == M_SLC) { int bg; if (item < 256) { bg = item >> 5; m = 32 + (item & 31); } else { const int i2 = item - 256; bg = i2 >> 5; m = 31 - (i2 & 31); } b = bg >> 1; g = bg & 1; }
        else { b = item >> 7; g = (item >> 6) & 1; m = item & 63; }
        T0 = 64 * m; hd = 4 * g + (w & 3); trel = 32 * (w >> 2) + r32;
        Qrow = (const bf16_t*)(ws + WS_QN) + (size_t)(b * SEQ + T0 + trel) * 512 + hd * 64;
        if (MODE == M_WIN) { Kb = (const bf16_t*)(ws + WS_KWN) + (size_t)(b * SEQ) * 128 + g * 64; kpitch = 128; Vb = P + (size_t)(b * SEQ) * NCP + C_VW + g * 64; vpitch = NCP; kt_first = m >= 8 ? m - 8 : 0; nt = m - kt_first + 1; }
        else if (MODE == M_SLC) { Kb = (const bf16_t*)(ws + WS_KSN) + (size_t)(b * SEQ) * 128 + g * 64; kpitch = 128; Vb = P + (size_t)(b * SEQ) * NCP + C_VS + g * 64; vpitch = NCP; kt_first = 0; nt = m + 1; }
        else { Kb = (const bf16_t*)(ws + WS_KCMP) + (size_t)((b * 2 + g) * 256) * 64; kpitch = 64; Vb = (const bf16_t*)(ws + WS_VCMP) + (size_t)((b * 2 + g) * 256) * 64; vpitch = 64; kt_first = 0; nt = ((4 * m + 2) >> 6) + 1; }
    }
    const int t = T0 + trel;
    bf16x8 qr[4];
#pragma unroll
    for (int d0 = 0; d0 < 4; ++d0) qr[d0] = *(const bf16x8*)(Qrow + 16 * d0 + 8 * hi);
    if (MODE == M_SB) {
#pragma unroll
        for (int d0 = 0; d0 < 4; ++d0) { u32x4 u = __builtin_bit_cast(u32x4, qr[d0]);
            u.x = pk2(bflo(u.x) * C2, bfhi(u.x) * C2); u.y = pk2(bflo(u.y) * C2, bfhi(u.y) * C2); u.z = pk2(bflo(u.z) * C2, bfhi(u.z) * C2); u.w = pk2(bflo(u.w) * C2, bfhi(u.w) * C2);
            qr[d0] = __builtin_bit_cast(bf16x8, u); }
    }
    float negmb = 0.f;
    if (MODE != M_SB) negmb = -((const float*)(ws + WS_MB))[MODE == M_CMP ? 0 : (MODE == M_SLC ? 1 : 2)];
    unsigned sel_lo = 0, sel_hi = 0;
    if (MODE == M_SLC) { const u32x2 sm = *(const u32x2*)((const unsigned long long*)(ws + WS_SEL) + (size_t)(b * 2 + g) * SEQ + t); sel_lo = sm.x; sel_hi = sm.y; }
    const int nmax = (t - 31) >> 4;
    f32x16 o[2]; o[0] = splat16(0.f); o[1] = splat16(0.f);
    float lsum = 0.f, carry = (MODE == M_SB) ? 1.f : 0.f  ;
    bool done = false;
    LAS unsigned* flags = (LAS unsigned*)(lds + ATT_FLAGS);
    LAS float* pw = (LAS float*)(lds + ATT_PW) + (w * 32 + r32) * 65;
    if (MODE == M_CMP) {
#pragma unroll
        for (int j = 0; j < 32; ++j) pw[hi * 32 + j] = 0.f;
        if (hi) pw[64] = 0.f;
    }
    f32x16 cneg = splat16(negmb);
    if (MODE != M_SB) asm volatile("" : "+v"(cneg));
    KVStage sA, sB;
    kv_load(sA, Kb, kpitch, Vb, vpitch, kt_first * 64, tid);
    kv_store(sA, lds, tid);
    kv_load(sA, Kb, kpitch, Vb, vpitch, (kt_first + (nt > 1 ? kt_step : 0)) * 64, tid);
    __syncthreads();
    auto step = [&](const int it, KVStage& have, KVStage& recv) __attribute__((always_inline)) -> bool {
        const int kt = kt_first + it * kt_step;
        const LAS unsigned char* cur = lds + (it & 1) * KV_BUF;
        LAS unsigned char* nxt = lds + ((it & 1) ^ 1) * KV_BUF;
        const bool more = it + 1 < nt;
        { const int itn = it + 2 < nt ? it + 2 : nt - 1; kv_load(recv, Kb, kpitch, Vb, vpitch, (kt_first + itn * kt_step) * 64, tid); }
        if (MODE == M_WIN) {
            f32x16 p0, p1;
            qk_tile(p0, p1, cneg, cur, qr, r32, hi);
#pragma unroll
            for (int i = 0; i < 16; ++i) { p0[i] = ex2(p0[i]); p1[i] = ex2(p1[i]); }
            if (kt == m) {
#pragma unroll
                for (int i = 0; i < 16; ++i) { const int rel = crow(i, hi); if (rel > trel) p0[i] = 0.f; if (rel + 32 > trel) p1[i] = 0.f; }
            }
            if (kt == m - 8) {
#pragma unroll
                for (int i = 0; i < 16; ++i) { const int rel = crow(i, hi); if (rel <= trel) p0[i] = 0.f; if (rel + 32 <= trel) p1[i] = 0.f; }
            }
            float s = 0.f;
#pragma unroll
            for (int i = 0; i < 16; ++i) s += p0[i] + p1[i];
            lsum += s;
            pv_tile(o, cur + KV_VOFF, p0, p1, lane);
        } else if (MODE == M_SLC) {
            const unsigned bit = ((kt < 32 ? sel_lo : sel_hi) >> (kt & 31)) & 1u;
            if (__any((int)bit)) {
                f32x16 p0, p1;
                qk_tile(p0, p1, cneg, cur, qr, r32, hi);
                const float bf = bit ? 1.f : 0.f;
#pragma unroll
                for (int i = 0; i < 16; ++i) { p0[i] = ex2(p0[i]) * bf; p1[i] = ex2(p1[i]) * bf; }
                if (kt == m) {
#pragma unroll
                    for (int i = 0; i < 16; ++i) { const int rel = crow(i, hi); if (rel > trel) p0[i] = 0.f; if (rel + 32 > trel) p1[i] = 0.f; }
                }
                float s = 0.f;
#pragma unroll
                for (int i = 0; i < 16; ++i) s += p0[i] + p1[i];
                lsum += s;
                pv_tile(o, cur + KV_VOFF, p0, p1, lane);
            }
        } else if (MODE == M_CMP) {
            f32x16 p0, p1;
            qk_tile(p0, p1, cneg, cur, qr, r32, hi);
            const int lim = nmax - kt * 64;
#pragma unroll
            for (int i = 0; i < 16; ++i) { const int rel = crow(i, hi); p0[i] = rel <= lim ? ex2(p0[i]) : 0.f; p1[i] = rel + 32 <= lim ? ex2(p1[i]) : 0.f; }
            float s = 0.f;
#pragma unroll
            for (int i = 0; i < 16; ++i) s += p0[i] + p1[i];
            lsum += s;
#pragma unroll
            for (int q = 0; q < 8; ++q) {
                const f32x16& pq = q < 4 ? p0 : p1; const int qb = 4 * (q & 3); const float e0 = pq[qb], e1 = pq[qb + 1], e2 = pq[qb + 2], e3 = pq[qb + 3];
                float a = e0 + e1 + e2 + 0.5f * e3; const float bq = 0.5f * e3;
                const float pb = __shfl_xor(bq, 32);
                a += hi ? pb : carry;
                carry = pb;
                pw[kt * 16 + 2 * q + hi] = a;
            }
            pv_tile(o, cur + KV_VOFF, p0, p1, lane);
        } else {
            const int kbase = kt * 64 - T0;
            const bool skip = done || (kbase >= 32 * w + 31);
            if (!skip) {
                f32x16 pz[2];
                qk_tile(pz[0], pz[1], splat16(0.f), cur, qr, r32, hi);
                const bool partial = kbase + 63 >= 32 * w;
                const int lim = trel - kbase;
                bf16x8 pa[4];
                float run = carry;
#pragma unroll
                for (int h2 = 1; h2 >= 0; --h2) {
                    f32x16 om, be;
#pragma unroll
                    for (int i = 0; i < 16; ++i) { const float z = __builtin_amdgcn_fmed3f(pz[h2][i], -60.f, 60.f); const float e = ex2(-z); const float bb = __builtin_amdgcn_rcpf(1.f + e); be[i] = bb; om[i] = e * bb; }
                    if (partial) {
#pragma unroll
                        for (int i = 0; i < 16; ++i) { const int rel = crow(i, hi) + 32 * h2; if (rel >= lim) { om[i] = 1.f; be[i] = 0.f; } }
                    }
                    float gs[4], po[4];
#pragma unroll
                    for (int q = 0; q < 4; ++q) { gs[q] = (om[4 * q] * om[4 * q + 1]) * (om[4 * q + 2] * om[4 * q + 3]); po[q] = __shfl_xor(gs[q], 32); }
#pragma unroll
                    for (int q = 3; q >= 0; --q) {
                        const float ghi = hi ? gs[q] : po[q], glo = hi ? po[q] : gs[q];
                        const float t1 = run; run *= ghi; const float t0 = run; run *= glo;
                        float af = hi ? t1 : t0;
                        be[4 * q + 3] *= af; af *= om[4 * q + 3];
                        be[4 * q + 2] *= af; af *= om[4 * q + 2];
                        be[4 * q + 1] *= af; af *= om[4 * q + 1];
                        be[4 * q] *= af;
                    }
                    pack_half(pa + 2 * h2, be);
                }
                carry = run;
                pv_packed(o, cur + KV_VOFF, pa, lane);
                done = __all(carry < 3.5527e-15f);
            }
        }
        if (more) kv_store(have, nxt, tid);
        if (MODE == M_SB) { if (lane == 0) flags[(it & 1) * 8 + w] = done ? 1u : 0u; }
        __syncthreads();
        if (MODE == M_SB) {
            const u32x4 f0 = *(const LAS u32x4*)(flags + (it & 1) * 8), f1 = *(const LAS u32x4*)(flags + (it & 1) * 8 + 4);
            if ((f0.x & f0.y & f0.z & f0.w & f1.x & f1.y & f1.z & f1.w) != 0u) return true;
        }
        return false;
    };
    for (int it = 0; it < nt; it += 2) {
        if (step(it, sA, sB)) break;
        if (it + 1 >= nt) break;
        if (step(it + 1, sB, sA)) break;
    }
    if (MODE == M_SB) {
        const bf16_t* gp = P + (size_t)(b * SEQ + t) * NCP + C_GSB + hd * 64;
        bf16_t* dst = (bf16_t*)(ws + WS_XB) + (size_t)(b * SEQ + t) * DM + 512 + hd * 64;
        u32x2 gvv[8];
#pragma unroll
        for (int e = 0; e < 8; ++e) gvv[e] = *(const u32x2*)(gp + (e >> 2) * 32 + 8 * (e & 3) + 4 * hi);
#pragma unroll
        for (int d0 = 0; d0 < 2; ++d0)
#pragma unroll
            for (int q = 0; q < 4; ++q) { const int d = d0 * 32 + 8 * q + 4 * hi;
                const u32x2 gv = gvv[d0 * 4 + q];
                const float g0 = bflo(gv.x), g1 = bfhi(gv.x), g2 = bflo(gv.y), g3 = bfhi(gv.y);
                u32x2 pk; pk.x = pk2(o[d0][4 * q] * g0 * sigmoidf_(g0), o[d0][4 * q + 1] * g1 * sigmoidf_(g1)); pk.y = pk2(o[d0][4 * q + 2] * g2 * sigmoidf_(g2), o[d0][4 * q + 3] * g3 * sigmoidf_(g3));
                *(u32x2*)(dst + d) = pk; }
    } else {
        lsum += __shfl_xor(lsum, 32);
        const float inv = lsum > 0.f ? 1.f / lsum : 0.f;
        const int br = MODE == M_CMP ? 0 : (MODE == M_SLC ? 1 : 2);
        const float gate = sigmoidf_(bf1(P[(size_t)(b * SEQ + t) * NCP + C_GL + hd * 3 + br]));
        const float sc = inv * gate;
        const size_t orow = (size_t)(b * SEQ + t) * 512 + hd * 64;
        if (MODE == M_SLC) {
            const bf16_t* oc = (const bf16_t*)(ws + WS_OC) + orow; const bf16_t* ow = (const bf16_t*)(ws + WS_OW) + orow;
            const bf16_t* gp = P + (size_t)(b * SEQ + t) * NCP + C_GN + hd * 64;
            bf16_t* dst = (bf16_t*)(ws + WS_XB) + (size_t)(b * SEQ + t) * DM + hd * 64;
#pragma unroll
            for (int d0 = 0; d0 < 2; ++d0)
#pragma unroll
                for (int q = 0; q < 4; ++q) { const int d = d0 * 32 + 8 * q + 4 * hi;
                    const u32x2 gv = *(const u32x2*)(gp + d), cv = *(const u32x2*)(oc + d), wv = *(const u32x2*)(ow + d);
                    const float g0 = bflo(gv.x), g1 = bfhi(gv.x), g2 = bflo(gv.y), g3 = bfhi(gv.y);
                    const float v0 = o[d0][4 * q] * sc + bflo(cv.x) + bflo(wv.x), v1 = o[d0][4 * q + 1] * sc + bfhi(cv.x) + bfhi(wv.x);
                    const float v2 = o[d0][4 * q + 2] * sc + bflo(cv.y) + bflo(wv.y), v3 = o[d0][4 * q + 3] * sc + bfhi(cv.y) + bfhi(wv.y);
                    u32x2 pk; pk.x = pk2(v0 * g0 * sigmoidf_(g0), v1 * g1 * sigmoidf_(g1)); pk.y = pk2(v2 * g2 * sigmoidf_(g2), v3 * g3 * sigmoidf_(g3));
                    *(u32x2*)(dst + d) = pk; }
        } else {
            bf16_t* dst = (bf16_t*)(ws + (MODE == M_CMP ? WS_OC : WS_OW)) + orow;
#pragma unroll
            for (int d0 = 0; d0 < 2; ++d0)
#pragma unroll
                for (int q = 0; q < 4; ++q) { const int d = d0 * 32 + 8 * q + 4 * hi;
                    u32x2 pk; pk.x = pk2(o[d0][4 * q] * sc, o[d0][4 * q + 1] * sc); pk.y = pk2(o[d0][4 * q + 2] * sc, o[d0][4 * q + 3] * sc);
                    *(u32x2*)(dst + d) = pk; }
        }
        if (MODE == M_CMP) {
            LAS float* linv = (LAS float*)(lds + ATT_LINV);
            if (hi == 0) linv[w * 32 + r32] = inv;
            __syncthreads();
            const LAS float* pwb = (const LAS float*)(lds + ATT_PW);
            unsigned long long* sel = (unsigned long long*)(ws + WS_SEL) + (size_t)(b * 2 + g) * SEQ + T0;
            const int j = lane, blk = m;
            const bool valid = j <= blk, forced = (j == 0) || (j == blk) || (j == blk - 1);
            for (int i = 0; i < 8; ++i) {
                const int tok = w * 8 + i, half = tok >> 5, r = tok & 31;
                float sc2 = 0.f;
#pragma unroll
                for (int hh = 0; hh < 4; ++hh) sc2 += pwb[((half * 4 + hh) * 32 + r) * 65 + j] * linv[(half * 4 + hh) * 32 + r];
                const float s = valid ? (forced ? sc2 + 1.0e4f : sc2) : -INFINITY;
                int cnt = 0;
#pragma unroll
                for (int l2 = 0; l2 < 64; ++l2) { const float sl = __uint_as_float(__builtin_amdgcn_readlane(__float_as_uint(s), l2)); cnt += ((sl > s) || (sl == s && l2 < lane)) ? 1 : 0; }
                const unsigned long long mk = __ballot(valid && cnt < 16);
                if (lane == 0) sel[tok] = mk;
            }
        }
    }
    __syncthreads();
}


__device__ __forceinline__ void k_reads(bf16x8* kf, const LAS unsigned char* kb, int r32, int hi) {
    const LAS unsigned char* base = kb + r32 * 144 + hi * 16;
#pragma unroll
    for (int d0 = 0; d0 < 4; ++d0) { kf[2 * d0] = *(const LAS bf16x8*)(base + d0 * 32); kf[2 * d0 + 1] = *(const LAS bf16x8*)(base + 32 * 144 + d0 * 32); }
}
__device__ __forceinline__ void qk_mfma(f32x16& p0, f32x16& p1, const f32x16& cinit, const bf16x8* kf, const bf16x8* qr) {
    p0 = MFMA32(kf[0], qr[0], cinit); p1 = MFMA32(kf[1], qr[0], cinit);
#pragma unroll
    for (int d0 = 1; d0 < 4; ++d0) { p0 = MFMA32(kf[2 * d0], qr[d0], p0); p1 = MFMA32(kf[2 * d0 + 1], qr[d0], p1); }
}
__device__ __forceinline__ void v_reads(s16x4* vlo, s16x4* vhi, const LAS unsigned char* vb, int lane) {
    const int hi = lane >> 5;
    const LAS unsigned char* base = vb + ((lane >> 4) & 1) * 32 + (lane & 3) * 8 + (4 * hi + ((lane & 15) >> 2)) * 64;
#pragma unroll
    for (int d0 = 0; d0 < 2; ++d0)
#pragma unroll
        for (int s = 0; s < 4; ++s) { vlo[d0 * 4 + s] = vtr(base + d0 * V_HALF + s * 1024); vhi[d0 * 4 + s] = vtr(base + d0 * V_HALF + s * 1024 + 512); }
}
__device__ __forceinline__ void pv_mfma(f32x16* o, const s16x4* vlo, const s16x4* vhi, const bf16x8* pa) {
#pragma unroll
    for (int s = 0; s < 4; ++s)
#pragma unroll
        for (int d0 = 0; d0 < 2; ++d0) {
            const bf16x8 vf = __builtin_shufflevector(vlo[d0 * 4 + s], vhi[d0 * 4 + s], 0, 1, 2, 3, 4, 5, 6, 7);
            o[d0] = MFMA32(vf, pa[s], o[d0]);
        }
}
__device__ __forceinline__ float fadd_s(float a, float b) { float r; asm("v_add_f32_e32 %0, %1, %2" : "=v"(r) : "v"(a), "v"(b)); return r; }
typedef float f32x2v __attribute__((ext_vector_type(2)));
template <int MODE>
__device__ __forceinline__ void softmax_stage(f32x16& p0, f32x16& p1, bf16x8* pa, float& lsum, int kt, int m, int trel, int hi, unsigned bit) {
#pragma unroll
    for (int i = 0; i < 16; ++i) { p0[i] = ex2(p0[i]); p1[i] = ex2(p1[i]); }
    if (kt == m) {
#pragma unroll
        for (int i = 0; i < 16; ++i) { const int rel = crow(i, hi); if (rel > trel) p0[i] = 0.f; if (rel + 32 > trel) p1[i] = 0.f; }
    }
    if (MODE == M_WIN && kt == m - 8) {
#pragma unroll
        for (int i = 0; i < 16; ++i) { const int rel = crow(i, hi); if (rel <= trel) p0[i] = 0.f; if (rel + 32 <= trel) p1[i] = 0.f; }
    }
    f32x2v acc = {0.f, 0.f};
#pragma unroll
    for (int i = 0; i < 8; ++i) { acc += (f32x2v){p0[2 * i], p0[2 * i + 1]}; acc += (f32x2v){p1[2 * i], p1[2 * i + 1]}; }
    float sum = acc.x + acc.y;
    const unsigned mk = (MODE == M_SLC) ? (bit ? 0xffffffffu : 0u) : 0xffffffffu;
#pragma unroll
    for (int k = 0; k < 4; ++k) { const f32x16& p = k < 2 ? p0 : p1; const int bs = 8 * (k & 1);
        u32x4 wv = {pk2(p[bs], p[bs + 1]), pk2(p[bs + 2], p[bs + 3]), pk2(p[bs + 4], p[bs + 5]), pk2(p[bs + 6], p[bs + 7])};
        if (MODE == M_SLC) { wv.x &= mk; wv.y &= mk; wv.z &= mk; wv.w &= mk; }
        pa[k] = __builtin_bit_cast(bf16x8, wv); }
    if (MODE == M_SLC) sum = bit ? sum : 0.f;
    lsum += sum;
}

template <int MODE>
__device__ __forceinline__ void attn_item2(const Args& A, LAS unsigned char* lds, int item, const int wv_) {
    int tid_l = TIDX; asm volatile("" : "+v"(tid_l));
    const int tid = tid_l, lane = tid & 63, r32 = lane & 31, hi = lane >> 5, w = __builtin_amdgcn_readfirstlane(tid >> 6);
    unsigned char* ws = A.ws;
    const bf16_t* P = (const bf16_t*)(ws + WS_P);
    int b, g, m;
    if (MODE == M_SLC) { int bg; if (item < 256) { bg = item >> 5; m = 32 + (item & 31); } else { const int i2 = item - 256; bg = i2 >> 5; m = 31 - (i2 & 31); } b = bg >> 1; g = bg & 1; }
    else { b = item >> 7; g = (item >> 6) & 1; m = item & 63; }
    const int T0 = 64 * m, hd = 4 * g + (w & 3), trel = 32 * (w >> 2) + r32, t = T0 + trel;
    const bf16_t* Qrow = (const bf16_t*)(ws + WS_QN) + (size_t)(b * SEQ + t) * 512 + hd * 64;
    const bf16_t* Kb = (const bf16_t*)(ws + (MODE == M_WIN ? WS_KWN : WS_KSN)) + (size_t)(b * SEQ) * 128 + g * 64;
    const bf16_t* Vb = P + (size_t)(b * SEQ) * NCP + (MODE == M_WIN ? C_VW : C_VS) + g * 64;
    const int kpitch = 128, vpitch = NCP;
    const int kt_first = (MODE == M_WIN && m >= 8) ? m - 8 : 0, nt = m - kt_first + 1;
    bf16x8 qr[4];
#pragma unroll
    for (int d0 = 0; d0 < 4; ++d0) qr[d0] = *(const bf16x8*)(Qrow + 16 * d0 + 8 * hi);
    const float negmb = -((const float*)(ws + WS_MB))[MODE == M_SLC ? 1 : 2];
    unsigned sel_lo = 0xffffffffu, sel_hi = 0xffffffffu;
    if (MODE == M_SLC) { const u32x2 sm = *(const u32x2*)((const unsigned long long*)(ws + WS_SEL) + (size_t)(b * 2 + g) * SEQ + t); sel_lo = sm.x; sel_hi = sm.y; }
    f32x16 o[2]; o[0] = splat16(0.f); o[1] = splat16(0.f);
    float lsum = 0.f;
    f32x16 cneg = splat16(negmb);
    asm volatile("" : "+v"(cneg));
    const bool grpA = (w < 4);
    KVStage sA, sB;
#define TILE_CL(i) ((kt_first + ((i) < nt ? (i) : nt - 1)) * 64)
    kv_load(sA, Kb, kpitch, Vb, vpitch, TILE_CL(0), tid);
    kv_load(sB, Kb, kpitch, Vb, vpitch, TILE_CL(1), tid);
    kv_store(sA, lds, tid);
    kv_store(sB, lds + KV_BUF, tid);
    kv_load(sA, Kb, kpitch, Vb, vpitch, TILE_CL(2), tid);
    __syncthreads();
    f32x16 SA0, SA1, SB0, SB1;
    qk_tile(SA0, SA1, cneg, lds, qr, r32, hi);
    int s0 = 0, s1 = KV_BUF, s2 = 2 * KV_BUF;
    auto step = [&](const int it, KVStage& have, KVStage& recv, f32x16& c0, f32x16& c1, f32x16& n0, f32x16& n1) __attribute__((always_inline)) {
        const int kt = kt_first + it;
        kv_load(recv, Kb, kpitch, Vb, vpitch, TILE_CL(it + 3), tid);
        const unsigned bit = ((kt < 32 ? sel_lo : sel_hi) >> (kt & 31)) & 1u;
        bf16x8 pa[4];
        bf16x8 kf[8]; s16x4 vlo[8], vhi[8];
        if (grpA) {
            k_reads(kf, lds + s1, r32, hi);
            __builtin_amdgcn_sched_barrier(0);
            __builtin_amdgcn_s_setprio(1); qk_mfma(n0, n1, cneg, kf, qr); __builtin_amdgcn_s_setprio(0);
            v_reads(vlo, vhi, lds + s0 + KV_VOFF, lane);
            __builtin_amdgcn_sched_barrier(0);
            softmax_stage<MODE>(c0, c1, pa, lsum, kt, m, trel, hi, bit);
            __builtin_amdgcn_sched_barrier(0);
            __builtin_amdgcn_s_setprio(1); pv_mfma(o, vlo, vhi, pa); __builtin_amdgcn_s_setprio(0);
        } else {
            v_reads(vlo, vhi, lds + s0 + KV_VOFF, lane);
            __builtin_amdgcn_sched_barrier(0);
            softmax_stage<MODE>(c0, c1, pa, lsum, kt, m, trel, hi, bit);
            k_reads(kf, lds + s1, r32, hi);
            __builtin_amdgcn_sched_barrier(0);
            __builtin_amdgcn_s_setprio(1); pv_mfma(o, vlo, vhi, pa);
            __builtin_amdgcn_sched_barrier(0);
            qk_mfma(n0, n1, cneg, kf, qr); __builtin_amdgcn_s_setprio(0);
        }
        kv_store(have, lds + s2, tid);
        __syncthreads();
        const int tmp = s0; s0 = s1; s1 = s2; s2 = tmp;
    };
    for (int it = 0; it < nt; it += 2) {
        step(it, sA, sB, SA0, SA1, SB0, SB1);
        if (it + 1 >= nt) break;
        step(it + 1, sB, sA, SB0, SB1, SA0, SA1);
    }
#undef TILE_CL
    lsum += __shfl_xor(lsum, 32);
    const float inv = lsum > 0.f ? 1.f / lsum : 0.f;
    const int br = MODE == M_SLC ? 1 : 2;
    const float gate = sigmoidf_(bf1(P[(size_t)(b * SEQ + t) * NCP + C_GL + hd * 3 + br]));
    const float sc = inv * gate;
    const size_t orow = (size_t)(b * SEQ + t) * 512 + hd * 64;
    if (MODE == M_SLC) {
        const bf16_t* oc = (const bf16_t*)(ws + WS_OC) + orow; const bf16_t* ow = (const bf16_t*)(ws + WS_OW) + orow;
        const bf16_t* gp = P + (size_t)(b * SEQ + t) * NCP + C_GN + hd * 64;
        bf16_t* dst = (bf16_t*)(ws + WS_XB) + (size_t)(b * SEQ + t) * DM + hd * 64;
#pragma unroll
        for (int d0 = 0; d0 < 2; ++d0)
#pragma unroll
            for (int q = 0; q < 4; ++q) { const int d = d0 * 32 + 8 * q + 4 * hi;
                const u32x2 gv = *(const u32x2*)(gp + d), cv = *(const u32x2*)(oc + d), wv = *(const u32x2*)(ow + d);
                const float g0 = bflo(gv.x), g1 = bfhi(gv.x), g2 = bflo(gv.y), g3 = bfhi(gv.y);
                const float v0 = o[d0][4 * q] * sc + bflo(cv.x) + bflo(wv.x), v1 = o[d0][4 * q + 1] * sc + bfhi(cv.x) + bfhi(wv.x);
                const float v2 = o[d0][4 * q + 2] * sc + bflo(cv.y) + bflo(wv.y), v3 = o[d0][4 * q + 3] * sc + bfhi(cv.y) + bfhi(wv.y);
                u32x2 pk; pk.x = pk2(v0 * g0 * sigmoidf_(g0), v1 * g1 * sigmoidf_(g1)); pk.y = pk2(v2 * g2 * sigmoidf_(g2), v3 * g3 * sigmoidf_(g3));
                *(u32x2*)(dst + d) = pk; }
    } else {
        bf16_t* dst = (bf16_t*)(ws + WS_OW) + orow;
#pragma unroll
        for (int d0 = 0; d0 < 2; ++d0)
#pragma unroll
            for (int q = 0; q < 4; ++q) { const int d = d0 * 32 + 8 * q + 4 * hi;
                u32x2 pk; pk.x = pk2(o[d0][4 * q] * sc, o[d0][4 * q + 1] * sc); pk.y = pk2(o[d0][4 * q + 2] * sc, o[d0][4 * q + 3] * sc);
                *(u32x2*)(dst + d) = pk; }
    }
    __syncthreads();
}

constexpr int NS_LINV = 53056, NS_SEL = 54080, NS_PW = 54784, NS_GL = 121344;

template <int MODE>
__device__ __forceinline__ void nsa_softmax(f32x16& p0, f32x16& p1, bf16x8* pa, float& lsum, float negmb, int kt, int m, int trel, int hi, unsigned bit, int nmax, LAS float* pw, float& carry) {
    if (MODE == M_CMP) {
#pragma unroll
        for (int i = 0; i < 16; ++i) { p0[i] += negmb; p1[i] += negmb; }
    }
    if (MODE == M_CMP) {
        const int lim = nmax - kt * 64;
#pragma unroll
        for (int i = 0; i < 16; ++i) { const int rel = crow(i, hi); p0[i] = rel <= lim ? ex2(p0[i]) : 0.f; p1[i] = rel + 32 <= lim ? ex2(p1[i]) : 0.f; }
#pragma unroll
        for (int q = 0; q < 8; ++q) {
            const f32x16& pq = q < 4 ? p0 : p1; const int qb = 4 * (q & 3); const float e0 = pq[qb], e1 = pq[qb + 1], e2 = pq[qb + 2], e3 = pq[qb + 3];
            float a = e0 + e1 + e2 + 0.5f * e3; const float bq = 0.5f * e3;
            const float pb = __shfl_xor(bq, 32);
            a += hi ? pb : carry;
            carry = pb;
            pw[kt * 16 + 2 * q + hi] = a;
        }
    } else {
#pragma unroll
        for (int i = 0; i < 16; ++i) { p0[i] = ex2(p0[i]); p1[i] = ex2(p1[i]); }
        if (kt == m) {
            asm volatile("" ::: "memory");
#pragma unroll
            for (int i = 0; i < 16; ++i) { const int rel = crow(i, hi); if (rel > trel) p0[i] = 0.f; if (rel + 32 > trel) p1[i] = 0.f; }
        }
        if (MODE == M_WIN && kt == m - 8) {
            asm volatile("" ::: "memory");
#pragma unroll
            for (int i = 0; i < 16; ++i) { const int rel = crow(i, hi); if (rel <= trel) p0[i] = 0.f; if (rel + 32 <= trel) p1[i] = 0.f; }
        }
    }
    float sa = 0.f, sb = 0.f, sc_ = 0.f, sd = 0.f;
#pragma unroll
    for (int i = 0; i < 16; i += 2) { sa = fadd_s(sa, p0[i]); sb = fadd_s(sb, p0[i + 1]); sc_ = fadd_s(sc_, p1[i]); sd = fadd_s(sd, p1[i + 1]); }
    float sum = fadd_s(fadd_s(sa, sb), fadd_s(sc_, sd));
    const unsigned mk = (MODE == M_SLC) ? (bit ? 0xffffffffu : 0u) : 0xffffffffu;
#pragma unroll
    for (int k = 0; k < 4; ++k) { const f32x16& p = k < 2 ? p0 : p1; const int bs = 8 * (k & 1);
        u32x4 wv = {pk2(p[bs], p[bs + 1]), pk2(p[bs + 2], p[bs + 3]), pk2(p[bs + 4], p[bs + 5]), pk2(p[bs + 6], p[bs + 7])};
        if (MODE == M_SLC) { wv.x &= mk; wv.y &= mk; wv.z &= mk; wv.w &= mk; }
        pa[k] = __builtin_bit_cast(bf16x8, wv); }
    if (MODE == M_SLC) sum = bit ? sum : 0.f;
    lsum += sum;
}

template <int MODE>
__device__ __forceinline__ void nsa_branch(LAS unsigned char* lds, const bf16_t* Kb, const int kpitch, const bf16_t* Vb, const int vpitch, const int kt_first, const int nt,
                                           const bf16x8* qr, const float negmb, f32x16* o, float& lsum, const int m, const int trel, const int tid, const int w,
                                           const unsigned sel_lo, const unsigned sel_hi, const int nmax, LAS float* pw) {
    const int lane = tid & 63, r32 = lane & 31, hi = lane >> 5;
    f32x16 cneg = splat16(MODE == M_CMP ? 0.f : negmb);
    if (MODE != M_CMP) asm volatile("" : "+v"(cneg));
    const bool grpA = (w < 4);
    float carry = 0.f;
    KVStage sA;
#define TILE_CL(i) ((kt_first + ((i) < nt ? (i) : nt - 1)) * 64)
    {   KVStage sB;
        kv_load(sA, Kb, kpitch, Vb, vpitch, TILE_CL(0), tid);
        kv_load(sB, Kb, kpitch, Vb, vpitch, TILE_CL(1), tid);
        kv_store(sA, lds, tid);
        kv_store(sB, lds + KV_BUF, tid); }
    __syncthreads();
    int s0 = 0, s1 = KV_BUF, s2 = 2 * KV_BUF;
    (void)grpA;
    for (int it = 0; it < nt; ++it) {
        const int kt = kt_first + it;
        kv_load(sA, Kb, kpitch, Vb, vpitch, TILE_CL(it + 2), tid);
        const unsigned bit = ((kt < 32 ? sel_lo : sel_hi) >> (kt & 31)) & 1u;
        bf16x8 pa[4];
        bf16x8 kf[8]; s16x4 vlo[8], vhi[8];
        f32x16 c0, c1;
        k_reads(kf, lds + s0, r32, hi);
        v_reads(vlo, vhi, lds + s0 + KV_VOFF, lane);
        __builtin_amdgcn_sched_barrier(0);
        qk_mfma(c0, c1, cneg, kf, qr);
        __builtin_amdgcn_sched_barrier(0);
        nsa_softmax<MODE>(c0, c1, pa, lsum, negmb, kt, m, trel, hi, bit, nmax, pw, carry);
        __builtin_amdgcn_sched_barrier(0);
        pv_mfma(o, vlo, vhi, pa);
        kv_store(sA, lds + s2, tid);
        __syncthreads();
        const int tmp = s0; s0 = s1; s1 = s2; s2 = tmp;
    }
#undef TILE_CL
}

__device__ __forceinline__ void nsa_item(const Args& A, LAS unsigned char* lds, int item, const int wv_) {
    unsigned char* ws = A.ws;
    const bf16_t* P = (const bf16_t*)(ws + WS_P);
    const int bg = item >> 6, m = item & 63;
    const int b = bg >> 1, g = bg & 1, T0 = 64 * m, w = wv_;
#define NSA_LANE() int tid_l = TIDX; asm volatile("" : "+v"(tid_l)); const int tid = tid_l, lane = tid & 63, r32 = lane & 31, hi = lane >> 5, hd = 4 * g + (w & 3), trel = 32 * (w >> 2) + r32, t = T0 + trel; \
                   const size_t tokrow = (size_t)(b * SEQ + t); (void)hd; (void)hi; (void)tokrow; (void)lane
    const float* mbp = (const float*)(ws + WS_MB);
    bf16x8 qr[4];
    f32x16 o[2]; float lsum;
    {   NSA_LANE();
        {
            const bf16_t* Qraw = P + tokrow * NCP + C_QN + hd * 64;
            u32x4 raw[4];
#pragma unroll
            for (int d0 = 0; d0 < 4; ++d0) raw[d0] = *(const u32x4*)(Qraw + 16 * d0 + 8 * hi);
            float y[32];
#pragma unroll
            for (int d0 = 0; d0 < 4; ++d0) { y[8 * d0] = bflo(raw[d0].x); y[8 * d0 + 1] = bfhi(raw[d0].x); y[8 * d0 + 2] = bflo(raw[d0].y); y[8 * d0 + 3] = bfhi(raw[d0].y);
                y[8 * d0 + 4] = bflo(raw[d0].z); y[8 * d0 + 5] = bfhi(raw[d0].z); y[8 * d0 + 6] = bflo(raw[d0].w); y[8 * d0 + 7] = bfhi(raw[d0].w); }
            float ss = 0.f;
#pragma unroll
            for (int i = 0; i < 32; ++i) ss += y[i] * y[i];
            ss += __shfl_xor(ss, 32);
            const float r = 1.f / sqrtf(ss * (1.f / 64.f) + EPSN);
            const float* gq = A.in[3];
#pragma unroll
            for (int d0 = 0; d0 < 4; ++d0) { const f32x4 ga = *(const f32x4*)(gq + 16 * d0 + 8 * hi), gb = *(const f32x4*)(gq + 16 * d0 + 8 * hi + 4);
                y[8 * d0] *= r * ga.x; y[8 * d0 + 1] *= r * ga.y; y[8 * d0 + 2] *= r * ga.z; y[8 * d0 + 3] *= r * ga.w; y[8 * d0 + 4] *= r * gb.x; y[8 * d0 + 5] *= r * gb.y; y[8 * d0 + 6] *= r * gb.z; y[8 * d0 + 7] *= r * gb.w; }
            const float2* rope = (const float2*)(ws + WS_ROPE) + t * 8;
#pragma unroll
            for (int j = 0; j < 8; ++j) { const float oth = __shfl_xor(y[j], 32); const float2 cs = rope[j];
                y[j] = hi ? (y[j] * cs.x + oth * cs.y) : (y[j] * cs.x - oth * cs.y); }
#pragma unroll
            for (int d0 = 0; d0 < 4; ++d0) { u32x4 u = {pk2(y[8 * d0] * C2, y[8 * d0 + 1] * C2), pk2(y[8 * d0 + 2] * C2, y[8 * d0 + 3] * C2), pk2(y[8 * d0 + 4] * C2, y[8 * d0 + 5] * C2), pk2(y[8 * d0 + 6] * C2, y[8 * d0 + 7] * C2)};
                qr[d0] = __builtin_bit_cast(bf16x8, u); }
        }
        const bf16_t* glp = P + tokrow * NCP + C_GL + hd * 3;
        LAS float* gls = (LAS float*)(lds + NS_GL) + tid;
        gls[0] = sigmoidf_(bf1(glp[0])); gls[512] = sigmoidf_(bf1(glp[1])); gls[1024] = sigmoidf_(bf1(glp[2]));
        LAS float* pw = (LAS float*)(lds + NS_PW) + (w * 32 + r32) * 65;
#pragma unroll
        for (int j = 0; j < 32; ++j) pw[hi * 32 + j] = 0.f;
        if (hi) pw[64] = 0.f;
        o[0] = splat16(0.f); o[1] = splat16(0.f); lsum = 0.f;
        const bf16_t* Kc = (const bf16_t*)(ws + WS_KCMP) + (size_t)((b * 2 + g) * 256) * 64; const bf16_t* Vc = (const bf16_t*)(ws + WS_VCMP) + (size_t)((b * 2 + g) * 256) * 64;
        nsa_branch<M_CMP>(lds, Kc, 64, Vc, 64, 0, ((4 * m + 2) >> 6) + 1, qr, -mbp[0], o, lsum, m, trel, tid, w, 0u, 0u, (t - 31) >> 4, pw);
    }
    float inv_c;
    {   NSA_LANE();
        lsum += __shfl_xor(lsum, 32);
        inv_c = lsum > 0.f ? 1.f / lsum : 0.f;
        LAS float* linv = (LAS float*)(lds + NS_LINV);
        if (hi == 0) linv[w * 32 + r32] = inv_c;
    }
    __syncthreads();
    {
        NSA_LANE();
        const LAS float* pwb = (const LAS float*)(lds + NS_PW);
        const LAS float* linv = (const LAS float*)(lds + NS_LINV);
        LAS unsigned long long* sell = (LAS unsigned long long*)(lds + NS_SEL);
        const int j = lane, blk = m;
        const bool valid = j <= blk, forced = (j == 0) || (j == blk) || (j == blk - 1);
        if (blk < 16) {
            const unsigned long long mk = __ballot(valid);
            if (lane < 8) sell[w * 8 + lane] = mk;
        } else {
            unsigned key[8], v[8];
#pragma unroll
            for (int i = 0; i < 8; ++i) {
                const int tok = w * 8 + i, half = tok >> 5, r = tok & 31;
                float sc2 = 0.f;
#pragma unroll
                for (int hh = 0; hh < 4; ++hh) sc2 += pwb[((half * 4 + hh) * 32 + r) * 65 + j] * linv[(half * 4 + hh) * 32 + r];
                const float sv = forced ? sc2 + 1.0e4f : sc2;
                key[i] = valid ? ((__float_as_uint(sv) & ~63u) | (unsigned)(63 - j)) : 0u;
                v[i] = key[i];
            }
#pragma unroll
            for (int k = 2; k <= 64; k <<= 1)
#pragma unroll
                for (int jj = k >> 1; jj > 0; jj >>= 1) {
                    const bool takemax = ((lane & jj) == 0) == ((lane & k) == 0);
#pragma unroll
                    for (int i = 0; i < 8; ++i) { const unsigned p = (unsigned)__shfl_xor((int)v[i], jj); const unsigned hi_ = v[i] > p ? v[i] : p, lo_ = v[i] > p ? p : v[i]; v[i] = takemax ? hi_ : lo_; }
                }
#pragma unroll
            for (int i = 0; i < 8; ++i) {
                const unsigned thr = (unsigned)__builtin_amdgcn_readlane((int)v[i], 15);
                const unsigned long long mk = __ballot(valid && key[i] >= thr);
                if (lane == 0) sell[w * 8 + i] = mk;
            }
        }
    }
    __syncthreads();
    {   NSA_LANE();
        const u32x2 sm = *(const LAS u32x2*)(lds + NS_SEL + trel * 8);
        LAS float* omix = (LAS float*)(lds + NS_PW) + w * 2048 + lane;
        const float sc = inv_c * ((const LAS float*)(lds + NS_GL))[tid];
#pragma unroll
        for (int i = 0; i < 16; ++i) { omix[i * 64] = o[0][i] * sc; omix[(16 + i) * 64] = o[1][i] * sc; }
        o[0] = splat16(0.f); o[1] = splat16(0.f); lsum = 0.f;
        const bf16_t* Ks = (const bf16_t*)(ws + WS_KSN) + (size_t)(b * SEQ) * 128 + g * 64; const bf16_t* Vs = P + (size_t)(b * SEQ) * NCP + C_VS + g * 64;
        nsa_branch<M_SLC>(lds, Ks, 128, Vs, NCP, 0, m + 1, qr, -mbp[1], o, lsum, m, trel, tid, w, sm.x, sm.y, 0, nullptr);
    }
    {   NSA_LANE();
        lsum += __shfl_xor(lsum, 32);
        const float inv = lsum > 0.f ? 1.f / lsum : 0.f;
        LAS float* omix = (LAS float*)(lds + NS_PW) + w * 2048 + lane;
        const float sc = inv * ((const LAS float*)(lds + NS_GL))[512 + tid];
#pragma unroll
        for (int i = 0; i < 16; ++i) { omix[i * 64] += o[0][i] * sc; omix[(16 + i) * 64] += o[1][i] * sc; }
        o[0] = splat16(0.f); o[1] = splat16(0.f); lsum = 0.f;
        const bf16_t* Kw = (const bf16_t*)(ws + WS_KWN) + (size_t)(b * SEQ) * 128 + g * 64; const bf16_t* Vw = P + (size_t)(b * SEQ) * NCP + C_VW + g * 64;
        const int kf0 = m >= 8 ? m - 8 : 0;
        nsa_branch<M_WIN>(lds, Kw, 128, Vw, NCP, kf0, m - kf0 + 1, qr, -mbp[2], o, lsum, m, trel, tid, w, 0u, 0u, 0, nullptr);
    }
    {   NSA_LANE();
        lsum += __shfl_xor(lsum, 32);
        const float inv = lsum > 0.f ? 1.f / lsum : 0.f;
        const LAS float* omix = (const LAS float*)(lds + NS_PW) + w * 2048 + lane;
        const float sc = inv * ((const LAS float*)(lds + NS_GL))[1024 + tid];
        const bf16_t* gp = P + tokrow * NCP + C_GN + hd * 64;
        bf16_t* dst = (bf16_t*)(ws + WS_XB) + tokrow * DM + hd * 64;
        u32x2 gvv[8];
#pragma unroll
        for (int e = 0; e < 8; ++e) gvv[e] = *(const u32x2*)(gp + (e >> 2) * 32 + 8 * (e & 3) + 4 * hi);
#pragma unroll
        for (int d0 = 0; d0 < 2; ++d0)
#pragma unroll
            for (int q = 0; q < 4; ++q) { const int d = d0 * 32 + 8 * q + 4 * hi;
                const u32x2 gv = gvv[d0 * 4 + q];
                const float g0 = bflo(gv.x), g1 = bfhi(gv.x), g2 = bflo(gv.y), g3 = bfhi(gv.y);
                const float v0 = o[d0][4 * q] * sc + omix[(d0 * 16 + 4 * q) * 64], v1 = o[d0][4 * q + 1] * sc + omix[(d0 * 16 + 4 * q + 1) * 64];
                const float v2 = o[d0][4 * q + 2] * sc + omix[(d0 * 16 + 4 * q + 2) * 64], v3 = o[d0][4 * q + 3] * sc + omix[(d0 * 16 + 4 * q + 3) * 64];
                u32x2 pk; pk.x = pk2(v0 * g0 * sigmoidf_(g0), v1 * g1 * sigmoidf_(g1)); pk.y = pk2(v2 * g2 * sigmoidf_(g2), v3 * g3 * sigmoidf_(g3));
                *(u32x2*)(dst + d) = pk; }
    }
#undef NSA_LANE
    __syncthreads();
}

#define XB_TMO      128
#define XB_XCNT(j)  (256  + 64 * (j))
#define XB_XSUB(j)  (1280 + 64 * (j))
#define XB_XGEN(j)  (2304 + 64 * (j))
#define XB_TOP      3328
#define XB_TOPGEN   3392
#define XCD_BAR_WORDS 3456
#define XB_SPIN_CAP (1u << 18)

__device__ __forceinline__ unsigned xb_ld(unsigned* p)              { return __hip_atomic_load(p, __ATOMIC_RELAXED, __HIP_MEMORY_SCOPE_AGENT); }
__device__ __forceinline__ unsigned xb_add(unsigned* p, unsigned v) { return __hip_atomic_fetch_add(p, v, __ATOMIC_RELAXED, __HIP_MEMORY_SCOPE_AGENT); }
__device__ __forceinline__ unsigned xb_xcc_id() { return (unsigned)__builtin_amdgcn_s_getreg((3 << 11) | 20) & 0xFu; }
#define XB_SPIN(cond, bar) do { unsigned _sp = 0; while (cond) { __builtin_amdgcn_s_sleep(1); \
    if ((++_sp & 255u) == 0u) { if (xb_ld(&(bar)[XB_TMO])) break; if (_sp > XB_SPIN_CAP) { atomicAdd(&(bar)[XB_TMO], 1u); break; } } } } while (0)

struct XcdBarrier {
    unsigned* bar; unsigned x;
    volatile LAS unsigned* st;
};

__device__ __forceinline__ XcdBarrier xcd_barrier_post(unsigned* bar, volatile LAS unsigned* st, const int wv_) {
    XcdBarrier b; b.bar = bar; b.x = xb_xcc_id(); b.st = st;
    if (TIDX == 0) (void)xb_add(&bar[XB_XCNT(b.x)], 1u);
    return b;
}
__device__ __forceinline__ void xcd_barrier_complete(unsigned* bar, unsigned x, unsigned& nloc, unsigned& nx) {
    const unsigned G = gridDim.x * gridDim.y * gridDim.z;
    unsigned sum, cnt, mine, sp = 0u;
    for (;;) {
        sum = 0u; cnt = 0u; mine = 0u;
#pragma unroll
        for (unsigned j = 0; j < 16; ++j) { const unsigned c = xb_ld(&bar[XB_XCNT(j)]); sum += c; cnt += (c > 0u) ? 1u : 0u; mine = (j == x) ? c : mine; }
        if (sum == G) break;
        __builtin_amdgcn_s_sleep(1);
        if ((++sp & 255u) == 0u) { if (xb_ld(&bar[XB_TMO])) break; if (sp > XB_SPIN_CAP) { atomicAdd(&bar[XB_TMO], 1u); break; } }
    }
    nloc = mine > 0u ? mine : 1u; nx = cnt > 0u ? cnt : 1u;
}

__device__ __forceinline__ void xcd_barrier(const XcdBarrier& b, const int wv_) {
    asm volatile("s_waitcnt vmcnt(0)" ::: "memory");
    __syncthreads();
    if (TIDX == 0) {
        unsigned* bar = b.bar;
        __builtin_amdgcn_s_waitcnt(0);
        unsigned nloc = b.st[0], nx = b.st[1];
        if (nloc == 0u) { xcd_barrier_complete(bar, b.x, nloc, nx); b.st[0] = nloc; b.st[1] = nx; }
        const unsigned old = xb_add(&bar[XB_XSUB(b.x)], 1u);
        const unsigned gen = old / nloc;
        if (old + 1u == (gen + 1u) * nloc) {
            __builtin_amdgcn_fence(__ATOMIC_RELEASE, "agent");
            asm volatile("s_waitcnt vmcnt(0)" ::: "memory");
            const unsigned og = xb_add(&bar[XB_TOP], 1u);
            const unsigned tg = og / nx;
            if (og + 1u == (tg + 1u) * nx) xb_add(&bar[XB_TOPGEN], 1u);
            else XB_SPIN(xb_ld(&bar[XB_TOPGEN]) == tg, bar);
            __builtin_amdgcn_fence(__ATOMIC_ACQUIRE, "agent");
            xb_add(&bar[XB_XGEN(b.x)], 1u);
            asm volatile("s_waitcnt vmcnt(0)" ::: "memory");
        } else {
            XB_SPIN(xb_ld(&bar[XB_XGEN(b.x)]) == gen, bar);
            __builtin_amdgcn_fence(__ATOMIC_ACQUIRE, "agent");
            asm volatile("s_waitcnt vmcnt(0)" ::: "memory");
        }
    }
    __syncthreads();
}

#define REP_P0 1
#define REP_G1 1
#define REP_P2 1
#define REP_SB 1
#define REP_WIN 1
#define REP_CMP 1
#define REP_SLC 1
#define REP_G2 1
#define XSYNC 0
__global__ void __launch_bounds__(512, 2) hybrid_fwd(Args A) {
    extern __shared__ __attribute__((aligned(16))) unsigned char lds_raw[];
    LAS unsigned char* lds = (LAS unsigned char*)lds_raw;
    cg::grid_group grid = cg::this_grid();
    const int wv_ = __builtin_amdgcn_readfirstlane((int)threadIdx.x >> 6);
    volatile LAS unsigned* bst = (volatile LAS unsigned*)(lds + 131072 + 64);
    if (TIDX < 2) bst[TIDX] = 0u;
    __syncthreads();
    XcdBarrier xbar = xcd_barrier_post((unsigned*)(A.ws + WS_CTL), bst, wv_);
    if (A.ws == nullptr) grid.sync();
#define GSYNC() xcd_barrier(xbar, wv_)
    unsigned char* ws = A.ws;
    const int G = gridDim.x, bx = blockIdx.x;

    for (int rep = 0; rep < REP_P0; ++rep) phase0(A, lds, wv_);
    GSYNC();
    for (int rep = 0; rep < XSYNC; ++rep) GSYNC();
#pragma unroll 1
    for (int rep = 0; rep < REP_G1; ++rep) {
        pg8::Gemm g{(const pg8::bf16_t*)(ws + WS_XB), (const pg8::bf16_t*)(ws + WS_WIN), NTOK, NCP, DM}; pg8::StaticOrder S; S.init(NTOK, NCP, G, bx);
        pg8::EpiProj E{(pg8::bf16_t*)(ws + WS_P), NCP, (const float*)(ws + WS_RSTD)};
        pg8::gemm_phase<pg8::EpiProj, pg8::StaticOrder, true, true>(lds, g, S, E, wv_);
    }
    GSYNC();
    if (G != 256) {
        for (int it = bx; it < 128; it += G) compress_item(A, lds, it, wv_);
        phase2_normrope(A, wv_, bx * 8 + wv_, G * 8);
        GSYNC();
    }
    if (G == 256) {
        const int x = bx & 7, j = bx >> 3;
        if (j >= 16) compress_item(A, lds, ((j - 16) >> 3) * 64 + (x >> 1) * 16 + (x & 1) * 8 + (j & 7), wv_);
        else knorm_bg(A, wv_, x, j * 8 + wv_, 16 * 8);
        group_arrive((unsigned*)(ws + WS_CTL) + 3584 + 64 * x, wv_);
    }
    for (int rep = 0; rep < REP_SB; ++rep) for (int it = bx; it < 512; it += G) {
        int item = it;
        if (G == 256) { const int x = bx & 7, idx = (bx >> 3) * 2 + (it >> 8); item = (x * 4 + (idx >> 4)) * 16 + (idx & 15); }
        attn_item<M_SB>(A, lds, item, wv_);
    }
    if (G == 256) group_wait((unsigned*)(ws + WS_CTL) + 3584 + 64 * (bx & 7), 32u, wv_);
    for (int rep = 0; rep < REP_SLC; ++rep) for (int it = bx; it < 512; it += G) {
        int item;
        if (G == 256) { const int x = bx & 7, j = bx >> 3; item = x * 64 + ((it >> 8) ? 31 - j : 32 + j); }
        else { if (it < 256) item = (it >> 5) * 64 + 32 + (it & 31); else item = ((it - 256) >> 5) * 64 + 31 - ((it - 256) & 31); }
        nsa_item(A, lds, item, wv_);
    }
    GSYNC();
    for (int rep = 0; rep < REP_G2; ++rep) {
        pg8::Gemm g{(const pg8::bf16_t*)(ws + WS_XB), (const pg8::bf16_t*)(ws + WS_WOUT), NTOK, DM, DM}; pg8::StaticOrder S; S.init(NTOK, DM, G, bx);
        pg8::EpiOut E{A.in[0], A.out, DM};
        pg8::gemm_phase<pg8::EpiOut, pg8::StaticOrder, true, true>(lds, g, S, E, wv_);
    }
}

extern "C" void kernel_launch(void* const* d_in, const int* in_sizes, int n_in, void* d_out, int out_size, void* d_ws, size_t ws_size, hipStream_t stream) {
    static int grid = 0;
    if (grid == 0) {
        if (n_in != 16 || ws_size < WS_END) { fprintf(stderr, "kernel_launch: unexpected inputs (n_in %d, ws %zu)\n", n_in, ws_size); grid = -1; return; }
        int dev = 0, cus = 0, per_cu = 0;
        hipGetDevice(&dev);
        hipDeviceGetAttribute(&cus, hipDeviceAttributeMultiprocessorCount, dev);
        if (hipFuncSetAttribute((const void*)hybrid_fwd, hipFuncAttributeMaxDynamicSharedMemorySize, LDS_BYTES) != hipSuccess) { fprintf(stderr, "kernel_launch: hipFuncSetAttribute failed\n"); }
        hipOccupancyMaxActiveBlocksPerMultiprocessor(&per_cu, (const void*)hybrid_fwd, 512, LDS_BYTES);
        if (per_cu < 1) { fprintf(stderr, "kernel_launch: occupancy query says %d blocks/CU\n", per_cu); per_cu = 1; }
        (void)hipGetLastError();
        grid = cus * 1;
    }
    if (grid < 0) return;
    Args a{};
    for (int i = 0; i < 16; ++i) a.in[i] = (const float*)d_in[i];
    a.out = (float*)d_out; a.ws = (unsigned char*)d_ws;
    for (int i = 0; i < 8; ++i) a.invf[i] = std::pow(500000.0, -(double)(2 * i) / 16.0) / 6.283185307179586476925;
    if (hipMemsetAsync((char*)d_ws + WS_CTL, 0, 16384, stream) != hipSuccess) { fprintf(stderr, "kernel_launch: memset failed\n"); return; }
    void* args[] = {&a};
    hipError_t e = hipLaunchCooperativeKernel((const void*)hybrid_fwd, dim3(grid), dim3(512), args, LDS_BYTES, stream);
    if (e != hipSuccess) fprintf(stderr, "cooperative launch failed: %s (grid %d)\n", hipGetErrorString(e), grid);
}
```

```cpp
#include <hip/hip_runtime.h>
#include <hip/hip_cooperative_groups.h>
#include <cstdio>
#include <cstdint>
#include <cmath>
namespace cg = cooperative_groups;
__device__ __forceinline__ int lane_id_opaque_g() { int x; asm volatile("v_mbcnt_lo_u32_b32 %0, -1, 0\n\tv_mbcnt_hi_u32_b32 %0, -1, %0" : "=v"(x)); return x; }
#define TIDX_G ((wv_ << 6) + lane_id_opaque_g())
namespace pg8 {
#define PG8_LAS __attribute__((address_space(3)))
typedef unsigned short bf16_t;
typedef short bf16x8 __attribute__((ext_vector_type(8)));
typedef float f32x4 __attribute__((ext_vector_type(4)));
typedef unsigned u32x4 __attribute__((ext_vector_type(4)));
constexpr int BM = 256, BK = 64, HALF = 128, HTB = HALF * BK * 2  , STAGE_BYTES = 8 * HTB, NXCD = 8, WGM = 8;

__host__ __device__ __forceinline__ int lds_byte(int r, int c) { const int st = (r >> 4) * 2 + (c >> 5), rr = r & 15, cc = c & 31, ob = rr * 64 + cc * 2; return st * 1024 + (ob ^ (((ob >> 9) & 1) << 5)); }
__host__ __device__ __forceinline__ void stage_rc(int b, int& R, int& C) { const int st = b / 1024, sb = b % 1024, swz = sb ^ (((sb >> 9) & 1) << 5); R = (st >> 1) * 16 + swz / 64; C = (st & 1) * 32 + (swz % 64) / 2; }
__host__ __device__ __forceinline__ int perm32(int rho) { const int n = rho >> 4, i = rho & 15; return 8 * (i >> 2) + 4 * n + (i & 3); }

struct Unit { int pm, pn; };
struct Gemm { const bf16_t* A; const bf16_t* Bt; int M, N, K; };

struct StaticOrder {
    int nM, nN, nwg, G, c;
    __host__ __device__ void init(int M, int N, int G_, int c_) { nM = M / BM; nN = N / BM; nwg = nM * nN; G = G_; c = c_; }
    __host__ __device__ bool next(int i, Unit& u) const {
        const long L = (long)i * G + c; if (L >= nwg) return false;
        int wgid = (int)L; { const int q = nwg / NXCD, r = nwg % NXCD, xcd = wgid % NXCD, off = wgid / NXCD; wgid = (xcd < r ? xcd * (q + 1) : r * (q + 1) + (xcd - r) * q) + off; }
        const int nig = WGM * nN, gid = wgid / nig, fm = gid * WGM, gsz = (nM - fm) < WGM ? (nM - fm) : WGM;
        u.pm = fm + ((wgid % nig) % gsz); u.pn = (wgid % nig) / gsz; return true;
    }
    __device__ __forceinline__ void a_ready(const Unit&) const {}
    __device__ __forceinline__ void done(const Unit&) const {}
};

__device__ __forceinline__ unsigned cvt_pk_bf16(float lo, float hi) { unsigned r; asm volatile("v_cvt_pk_bf16_f32 %0, %1, %2" : "=v"(r) : "v"(lo), "v"(hi)); return r; }
struct EpiProj {
    static constexpr bool PERM = true, AFTER_DRAIN = false;
    bf16_t* O; int ldc; const float* rstd;
    __device__ __forceinline__ void operator()(const f32x4 (&acc)[2][2][4][2], const Unit& u, int wr, int wc, int fr, int fq) const {
        const int row0 = u.pm * BM + wr * 64 + fr; const int col0 = u.pn * BM + wc * 32 + 8 * fq;
        float sc[2][4];
#pragma unroll
        for (int ai = 0; ai < 2; ++ai)
#pragma unroll
            for (int m = 0; m < 4; ++m) sc[ai][m] = rstd[row0 + ai * HALF + m * 16];
#pragma unroll
        for (int ai = 0; ai < 2; ++ai)
#pragma unroll
            for (int m = 0; m < 4; ++m) { const int row = row0 + ai * HALF + m * 16; const float s = sc[ai][m]; bf16_t* rowp = O + (size_t)row * ldc + col0;
#pragma unroll
                for (int bj = 0; bj < 2; ++bj) { f32x4 v0 = acc[ai][bj][m][0] * s, v1 = acc[ai][bj][m][1] * s;
                    u32x4 w; w.x = cvt_pk_bf16(v0[0], v0[1]); w.y = cvt_pk_bf16(v0[2], v0[3]); w.z = cvt_pk_bf16(v1[0], v1[1]); w.w = cvt_pk_bf16(v1[2], v1[3]);
                    *(u32x4*)(rowp + bj * HALF) = w; } }
    }
};
struct EpiOut {
    static constexpr bool PERM = true, AFTER_DRAIN = false;
    const float* X; float* O; int ldc;
    __device__ __forceinline__ void operator()(const f32x4 (&acc)[2][2][4][2], const Unit& u, int wr, int wc, int fr, int fq) const {
        const int row0 = u.pm * BM + wr * 64 + fr; const int col0 = u.pn * BM + wc * 32 + 8 * fq;
#pragma unroll
        for (int ai = 0; ai < 2; ++ai) {
            f32x4 xa[4][2][2];
#pragma unroll
            for (int m = 0; m < 4; ++m)
#pragma unroll
                for (int bj = 0; bj < 2; ++bj) { const size_t off = (size_t)(row0 + ai * HALF + m * 16) * ldc + col0 + bj * HALF;
                    xa[m][bj][0] = __builtin_nontemporal_load((const f32x4*)(X + off)); xa[m][bj][1] = __builtin_nontemporal_load((const f32x4*)(X + off + 4)); }
#pragma unroll
            for (int m = 0; m < 4; ++m)
#pragma unroll
                for (int bj = 0; bj < 2; ++bj) { const size_t off = (size_t)(row0 + ai * HALF + m * 16) * ldc + col0 + bj * HALF;
                    *(f32x4*)(O + off) = xa[m][bj][0] + acc[ai][bj][m][0]; *(f32x4*)(O + off + 4) = xa[m][bj][1] + acc[ai][bj][m][1]; }
        }
    }
};
template <class Epi, class Sched, bool ALIGN_EPI = false, bool SP2 = false>
__device__ __forceinline__ void gemm_phase(PG8_LAS unsigned char* lds, const Gemm g, const Sched& S, const Epi& E, const int wv_) {
    int tid_l = TIDX_G; asm volatile("" : "+v"(tid_l));
    const int tid = tid_l, wid = __builtin_amdgcn_readfirstlane(tid >> 6), lane = tid & 63, wr = wid >> 2, wc = wid & 3, fr = lane & 15, fq = lane >> 4;
    const int K = g.K, nt = K / BK;
    unsigned voffA[2], voffB[2];
#pragma unroll
    for (int i = 0; i < 2; ++i) { int R, C; stage_rc(tid * 16 + i * 8192, R, C); const int Rb = Epi::PERM ? ((R & ~31) + perm32(R & 31)) : R;
        voffA[i] = (unsigned)(R * K + C) * 2u; voffB[i] = (unsigned)(Rb * K + C) * 2u; }
    const size_t kstep = (size_t)(BK * 2);
    const size_t hstep = (size_t)HALF * K * 2;
    const size_t tstep = 2 * hstep;
    const unsigned ldsw = (unsigned)wid * 1024u;
    const int aoff = lds_byte(wr * 64 + fr, fq * 8), boff = lds_byte(wc * 32 + fr, fq * 8);
#define PG8_SA(b, h) (((b) * 2 + (h)) * HTB)
#define PG8_SB(b, h) ((4 + (b) * 2 + (h)) * HTB)
#define PG8_STAGE(bufoff, gbase, voff) do { _Pragma("unroll") for (int _i = 0; _i < 2; ++_i) \
        __builtin_amdgcn_global_load_lds((const unsigned*)((const char*)(gbase) + (voff)[_i]), (PG8_LAS unsigned*)(lds + (bufoff) + ldsw + _i * 8192), 16, 0, 0); } while (0)
#define PG8_LDA(dst, b, h) do { _Pragma("unroll") for (int m = 0; m < 4; ++m) _Pragma("unroll") for (int k = 0; k < 2; ++k) dst[m][k] = *(const PG8_LAS bf16x8*)(lds + PG8_SA(b, h) + aoff + m * 2048 + k * 1024); } while (0)
#define PG8_LDB(dst, b, h) do { _Pragma("unroll") for (int n = 0; n < 2; ++n) _Pragma("unroll") for (int k = 0; k < 2; ++k) dst[n][k] = *(const PG8_LAS bf16x8*)(lds + PG8_SB(b, h) + boff + n * 2048 + k * 1024); } while (0)
#define PG8_MMA(ai, bj, At, Bt) do { __builtin_amdgcn_s_setprio(1); _Pragma("unroll") for (int m = 0; m < 4; ++m) _Pragma("unroll") for (int n = 0; n < 2; ++n) _Pragma("unroll") for (int k = 0; k < 2; ++k) \
        acc[ai][bj][m][n] = __builtin_amdgcn_mfma_f32_16x16x32_bf16(Bt[n][k], At[m][k], acc[ai][bj][m][n], 0, 0, 0); __builtin_amdgcn_s_setprio(0); } while (0)
#define PG8_WAIT_V(n) asm volatile("s_waitcnt vmcnt(" #n ")" ::: "memory")
#define PG8_WAIT_L(n) asm volatile("s_waitcnt lgkmcnt(" #n ")" ::: "memory")
#define PG8_BAR __builtin_amdgcn_s_barrier()
#define PG8_SCHED __builtin_amdgcn_sched_barrier(0)
    Unit cur, nxt; int ui = 0;
    if (!S.next(0, cur)) return;
    f32x4 acc[2][2][4][2];
#pragma unroll
    for (int a = 0; a < 2; ++a)
#pragma unroll
        for (int b = 0; b < 2; ++b)
#pragma unroll
            for (int m = 0; m < 4; ++m)
#pragma unroll
                for (int n = 0; n < 2; ++n) acc[a][b][m][n] = (f32x4){0.f, 0.f, 0.f, 0.f};
    bf16x8 At[4][2], B0[2][2], B1[2][2];
    const char* cA = (const char*)g.A + (size_t)cur.pm * tstep; const char* cB = (const char*)g.Bt + (size_t)cur.pn * tstep;
    S.a_ready(cur);
    if constexpr (SP2) {
        PG8_STAGE(PG8_SB(0, 0), cB, voffB); PG8_STAGE(PG8_SB(0, 1), cB + hstep, voffB); PG8_STAGE(PG8_SA(0, 0), cA, voffA); PG8_STAGE(PG8_SA(0, 1), cA + hstep, voffA);
        if (wr == 1) PG8_BAR;
        PG8_WAIT_V(2); PG8_BAR;
        PG8_STAGE(PG8_SB(1, 0), cB + kstep, voffB); PG8_STAGE(PG8_SA(1, 0), cA + kstep, voffA); PG8_STAGE(PG8_SB(1, 1), cB + hstep + kstep, voffB);
        PG8_WAIT_V(6); PG8_BAR;
    } else {
        PG8_STAGE(PG8_SB(0, 0), cB, voffB); PG8_STAGE(PG8_SA(0, 0), cA, voffA); PG8_STAGE(PG8_SB(0, 1), cB + hstep, voffB); PG8_STAGE(PG8_SA(0, 1), cA + hstep, voffA);
        if (wr == 1) PG8_BAR;
        PG8_WAIT_V(4); PG8_BAR;
        PG8_STAGE(PG8_SB(1, 0), cB + kstep, voffB); PG8_STAGE(PG8_SA(1, 0), cA + kstep, voffA); PG8_STAGE(PG8_SB(1, 1), cB + hstep + kstep, voffB);
        PG8_WAIT_V(6); PG8_BAR;
    }
    for (;;) {
        const bool has_next = S.next(ui + 1, nxt);
        const char* nA = has_next ? (const char*)g.A + (size_t)nxt.pm * tstep : cA; const char* nB = has_next ? (const char*)g.Bt + (size_t)nxt.pn * tstep : cB;
        for (int t = 0; t < nt; t += 2) {
            const bool last = (t == nt - 2);
            const char* a1 = cA + (size_t)(t + 1) * kstep;
            const char* a2 = last ? nA : cA + (size_t)(t + 2) * kstep; const char* b2 = last ? nB : cB + (size_t)(t + 2) * kstep;
            const char* a3 = a2 + kstep; const char* b3 = b2 + kstep;
            if (last && has_next) S.a_ready(nxt);
            if constexpr (SP2) {
            PG8_LDB(B0, 0, 0); PG8_LDB(B1, 0, 1); PG8_SCHED; PG8_LDA(At, 0, 0); PG8_STAGE(PG8_SA(1, 1), a1 + hstep, voffA);
            PG8_WAIT_V(8); PG8_WAIT_L(0); PG8_BAR; PG8_MMA(0, 0, At, B0); PG8_MMA(0, 1, At, B1); PG8_BAR; PG8_SCHED;
            PG8_LDA(At, 0, 1); PG8_STAGE(PG8_SB(0, 0), b2, voffB); PG8_STAGE(PG8_SB(0, 1), b2 + hstep, voffB); PG8_STAGE(PG8_SA(0, 0), a2, voffA);
            PG8_WAIT_V(8); PG8_WAIT_L(0); PG8_BAR; PG8_MMA(1, 0, At, B0); PG8_MMA(1, 1, At, B1); PG8_BAR; PG8_SCHED;
            PG8_LDB(B0, 1, 0); PG8_LDB(B1, 1, 1); PG8_SCHED; PG8_LDA(At, 1, 0); PG8_STAGE(PG8_SA(0, 1), a2 + hstep, voffA);
            PG8_WAIT_V(8); PG8_WAIT_L(0); PG8_BAR; PG8_MMA(0, 0, At, B0); PG8_MMA(0, 1, At, B1); PG8_BAR; PG8_SCHED;
            PG8_LDA(At, 1, 1); PG8_STAGE(PG8_SB(1, 0), b3, voffB); PG8_STAGE(PG8_SB(1, 1), b3 + hstep, voffB); PG8_STAGE(PG8_SA(1, 0), a3, voffA);
            PG8_WAIT_V(8); PG8_WAIT_L(0); PG8_BAR; PG8_MMA(1, 0, At, B0); PG8_MMA(1, 1, At, B1); PG8_BAR; PG8_SCHED;
            } else {
            PG8_LDB(B0, 0, 0); PG8_SCHED; PG8_LDA(At, 0, 0); PG8_STAGE(PG8_SA(1, 1), a1 + hstep, voffA);
            PG8_WAIT_L(8); PG8_BAR; PG8_WAIT_L(0); PG8_MMA(0, 0, At, B0); PG8_BAR; PG8_SCHED;
            PG8_LDB(B1, 0, 1); PG8_STAGE(PG8_SB(0, 0), b2, voffB);
            PG8_BAR; PG8_WAIT_L(0); PG8_MMA(0, 1, At, B1); PG8_BAR;
            PG8_LDA(At, 0, 1); PG8_STAGE(PG8_SA(0, 0), a2, voffA);
            PG8_BAR; PG8_WAIT_L(0); PG8_MMA(1, 0, At, B0); PG8_BAR; PG8_SCHED;
            PG8_STAGE(PG8_SB(0, 1), b2 + hstep, voffB);
            PG8_WAIT_V(6); PG8_BAR; PG8_MMA(1, 1, At, B1); PG8_BAR;
            PG8_LDB(B0, 1, 0); PG8_SCHED; PG8_LDA(At, 1, 0); PG8_STAGE(PG8_SA(0, 1), a2 + hstep, voffA);
            PG8_WAIT_L(8); PG8_BAR; PG8_WAIT_L(0); PG8_MMA(0, 0, At, B0); PG8_BAR; PG8_SCHED;
            PG8_LDB(B1, 1, 1); PG8_STAGE(PG8_SB(1, 0), b3, voffB);
            PG8_BAR; PG8_WAIT_L(0); PG8_MMA(0, 1, At, B1); PG8_BAR;
            PG8_LDA(At, 1, 1); PG8_STAGE(PG8_SA(1, 0), a3, voffA);
            PG8_BAR; PG8_WAIT_L(0); PG8_MMA(1, 0, At, B0); PG8_BAR; PG8_SCHED;
            PG8_STAGE(PG8_SB(1, 1), b3 + hstep, voffB);
            PG8_WAIT_V(6); PG8_BAR; PG8_MMA(1, 1, At, B1); PG8_BAR;
            }
        }
        if constexpr (ALIGN_EPI) { if (wr == 0) PG8_BAR; }
        if constexpr (!Epi::AFTER_DRAIN) { E(acc, cur, wr, wc, fr, fq); S.done(cur); }
        if (!has_next) break;
#pragma unroll
        for (int a = 0; a < 2; ++a)
#pragma unroll
            for (int b = 0; b < 2; ++b)
#pragma unroll
                for (int m = 0; m < 4; ++m)
#pragma unroll
                    for (int n = 0; n < 2; ++n) acc[a][b][m][n] = (f32x4){0.f, 0.f, 0.f, 0.f};
        cur = nxt; cA = nA; cB = nB; ++ui;
        if constexpr (ALIGN_EPI) { if (wr == 1) PG8_BAR; }
    }
    PG8_WAIT_V(0);
    if constexpr (!ALIGN_EPI) { if (wr == 0) PG8_BAR; }
    PG8_BAR;
    if constexpr (Epi::AFTER_DRAIN) { E.fused(acc, cur, wr, wc, fr, fq, lds, wid, lane); S.done(cur); }
#undef PG8_SA
#undef PG8_SB
#undef PG8_STAGE
#undef PG8_LDA
#undef PG8_LDB
#undef PG8_MMA
#undef PG8_WAIT_V
#undef PG8_WAIT_L
#undef PG8_BAR
#undef PG8_SCHED
}
}

#define LAS __attribute__((address_space(3)))
typedef unsigned short bf16_t;
typedef short bf16x8 __attribute__((ext_vector_type(8)));
typedef short s16x4 __attribute__((ext_vector_type(4)));
typedef float f32x4 __attribute__((ext_vector_type(4)));
typedef float f32x16 __attribute__((ext_vector_type(16)));
typedef unsigned u32x4 __attribute__((ext_vector_type(4)));
typedef unsigned u32x2 __attribute__((ext_vector_type(2)));

constexpr int NB = 4, SEQ = 4096, NTOK = NB * SEQ, DM = 1024, NCP = 4096, NCOLS = 3864;
constexpr int C_QN = 0, C_KC = 512, C_VC = 640, C_KS = 768, C_VS = 896, C_KW = 1024, C_VW = 1152, C_GN = 1280, C_QSB = 1792, C_KSB = 2304, C_VSB = 2816, C_GSB = 3328, C_GL = 3840;
constexpr size_t MiB = 1u << 20;
constexpr size_t WS_WIN = 0, WS_WOUT = 8 * MiB, WS_W1T = 10 * MiB, WS_RSTD = 11 * MiB, WS_ROPE = 11 * MiB + 64 * 1024, WS_CBIAS = 11 * MiB + 384 * 1024, WS_MB = 11 * MiB + 400 * 1024;
constexpr size_t WS_KCMP = 12 * MiB, WS_VCMP = 12 * MiB + 512 * 1024, WS_SEL = 13 * MiB, WS_CTL = 14 * MiB, WS_XB = 16 * MiB, WS_P = 48 * MiB, WS_QN = 176 * MiB, WS_KSN = 192 * MiB, WS_KWN = 196 * MiB, WS_OC = 200 * MiB, WS_OW = 216 * MiB, WS_END = 232 * MiB;
constexpr int LDS_BYTES = 135168;
constexpr float C2 = 0.125f * 1.4426950408889634f;
constexpr float EPSN = 1e-6f;

struct Args { const float* in[16]; float* out; unsigned char* ws; double invf[8]; };

__device__ __forceinline__ unsigned pk2(float lo, float hi) {
    typedef float f2_t __attribute__((ext_vector_type(2))); typedef __bf16 b2_t __attribute__((ext_vector_type(2)));
    f2_t v = {lo, hi}; b2_t b = __builtin_convertvector(v, b2_t); return __builtin_bit_cast(unsigned, b); }
__device__ __forceinline__ float bflo(unsigned u) { return __uint_as_float(u << 16); }
__device__ __forceinline__ float bfhi(unsigned u) { return __uint_as_float(u & 0xffff0000u); }
__device__ __forceinline__ float bf1(bf16_t h) { return __uint_as_float(((unsigned)h) << 16); }
__device__ __forceinline__ float ex2(float x) { return __builtin_amdgcn_exp2f(x); }
__device__ __forceinline__ float lg2(float x) { return __builtin_amdgcn_logf(x); }
__device__ __forceinline__ float sigmoidf_(float x) { return 1.f / (1.f + __expf(-x)); }
__device__ __forceinline__ float wave_sum(float v) {
#pragma unroll
    for (int o = 1; o < 64; o <<= 1) v += __shfl_xor(v, o);
    return v;
}
__device__ __forceinline__ float wave_max(float v) {
#pragma unroll
    for (int o = 1; o < 64; o <<= 1) v = fmaxf(v, __shfl_xor(v, o));
    return v;
}
#define LDS_WAIT() asm volatile("s_waitcnt lgkmcnt(0)" ::: "memory")
__device__ __forceinline__ int lane_id_opaque() { int x; asm volatile("v_mbcnt_lo_u32_b32 %0, -1, 0\n\tv_mbcnt_hi_u32_b32 %0, -1, %0" : "=v"(x)); return x; }
#define TIDX ((wv_ << 6) + lane_id_opaque())
#define MFMA32(a, b, c) __builtin_amdgcn_mfma_f32_32x32x16_bf16((a), (b), (c), 0, 0, 0)

template <int MODE>
__device__ __forceinline__ void transpose_item(const float* W, int ldw, const float* gain, bf16_t* WT, int Kd, LAS float* scr, int kb, int nb, int lane) {
    const int k0 = 64 * kb, n0 = 32 * nb, n = n0 + (lane & 31);
    int sc = n; bool ok = true;
    if (MODE == 0) { if (n < 1280) sc = n; else if (n < 3840) sc = n + 24; else if (n < NCOLS) sc = n - 3840 + 1280; else { sc = 0; ok = false; } }
    float tv[32];
#pragma unroll
    for (int i = 0; i < 32; ++i) { const int kk = 2 * i + (lane >> 5); tv[i] = ok ? __builtin_nontemporal_load(W + (size_t)(k0 + kk) * ldw + sc) : 0.f; }
#pragma unroll
    for (int i = 0; i < 32; ++i) { const int kk = 2 * i + (lane >> 5); float v = tv[i]; if (MODE == 0) v *= gain[k0 + kk]; scr[kk * 33 + (lane & 31)] = v; }
    LDS_WAIT();
    const int c = lane & 7;
#pragma unroll
    for (int j = 0; j < 4; ++j) { const int nn = (lane >> 3) + 8 * j; const LAS float* s = scr + (8 * c) * 33 + nn;
        u32x4 o; o.x = pk2(s[0 * 33], s[1 * 33]); o.y = pk2(s[2 * 33], s[3 * 33]); o.z = pk2(s[4 * 33], s[5 * 33]); o.w = pk2(s[6 * 33], s[7 * 33]);
        *(u32x4*)(WT + (size_t)(n0 + nn) * Kd + k0 + 8 * c) = o; }
    LDS_WAIT();
}

__device__ __forceinline__ void phase0(const Args& A, LAS unsigned char* lds, const int wv_) {
    const int tid = TIDX, lane = tid & 63, wave = __builtin_amdgcn_readfirstlane(tid >> 6);
    const int gw = blockIdx.x * 8 + wave, NGW = gridDim.x * 8;
    unsigned char* ws = A.ws;
    LAS float* scr = (LAS float*)(lds + wave * 8704);
    bf16_t* WinT = (bf16_t*)(ws + WS_WIN); bf16_t* WoutT = (bf16_t*)(ws + WS_WOUT); bf16_t* W1T = (bf16_t*)(ws + WS_W1T);
    constexpr int I_IN = 16 * 128, I_OUT = 16 * 32, I_W1 = 32 * 2;
    for (int it = gw; it < I_IN + I_OUT + 2 * I_W1; it += NGW) {
        int r = it;
        if (r < I_IN) { transpose_item<0>(A.in[2], NCOLS, A.in[1], WinT, DM, scr, r / 128, r % 128, lane); continue; } r -= I_IN;
        if (r < I_OUT) { transpose_item<1>(A.in[15], DM, nullptr, WoutT, DM, scr, r / 32, r % 32, lane); continue; } r -= I_OUT;
        if (r < I_W1) { transpose_item<1>(A.in[8], 64, nullptr, W1T, 2048, scr, r / 2, r % 2, lane); continue; } r -= I_W1;
        transpose_item<1>(A.in[12], 64, nullptr, W1T + 64 * 2048, 2048, scr, r / 2, r % 2, lane);
    }
    const float* x = A.in[0]; bf16_t* xb = (bf16_t*)(ws + WS_XB); float* rstd = (float*)(ws + WS_RSTD);
    for (int m0 = gw; m0 < NTOK; m0 += 2 * NGW) {
        f32x4 v[2][4];
#pragma unroll
        for (int u = 0; u < 2; ++u) { const int m = m0 + u * NGW; const f32x4* xr = (const f32x4*)(x + (size_t)m * DM) + lane;
#pragma unroll
            for (int j = 0; j < 4; ++j) v[u][j] = __builtin_nontemporal_load(xr + 64 * j); }
#pragma unroll
        for (int u = 0; u < 2; ++u) { const int m = m0 + u * NGW; float s = 0.f;
#pragma unroll
            for (int j = 0; j < 4; ++j) s += (v[u][j].x * v[u][j].x + v[u][j].y * v[u][j].y) + (v[u][j].z * v[u][j].z + v[u][j].w * v[u][j].w);
            s = wave_sum(s);
            if (lane == 0) rstd[m] = 1.f / sqrtf(s * (1.f / DM) + EPSN);
            unsigned long long* o8 = (unsigned long long*)(xb + (size_t)m * DM) + lane;
#pragma unroll
            for (int j = 0; j < 4; ++j) o8[64 * j] = (unsigned long long)pk2(v[u][j].x, v[u][j].y) | ((unsigned long long)pk2(v[u][j].z, v[u][j].w) << 32); }
    }
    float* cbias = (float*)(ws + WS_CBIAS);
    for (int it = NGW - 1 - gw; it < 128; it += NGW) {
        const int kv = it >> 6, n = it & 63;
        const float* pos = A.in[kv ? 11 : 7]; const float* w1 = A.in[kv ? 12 : 8]; const float* b1 = A.in[kv ? 13 : 9];
        float pv_[32], wv_l[32];
#pragma unroll
        for (int i = 0; i < 32; ++i) { const int k = lane + 64 * i; pv_[i] = pos[k]; wv_l[i] = w1[(size_t)k * 64 + n]; }
        float s = 0.f;
#pragma unroll
        for (int i = 0; i < 32; ++i) s += pv_[i] * wv_l[i];
        s = wave_sum(s);
        if (lane == 0) cbias[it] = s + b1[n];
    }
    float2* rope = (float2*)(ws + WS_ROPE);
    for (int e = (gridDim.x - 1 - blockIdx.x) * 512 + tid; e < SEQ * 8; e += gridDim.x * 512) {
        const int pos = e >> 3, i = e & 7;
        double rev = (double)pos * A.invf[i];
        rev -= floor(rev);
        const float rf = (float)rev;
        rope[e] = make_float2(__builtin_amdgcn_cosf(rf), __builtin_amdgcn_sinf(rf));
    }
    if (blockIdx.x == gridDim.x - 1 && wave == 7) {
        const float gq = wave_max(fabsf(A.in[3][lane]));
        const float gc = wave_max(fabsf(A.in[4][lane])), gs = wave_max(fabsf(A.in[5][lane])), gwn = wave_max(fabsf(A.in[6][lane]));
        float* mb = (float*)(ws + WS_MB);
        if (lane == 0) { mb[0] = 8.f * gq * gc * 1.4426950408889634f * 1.02f; mb[1] = 8.f * gq * gs * 1.4426950408889634f * 1.02f; mb[2] = 8.f * gq * gwn * 1.4426950408889634f * 1.02f; }
    }
}

__device__ __forceinline__ void phase2_normrope(const Args& A, const int wv_, const int gw0, const int ngw) {
    const int tid = TIDX, lane = tid & 63;
    unsigned char* ws = A.ws;
    const bf16_t* __restrict__ P = (const bf16_t*)(ws + WS_P);
    bf16_t* __restrict__ ksn = (bf16_t*)(ws + WS_KSN); bf16_t* __restrict__ kwn = (bf16_t*)(ws + WS_KWN);
    const float2* __restrict__ rope = (const float2*)(ws + WS_ROPE);
    const int sub = lane & 7;
#pragma unroll 4
    for (int vb = gw0 * 8; vb < NTOK * 4; vb += ngw * 8) {
        const int v = vb + (lane >> 3);
        const int t = v >> 2, which = v & 3;
        int scol; const float* gain; bf16_t* dst;
        if (which < 2) { scol = C_KS + which * 64; gain = A.in[5]; dst = ksn + (size_t)t * 128 + which * 64; }
        else { scol = C_KW + (which - 2) * 64; gain = A.in[6]; dst = kwn + (size_t)t * 128 + (which - 2) * 64; }
        const u32x4 raw = *(const u32x4*)(P + (size_t)t * NCP + scol + sub * 8);
        float y[8];
        y[0] = bflo(raw.x); y[1] = bfhi(raw.x); y[2] = bflo(raw.y); y[3] = bfhi(raw.y); y[4] = bflo(raw.z); y[5] = bfhi(raw.z); y[6] = bflo(raw.w); y[7] = bfhi(raw.w);
        float ss = 0.f;
#pragma unroll
        for (int i = 0; i < 8; ++i) ss += y[i] * y[i];
        ss += __shfl_xor(ss, 1); ss += __shfl_xor(ss, 2); ss += __shfl_xor(ss, 4);
        const float r = 1.f / sqrtf(ss * (1.f / 64.f) + EPSN);
        const f32x4 g0 = *(const f32x4*)(gain + sub * 8), g1 = *(const f32x4*)(gain + sub * 8 + 4);
        y[0] *= r * g0.x; y[1] *= r * g0.y; y[2] *= r * g0.z; y[3] *= r * g0.w; y[4] *= r * g1.x; y[5] *= r * g1.y; y[6] *= r * g1.z; y[7] *= r * g1.w;
        const int pos = t & (SEQ - 1);
#pragma unroll
        for (int i = 0; i < 8; ++i) {
            const float oth = __shfl_xor(y[i], 1);
            const float2 cs = rope[pos * 8 + i];
            if (sub == 0) y[i] = y[i] * cs.x - oth * cs.y;
            else if (sub == 1) y[i] = y[i] * cs.x + oth * cs.y;
        }
        u32x4 o; o.x = pk2(y[0], y[1]); o.y = pk2(y[2], y[3]); o.z = pk2(y[4], y[5]); o.w = pk2(y[6], y[7]);
        *(u32x4*)(dst + sub * 8) = o;
    }
}

__device__ __forceinline__ void knorm_bg(const Args& A, const int wv_, const int bg, const int gw0, const int ngw) {
    const int tid = TIDX, lane = tid & 63;
    unsigned char* ws = A.ws;
    const bf16_t* __restrict__ P = (const bf16_t*)(ws + WS_P);
    bf16_t* __restrict__ ksn = (bf16_t*)(ws + WS_KSN); bf16_t* __restrict__ kwn = (bf16_t*)(ws + WS_KWN);
    const float2* __restrict__ rope = (const float2*)(ws + WS_ROPE);
    const int sub = lane & 7, b = bg >> 1, g = bg & 1;
#pragma unroll 4
    for (int ub = gw0 * 8; ub < SEQ * 2; ub += ngw * 8) {
        const int u = ub + (lane >> 3);
        const int t = b * SEQ + (u >> 1), win = u & 1;
        const int scol = (win ? C_KW : C_KS) + g * 64; const float* gain = A.in[win ? 6 : 5]; bf16_t* dst = (win ? kwn : ksn) + (size_t)t * 128 + g * 64;
        const u32x4 raw = *(const u32x4*)(P + (size_t)t * NCP + scol + sub * 8);
        float y[8];
        y[0] = bflo(raw.x); y[1] = bfhi(raw.x); y[2] = bflo(raw.y); y[3] = bfhi(raw.y); y[4] = bflo(raw.z); y[5] = bfhi(raw.z); y[6] = bflo(raw.w); y[7] = bfhi(raw.w);
        float ss = 0.f;
#pragma unroll
        for (int i = 0; i < 8; ++i) ss += y[i] * y[i];
        ss += __shfl_xor(ss, 1); ss += __shfl_xor(ss, 2); ss += __shfl_xor(ss, 4);
        const float r = 1.f / sqrtf(ss * (1.f / 64.f) + EPSN);
        const f32x4 g0 = *(const f32x4*)(gain + sub * 8), g1 = *(const f32x4*)(gain + sub * 8 + 4);
        y[0] *= r * g0.x; y[1] *= r * g0.y; y[2] *= r * g0.z; y[3] *= r * g0.w; y[4] *= r * g1.x; y[5] *= r * g1.y; y[6] *= r * g1.z; y[7] *= r * g1.w;
        const int pos = t & (SEQ - 1);
#pragma unroll
        for (int i = 0; i < 8; ++i) {
            const float oth = __shfl_xor(y[i], 1);
            const float2 cs = rope[pos * 8 + i];
            if (sub == 0) y[i] = y[i] * cs.x - oth * cs.y;
            else if (sub == 1) y[i] = y[i] * cs.x + oth * cs.y;
        }
        u32x4 o; o.x = pk2(y[0], y[1]); o.y = pk2(y[2], y[3]); o.z = pk2(y[4], y[5]); o.w = pk2(y[6], y[7]);
        *(u32x4*)(dst + sub * 8) = o;
    }
}
__device__ __forceinline__ void group_arrive(unsigned* ctr, const int wv_) {
    asm volatile("s_waitcnt vmcnt(0)" ::: "memory");
    __syncthreads();
    if (TIDX == 0) {
        __builtin_amdgcn_fence(__ATOMIC_RELEASE, "agent");
        asm volatile("s_waitcnt vmcnt(0)" ::: "memory");
        __hip_atomic_fetch_add(ctr, 1u, __ATOMIC_RELAXED, __HIP_MEMORY_SCOPE_AGENT);
    }
}
__device__ __forceinline__ void group_wait(unsigned* ctr, const unsigned n, const int wv_) {
    if (TIDX == 0) {
        unsigned sp = 0;
        while (__hip_atomic_load(ctr, __ATOMIC_RELAXED, __HIP_MEMORY_SCOPE_AGENT) < n) { __builtin_amdgcn_s_sleep(1); if (++sp > (1u << 22)) break; }
        __builtin_amdgcn_fence(__ATOMIC_ACQUIRE, "agent");
        asm volatile("s_waitcnt vmcnt(0)" ::: "memory");
    }
    __syncthreads();
}

__device__ __forceinline__ void compress_item(const Args& A, LAS unsigned char* lds, int item, const int wv_) {
    const int tid = TIDX, lane = tid & 63, r32 = lane & 31, hi = lane >> 5, wave = __builtin_amdgcn_readfirstlane(tid >> 6);
    unsigned char* ws = A.ws;
    const int kv = item >> 6, b = (item >> 4) & 3, g = (item >> 3) & 1, nt = item & 7, n0 = 32 * nt;
    const bf16_t* P = (const bf16_t*)(ws + WS_P);
    const bf16_t* W1T = (const bf16_t*)(ws + WS_W1T) + (size_t)kv * 64 * 2048;
    const int col = (kv ? C_VC : C_KC) + g * 64;
    const int n = n0 + r32; const bool nok = n <= 254;
    f32x16 acc0 = {}, acc1 = {};
#pragma unroll 8
    for (int ks = 0; ks < 16; ++ks) {
        const int kk = 256 * wave + 16 * ks + 8 * hi;
        const int tok = 16 * n + (kk >> 6), d = kk & 63;
        bf16x8 a = {};
        if (nok) a = *(const bf16x8*)(P + (size_t)(b * SEQ + tok) * NCP + col + d);
        const bf16x8 b0 = *(const bf16x8*)(W1T + (size_t)r32 * 2048 + kk);
        const bf16x8 b1 = *(const bf16x8*)(W1T + (size_t)(32 + r32) * 2048 + kk);
        acc0 = MFMA32(a, b0, acc0); acc1 = MFMA32(a, b1, acc1);
    }
    LAS float* red = (LAS float*)lds;
    LAS float* hid = (LAS float*)(lds + 65536);
#pragma unroll
    for (int i = 0; i < 16; ++i) { const int row = (i & 3) + 8 * (i >> 2) + 4 * hi; red[(wave * 32 + row) * 64 + r32] = acc0[i]; red[(wave * 32 + row) * 64 + 32 + r32] = acc1[i]; }
    __syncthreads();
    const float* cbias = (const float*)(ws + WS_CBIAS) + kv * 64;
#pragma unroll
    for (int j = 0; j < 4; ++j) { const int e = tid + 512 * j, c = e & 63; float s = cbias[c];
#pragma unroll
        for (int w = 0; w < 8; ++w) s += red[w * 2048 + e];
        hid[e] = s * sigmoidf_(s); }
    __syncthreads();
    const float* w2 = A.in[kv ? 14 : 10];
    const int row = tid >> 4, c4 = (tid & 15) * 4;
    f32x4 o = {0.f, 0.f, 0.f, 0.f};
    for (int j = 0; j < 64; ++j) { const float hv = hid[row * 64 + j]; const f32x4 wv = *(const f32x4*)(w2 + j * 64 + c4); o += wv * hv; }
    const int nn = n0 + row;
    bf16_t* dst = (bf16_t*)(ws + (kv ? WS_VCMP : WS_KCMP)) + ((size_t)((b * 2 + g) * 256 + nn)) * 64 + c4;
    if (kv == 0) {
        float ss = o.x * o.x + o.y * o.y + o.z * o.z + o.w * o.w;
        ss += __shfl_xor(ss, 1); ss += __shfl_xor(ss, 2); ss += __shfl_xor(ss, 4); ss += __shfl_xor(ss, 8);
        const float r = 1.f / sqrtf(ss * (1.f / 64.f) + EPSN);
        const f32x4 gn = *(const f32x4*)(A.in[4] + c4);
        o = o * r * gn;
        const int pos = 16 * nn + 31;
        const f32x4 oth = {__shfl_xor(o.x, 2), __shfl_xor(o.y, 2), __shfl_xor(o.z, 2), __shfl_xor(o.w, 2)};
        const int cc = tid & 15;
        if (cc < 4 && nn <= 254) {
            const float2* rope = (const float2*)(ws + WS_ROPE) + pos * 8 + (cc & 1) * 4;
            const float2 c0 = rope[0], c1 = rope[1], c2_ = rope[2], c3 = rope[3];
            if (cc < 2) { o.x = o.x * c0.x - oth.x * c0.y; o.y = o.y * c1.x - oth.y * c1.y; o.z = o.z * c2_.x - oth.z * c2_.y; o.w = o.w * c3.x - oth.w * c3.y; }
            else        { o.x = o.x * c0.x + oth.x * c0.y; o.y = o.y * c1.x + oth.y * c1.y; o.z = o.z * c2_.x + oth.z * c2_.y; o.w = o.w * c3.x + oth.w * c3.y; }
        }
    }
    if (nn > 254) o = (f32x4){0.f, 0.f, 0.f, 0.f};
    u32x2 pk; pk.x = pk2(o.x, o.y); pk.y = pk2(o.z, o.w);
    *(u32x2*)dst = pk;
    __syncthreads();
}

constexpr int KV_BUF = 17664, KV_VOFF = 9216, V_HALF = 4224;
constexpr int ATT_FLAGS = 35328, ATT_LINV = 35392, ATT_PW = 36416;

struct KVStage { u32x4 k, v; };
__device__ __forceinline__ void kv_load(KVStage& st, const bf16_t* Kb, int kpitch, const bf16_t* Vb, int vpitch, int key0, int tid) {
    const int key = tid >> 3, c = tid & 7;
    st.k = *(const u32x4*)(Kb + (size_t)(key0 + key) * kpitch + c * 8);
    st.v = *(const u32x4*)(Vb + (size_t)(key0 + key) * vpitch + c * 8);
}
__device__ __forceinline__ void kv_store(const KVStage& st, LAS unsigned char* buf, int tid) {
    const int key = tid >> 3, c = tid & 7;
    *(LAS u32x4*)(buf + key * 144 + c * 16) = st.k;
    *(LAS u32x4*)(buf + KV_VOFF + (c >> 2) * V_HALF + key * 64 + (c & 3) * 16) = st.v;
}
__device__ __forceinline__ void qk_tile(f32x16& p0, f32x16& p1, const f32x16& cinit, const LAS unsigned char* kb, const bf16x8* qr, int r32, int hi) {
    const LAS unsigned char* base = kb + r32 * 144 + hi * 16;
    { const bf16x8 a0 = *(const LAS bf16x8*)(base), a1 = *(const LAS bf16x8*)(base + 32 * 144);
      p0 = MFMA32(a0, qr[0], cinit); p1 = MFMA32(a1, qr[0], cinit); }
#pragma unroll
    for (int d0 = 1; d0 < 4; ++d0) { const bf16x8 a0 = *(const LAS bf16x8*)(base + d0 * 32), a1 = *(const LAS bf16x8*)(base + 32 * 144 + d0 * 32);
        p0 = MFMA32(a0, qr[d0], p0); p1 = MFMA32(a1, qr[d0], p1); }
}
typedef short v4i16_t __attribute__((ext_vector_type(4)));
__device__ __forceinline__ s16x4 vtr(const LAS unsigned char* p) { return __builtin_bit_cast(s16x4, __builtin_amdgcn_ds_read_tr16_b64_v4i16((LAS v4i16_t*)p)); }
__device__ __forceinline__ void pv_packed(f32x16* o, const LAS unsigned char* vb, const bf16x8* pa, int lane) {
    const int hi = lane >> 5;
    const LAS unsigned char* base = vb + ((lane >> 4) & 1) * 32 + (lane & 3) * 8 + (4 * hi + ((lane & 15) >> 2)) * 64;
#pragma unroll
    for (int d0 = 0; d0 < 2; ++d0)
#pragma unroll
        for (int s = 0; s < 4; ++s) {
            const s16x4 lo = vtr(base + d0 * V_HALF + s * 1024);
            const s16x4 hh = vtr(base + d0 * V_HALF + s * 1024 + 512);
            const bf16x8 vf = __builtin_shufflevector(lo, hh, 0, 1, 2, 3, 4, 5, 6, 7);
            o[d0] = MFMA32(vf, pa[s], o[d0]);
        }
}
__device__ __forceinline__ void pack_half(bf16x8* pa2, const f32x16& p) {
    u32x4 w0 = {pk2(p[0], p[1]), pk2(p[2], p[3]), pk2(p[4], p[5]), pk2(p[6], p[7])};
    u32x4 w1 = {pk2(p[8], p[9]), pk2(p[10], p[11]), pk2(p[12], p[13]), pk2(p[14], p[15])};
    pa2[0] = __builtin_bit_cast(bf16x8, w0); pa2[1] = __builtin_bit_cast(bf16x8, w1);
}
__device__ __forceinline__ void pv_tile(f32x16* o, const LAS unsigned char* vb, const f32x16& p0, const f32x16& p1, int lane) {
    bf16x8 pa[4]; pack_half(pa, p0); pack_half(pa + 2, p1);
    pv_packed(o, vb, pa, lane);
}
__device__ __forceinline__ f32x16 splat16(float v) { f32x16 r;
#pragma unroll
    for (int i = 0; i < 16; ++i) r[i] = v;
    return r; }
__device__ __forceinline__ int crow(int i, int hi) { return (i & 3) + 8 * (i >> 2) + 4 * hi; }

enum { M_WIN = 0, M_SLC = 1, M_SB = 2, M_CMP = 3 };

template <int MODE>
__device__ __forceinline__ void attn_item(const Args& A, LAS unsigned char* lds, int item, const int wv_) {
    int tid_l = TIDX; asm volatile("" : "+v"(tid_l));
    const int tid = tid_l, lane = tid & 63, r32 = lane & 31, hi = lane >> 5, w = __builtin_amdgcn_readfirstlane(tid >> 6);
    unsigned char* ws = A.ws;
    const bf16_t* P = (const bf16_t*)(ws + WS_P);
    int b, g = 0, hd, m, T0, trel;
    const bf16_t *Qrow, *Kb, *Vb; int kpitch, vpitch, kt_first, nt, kt_step = 1;
    if (MODE == M_SB) {
        b = item >> 7; hd = (item >> 4) & 7; m = item & 15; T0 = 256 * m; trel = 32 * w + r32;
        Qrow = P + (size_t)(b * SEQ + T0 + trel) * NCP + C_QSB + hd * 64;
        Kb = P + (size_t)(b * SEQ) * NCP + C_KSB + hd * 64; Vb = P + (size_t)(b * SEQ) * NCP + C_VSB + hd * 64; kpitch = NCP; vpitch = NCP;
        kt_first = 4 * m + 3; nt = 4 * m + 4; kt_step = -1;
    } else {
        if (MODE == M_SLC) { int bg; if (item < 256) { bg = item >> 5; m = 32 + (item & 31); } else { const int i2 = item - 256; bg = i2 >> 5; m = 31 - (i2 & 31); } b = bg >> 1; g = bg & 1; }
        else { b = item >> 7; g = (item >> 6) & 1; m = item & 63; }
        T0 = 64 * m; hd = 4 * g + (w & 3); trel = 32 * (w >> 2) + r32;
        Qrow = (const bf16_t*)(ws + WS_QN) + (size_t)(b * SEQ + T0 + trel) * 512 + hd * 64;
        if (MODE == M_WIN) { Kb = (const bf16_t*)(ws + WS_KWN) + (size_t)(b * SEQ) * 128 + g * 64; kpitch = 128; Vb = P + (size_t)(b * SEQ) * NCP + C_VW + g * 64; vpitch = NCP; kt_first = m >= 8 ? m - 8 : 0; nt = m - kt_first + 1; }
        else if (MODE == M_SLC) { Kb = (const bf16_t*)(ws + WS_KSN) + (size_t)(b * SEQ) * 128 + g * 64; kpitch = 128; Vb = P + (size_t)(b * SEQ) * NCP + C_VS + g * 64; vpitch = NCP; kt_first = 0; nt = m + 1; }
        else { Kb = (const bf16_t*)(ws + WS_KCMP) + (size_t)((b * 2 + g) * 256) * 64; kpitch = 64; Vb = (const bf16_t*)(ws + WS_VCMP) + (size_t)((b * 2 + g) * 256) * 64; vpitch = 64; kt_first = 0; nt = ((4 * m + 2) >> 6) + 1; }
    }
    const int t = T0 + trel;
    bf16x8 qr[4];
#pragma unroll
    for (int d0 = 0; d0 < 4; ++d0) qr[d0] = *(const bf16x8*)(Qrow + 16 * d0 + 8 * hi);
    if (MODE == M_SB) {
#pragma unroll
        for (int d0 = 0; d0 < 4; ++d0) { u32x4 u = __builtin_bit_cast(u32x4, qr[d0]);
            u.x = pk2(bflo(u.x) * C2, bfhi(u.x) * C2); u.y = pk2(bflo(u.y) * C2, bfhi(u.y) * C2); u.z = pk2(bflo(u.z) * C2, bfhi(u.z) * C2); u.w = pk2(bflo(u.w) * C2, bfhi(u.w) * C2);
            qr[d0] = __builtin_bit_cast(bf16x8, u); }
    }
    float negmb = 0.f;
    if (MODE != M_SB) negmb = -((const float*)(ws + WS_MB))[MODE == M_CMP ? 0 : (MODE == M_SLC ? 1 : 2)];
    unsigned sel_lo = 0, sel_hi = 0;
    if (MODE == M_SLC) { const u32x2 sm = *(const u32x2*)((const unsigned long long*)(ws + WS_SEL) + (size_t)(b * 2 + g) * SEQ + t); sel_lo = sm.x; sel_hi = sm.y; }
    const int nmax = (t - 31) >> 4;
    f32x16 o[2]; o[0] = splat16(0.f); o[1] = splat16(0.f);
    float lsum = 0.f, carry = (MODE == M_SB) ? 1.f : 0.f  ;
    bool done = false;
    LAS unsigned* flags = (LAS unsigned*)(lds + ATT_FLAGS);
    LAS float* pw = (LAS float*)(lds + ATT_PW) + (w * 32 + r32) * 65;
    if (MODE == M_CMP) {
#pragma unroll
        for (int j = 0; j < 32; ++j) pw[hi * 32 + j] = 0.f;
        if (hi) pw[64] = 0.f;
    }
    f32x16 cneg = splat16(negmb);
    if (MODE != M_SB) asm volatile("" : "+v"(cneg));
    KVStage sA, sB;
    kv_load(sA, Kb, kpitch, Vb, vpitch, kt_first * 64, tid);
    kv_store(sA, lds, tid);
    kv_load(sA, Kb, kpitch, Vb, vpitch, (kt_first + (nt > 1 ? kt_step : 0)) * 64, tid);
    __syncthreads();
    auto step = [&](const int it, KVStage& have, KVStage& recv) __attribute__((always_inline)) -> bool {
        const int kt = kt_first + it * kt_step;
        const LAS unsigned char* cur = lds + (it & 1) * KV_BUF;
        LAS unsigned char* nxt = lds + ((it & 1) ^ 1) * KV_BUF;
        const bool more = it + 1 < nt;
        { const int itn = it + 2 < nt ? it + 2 : nt - 1; kv_load(recv, Kb, kpitch, Vb, vpitch, (kt_first + itn * kt_step) * 64, tid); }
        if (MODE == M_WIN) {
            f32x16 p0, p1;
            qk_tile(p0, p1, cneg, cur, qr, r32, hi);
#pragma unroll
            for (int i = 0; i < 16; ++i) { p0[i] = ex2(p0[i]); p1[i] = ex2(p1[i]); }
            if (kt == m) {
#pragma unroll
                for (int i = 0; i < 16; ++i) { const int rel = crow(i, hi); if (rel > trel) p0[i] = 0.f; if (rel + 32 > trel) p1[i] = 0.f; }
            }
            if (kt == m - 8) {
#pragma unroll
                for (int i = 0; i < 16; ++i) { const int rel = crow(i, hi); if (rel <= trel) p0[i] = 0.f; if (rel + 32 <= trel) p1[i] = 0.f; }
            }
            float s = 0.f;
#pragma unroll
            for (int i = 0; i < 16; ++i) s += p0[i] + p1[i];
            lsum += s;
            pv_tile(o, cur + KV_VOFF, p0, p1, lane);
        } else if (MODE == M_SLC) {
            const unsigned bit = ((kt < 32 ? sel_lo : sel_hi) >> (kt & 31)) & 1u;
            if (__any((int)bit)) {
                f32x16 p0, p1;
                qk_tile(p0, p1, cneg, cur, qr, r32, hi);
                const float bf = bit ? 1.f : 0.f;
#pragma unroll
                for (int i = 0; i < 16; ++i) { p0[i] = ex2(p0[i]) * bf; p1[i] = ex2(p1[i]) * bf; }
                if (kt == m) {
#pragma unroll
                    for (int i = 0; i < 16; ++i) { const int rel = crow(i, hi); if (rel > trel) p0[i] = 0.f; if (rel + 32 > trel) p1[i] = 0.f; }
                }
                float s = 0.f;
#pragma unroll
                for (int i = 0; i < 16; ++i) s += p0[i] + p1[i];
                lsum += s;
                pv_tile(o, cur + KV_VOFF, p0, p1, lane);
            }
        } else if (MODE == M_CMP) {
            f32x16 p0, p1;
            qk_tile(p0, p1, cneg, cur, qr, r32, hi);
            const int lim = nmax - kt * 64;
#pragma unroll
            for (int i = 0; i < 16; ++i) { const int rel = crow(i, hi); p0[i] = rel <= lim ? ex2(p0[i]) : 0.f; p1[i] = rel + 32 <= lim ? ex2(p1[i]) : 0.f; }
            float s = 0.f;
#pragma unroll
            for (int i = 0; i < 16; ++i) s += p0[i] + p1[i];
            lsum += s;
#pragma unroll
            for (int q = 0; q < 8; ++q) {
                const f32x16& pq = q < 4 ? p0 : p1; const int qb = 4 * (q & 3); const float e0 = pq[qb], e1 = pq[qb + 1], e2 = pq[qb + 2], e3 = pq[qb + 3];
                float a = e0 + e1 + e2 + 0.5f * e3; const float bq = 0.5f * e3;
                const float pb = __shfl_xor(bq, 32);
                a += hi ? pb : carry;
                carry = pb;
                pw[kt * 16 + 2 * q + hi] = a;
            }
            pv_tile(o, cur + KV_VOFF, p0, p1, lane);
        } else {
            const int kbase = kt * 64 - T0;
            const bool skip = done || (kbase >= 32 * w + 31);
            if (!skip) {
                f32x16 pz[2];
                qk_tile(pz[0], pz[1], splat16(0.f), cur, qr, r32, hi);
                const bool partial = kbase + 63 >= 32 * w;
                const int lim = trel - kbase;
                bf16x8 pa[4];
                float run = carry;
#pragma unroll
                for (int h2 = 1; h2 >= 0; --h2) {
                    f32x16 om, be;
#pragma unroll
                    for (int i = 0; i < 16; ++i) { const float z = __builtin_amdgcn_fmed3f(pz[h2][i], -60.f, 60.f); const float e = ex2(-z); const float bb = __builtin_amdgcn_rcpf(1.f + e); be[i] = bb; om[i] = e * bb; }
                    if (partial) {
#pragma unroll
                        for (int i = 0; i < 16; ++i) { const int rel = crow(i, hi) + 32 * h2; if (rel >= lim) { om[i] = 1.f; be[i] = 0.f; } }
                    }
                    float gs[4], po[4];
#pragma unroll
                    for (int q = 0; q < 4; ++q) { gs[q] = (om[4 * q] * om[4 * q + 1]) * (om[4 * q + 2] * om[4 * q + 3]); po[q] = __shfl_xor(gs[q], 32); }
#pragma unroll
                    for (int q = 3; q >= 0; --q) {
                        const float ghi = hi ? gs[q] : po[q], glo = hi ? po[q] : gs[q];
                        const float t1 = run; run *= ghi; const float t0 = run; run *= glo;
                        float af = hi ? t1 : t0;
                        be[4 * q + 3] *= af; af *= om[4 * q + 3];
                        be[4 * q + 2] *= af; af *= om[4 * q + 2];
                        be[4 * q + 1] *= af; af *= om[4 * q + 1];
                        be[4 * q] *= af;
                    }
                    pack_half(pa + 2 * h2, be);
                }
                carry = run;
                pv_packed(o, cur + KV_VOFF, pa, lane);
                done = __all(carry < 3.5527e-15f);
            }
        }
        if (more) kv_store(have, nxt, tid);
        if (MODE == M_SB) { if (lane == 0) flags[(it & 1) * 8 + w] = done ? 1u : 0u; }
        __syncthreads();
        if (MODE == M_SB) {
            const u32x4 f0 = *(const LAS u32x4*)(flags + (it & 1) * 8), f1 = *(const LAS u32x4*)(flags + (it & 1) * 8 + 4);
            if ((f0.x & f0.y & f0.z & f0.w & f1.x & f1.y & f1.z & f1.w) != 0u) return true;
        }
        return false;
    };
    for (int it = 0; it < nt; it += 2) {
        if (step(it, sA, sB)) break;
        if (it + 1 >= nt) break;
        if (step(it + 1, sB, sA)) break;
    }
    if (MODE == M_SB) {
        const bf16_t* gp = P + (size_t)(b * SEQ + t) * NCP + C_GSB + hd * 64;
        bf16_t* dst = (bf16_t*)(ws + WS_XB) + (size_t)(b * SEQ + t) * DM + 512 + hd * 64;
        u32x2 gvv[8];
#pragma unroll
        for (int e = 0; e < 8; ++e) gvv[e] = *(const u32x2*)(gp + (e >> 2) * 32 + 8 * (e & 3) + 4 * hi);
#pragma unroll
        for (int d0 = 0; d0 < 2; ++d0)
#pragma unroll
            for (int q = 0; q < 4; ++q) { const int d = d0 * 32 + 8 * q + 4 * hi;
                const u32x2 gv = gvv[d0 * 4 + q];
                const float g0 = bflo(gv.x), g1 = bfhi(gv.x), g2 = bflo(gv.y), g3 = bfhi(gv.y);
                u32x2 pk; pk.x = pk2(o[d0][4 * q] * g0 * sigmoidf_(g0), o[d0][4 * q + 1] * g1 * sigmoidf_(g1)); pk.y = pk2(o[d0][4 * q + 2] * g2 * sigmoidf_(g2), o[d0][4 * q + 3] * g3 * sigmoidf_(g3));
                *(u32x2*)(dst + d) = pk; }
    } else {
        lsum += __shfl_xor(lsum, 32);
        const float inv = lsum > 0.f ? 1.f / lsum : 0.f;
        const int br = MODE == M_CMP ? 0 : (MODE == M_SLC ? 1 : 2);
        const float gate = sigmoidf_(bf1(P[(size_t)(b * SEQ + t) * NCP + C_GL + hd * 3 + br]));
        const float sc = inv * gate;
        const size_t orow = (size_t)(b * SEQ + t) * 512 + hd * 64;
        if (MODE == M_SLC) {
            const bf16_t* oc = (const bf16_t*)(ws + WS_OC) + orow; const bf16_t* ow = (const bf16_t*)(ws + WS_OW) + orow;
            const bf16_t* gp = P + (size_t)(b * SEQ + t) * NCP + C_GN + hd * 64;
            bf16_t* dst = (bf16_t*)(ws + WS_XB) + (size_t)(b * SEQ + t) * DM + hd * 64;
#pragma unroll
            for (int d0 = 0; d0 < 2; ++d0)
#pragma unroll
                for (int q = 0; q < 4; ++q) { const int d = d0 * 32 + 8 * q + 4 * hi;
                    const u32x2 gv = *(const u32x2*)(gp + d), cv = *(const u32x2*)(oc + d), wv = *(const u32x2*)(ow + d);
                    const float g0 = bflo(gv.x), g1 = bfhi(gv.x), g2 = bflo(gv.y), g3 = bfhi(gv.y);
                    const float v0 = o[d0][4 * q] * sc + bflo(cv.x) + bflo(wv.x), v1 = o[d0][4 * q + 1] * sc + bfhi(cv.x) + bfhi(wv.x);
                    const float v2 = o[d0][4 * q + 2] * sc + bflo(cv.y) + bflo(wv.y), v3 = o[d0][4 * q + 3] * sc + bfhi(cv.y) + bfhi(wv.y);
                    u32x2 pk; pk.x = pk2(v0 * g0 * sigmoidf_(g0), v1 * g1 * sigmoidf_(g1)); pk.y = pk2(v2 * g2 * sigmoidf_(g2), v3 * g3 * sigmoidf_(g3));
                    *(u32x2*)(dst + d) = pk; }
        } else {
            bf16_t* dst = (bf16_t*)(ws + (MODE == M_CMP ? WS_OC : WS_OW)) + orow;
#pragma unroll
            for (int d0 = 0; d0 < 2; ++d0)
#pragma unroll
                for (int q = 0; q < 4; ++q) { const int d = d0 * 32 + 8 * q + 4 * hi;
                    u32x2 pk; pk.x = pk2(o[d0][4 * q] * sc, o[d0][4 * q + 1] * sc); pk.y = pk2(o[d0][4 * q + 2] * sc, o[d0][4 * q + 3] * sc);
                    *(u32x2*)(dst + d) = pk; }
        }
        if (MODE == M_CMP) {
            LAS float* linv = (LAS float*)(lds + ATT_LINV);
            if (hi == 0) linv[w * 32 + r32] = inv;
            __syncthreads();
            const LAS float* pwb = (const LAS float*)(lds + ATT_PW);
            unsigned long long* sel = (unsigned long long*)(ws + WS_SEL) + (size_t)(b * 2 + g) * SEQ + T0;
            const int j = lane, blk = m;
            const bool valid = j <= blk, forced = (j == 0) || (j == blk) || (j == blk - 1);
            for (int i = 0; i < 8; ++i) {
                const int tok = w * 8 + i, half = tok >> 5, r = tok & 31;
                float sc2 = 0.f;
#pragma unroll
                for (int hh = 0; hh < 4; ++hh) sc2 += pwb[((half * 4 + hh) * 32 + r) * 65 + j] * linv[(half * 4 + hh) * 32 + r];
                const float s = valid ? (forced ? sc2 + 1.0e4f : sc2) : -INFINITY;
                int cnt = 0;
#pragma unroll
                for (int l2 = 0; l2 < 64; ++l2) { const float sl = __uint_as_float(__builtin_amdgcn_readlane(__float_as_uint(s), l2)); cnt += ((sl > s) || (sl == s && l2 < lane)) ? 1 : 0; }
                const unsigned long long mk = __ballot(valid && cnt < 16);
                if (lane == 0) sel[tok] = mk;
            }
        }
    }
    __syncthreads();
}


__device__ __forceinline__ void k_reads(bf16x8* kf, const LAS unsigned char* kb, int r32, int hi) {
    const LAS unsigned char* base = kb + r32 * 144 + hi * 16;
#pragma unroll
    for (int d0 = 0; d0 < 4; ++d0) { kf[2 * d0] = *(const LAS bf16x8*)(base + d0 * 32); kf[2 * d0 + 1] = *(const LAS bf16x8*)(base + 32 * 144 + d0 * 32); }
}
__device__ __forceinline__ void qk_mfma(f32x16& p0, f32x16& p1, const f32x16& cinit, const bf16x8* kf, const bf16x8* qr) {
    p0 = MFMA32(kf[0], qr[0], cinit); p1 = MFMA32(kf[1], qr[0], cinit);
#pragma unroll
    for (int d0 = 1; d0 < 4; ++d0) { p0 = MFMA32(kf[2 * d0], qr[d0], p0); p1 = MFMA32(kf[2 * d0 + 1], qr[d0], p1); }
}
__device__ __forceinline__ void v_reads(s16x4* vlo, s16x4* vhi, const LAS unsigned char* vb, int lane) {
    const int hi = lane >> 5;
    const LAS unsigned char* base = vb + ((lane >> 4) & 1) * 32 + (lane & 3) * 8 + (4 * hi + ((lane & 15) >> 2)) * 64;
#pragma unroll
    for (int d0 = 0; d0 < 2; ++d0)
#pragma unroll
        for (int s = 0; s < 4; ++s) { vlo[d0 * 4 + s] = vtr(base + d0 * V_HALF + s * 1024); vhi[d0 * 4 + s] = vtr(base + d0 * V_HALF + s * 1024 + 512); }
}
__device__ __forceinline__ void pv_mfma(f32x16* o, const s16x4* vlo, const s16x4* vhi, const bf16x8* pa) {
#pragma unroll
    for (int s = 0; s < 4; ++s)
#pragma unroll
        for (int d0 = 0; d0 < 2; ++d0) {
            const bf16x8 vf = __builtin_shufflevector(vlo[d0 * 4 + s], vhi[d0 * 4 + s], 0, 1, 2, 3, 4, 5, 6, 7);
            o[d0] = MFMA32(vf, pa[s], o[d0]);
        }
}
__device__ __forceinline__ float fadd_s(float a, float b) { float r; asm("v_add_f32_e32 %0, %1, %2" : "=v"(r) : "v"(a), "v"(b)); return r; }
typedef float f32x2v __attribute__((ext_vector_type(2)));
template <int MODE>
__device__ __forceinline__ void softmax_stage(f32x16& p0, f32x16& p1, bf16x8* pa, float& lsum, int kt, int m, int trel, int hi, unsigned bit) {
#pragma unroll
    for (int i = 0; i < 16; ++i) { p0[i] = ex2(p0[i]); p1[i] = ex2(p1[i]); }
    if (kt == m) {
#pragma unroll
        for (int i = 0; i < 16; ++i) { const int rel = crow(i, hi); if (rel > trel) p0[i] = 0.f; if (rel + 32 > trel) p1[i] = 0.f; }
    }
    if (MODE == M_WIN && kt == m - 8) {
#pragma unroll
        for (int i = 0; i < 16; ++i) { const int rel = crow(i, hi); if (rel <= trel) p0[i] = 0.f; if (rel + 32 <= trel) p1[i] = 0.f; }
    }
    f32x2v acc = {0.f, 0.f};
#pragma unroll
    for (int i = 0; i < 8; ++i) { acc += (f32x2v){p0[2 * i], p0[2 * i + 1]}; acc += (f32x2v){p1[2 * i], p1[2 * i + 1]}; }
    float sum = acc.x + acc.y;
    const unsigned mk = (MODE == M_SLC) ? (bit ? 0xffffffffu : 0u) : 0xffffffffu;
#pragma unroll
    for (int k = 0; k < 4; ++k) { const f32x16& p = k < 2 ? p0 : p1; const int bs = 8 * (k & 1);
        u32x4 wv = {pk2(p[bs], p[bs + 1]), pk2(p[bs + 2], p[bs + 3]), pk2(p[bs + 4], p[bs + 5]), pk2(p[bs + 6], p[bs + 7])};
        if (MODE == M_SLC) { wv.x &= mk; wv.y &= mk; wv.z &= mk; wv.w &= mk; }
        pa[k] = __builtin_bit_cast(bf16x8, wv); }
    if (MODE == M_SLC) sum = bit ? sum : 0.f;
    lsum += sum;
}

template <int MODE>
__device__ __forceinline__ void attn_item2(const Args& A, LAS unsigned char* lds, int item, const int wv_) {
    int tid_l = TIDX; asm volatile("" : "+v"(tid_l));
    const int tid = tid_l, lane = tid & 63, r32 = lane & 31, hi = lane >> 5, w = __builtin_amdgcn_readfirstlane(tid >> 6);
    unsigned char* ws = A.ws;
    const bf16_t* P = (const bf16_t*)(ws + WS_P);
    int b, g, m;
    if (MODE == M_SLC) { int bg; if (item < 256) { bg = item >> 5; m = 32 + (item & 31); } else { const int i2 = item - 256; bg = i2 >> 5; m = 31 - (i2 & 31); } b = bg >> 1; g = bg & 1; }
    else { b = item >> 7; g = (item >> 6) & 1; m = item & 63; }
    const int T0 = 64 * m, hd = 4 * g + (w & 3), trel = 32 * (w >> 2) + r32, t = T0 + trel;
    const bf16_t* Qrow = (const bf16_t*)(ws + WS_QN) + (size_t)(b * SEQ + t) * 512 + hd * 64;
    const bf16_t* Kb = (const bf16_t*)(ws + (MODE == M_WIN ? WS_KWN : WS_KSN)) + (size_t)(b * SEQ) * 128 + g * 64;
    const bf16_t* Vb = P + (size_t)(b * SEQ) * NCP + (MODE == M_WIN ? C_VW : C_VS) + g * 64;
    const int kpitch = 128, vpitch = NCP;
    const int kt_first = (MODE == M_WIN && m >= 8) ? m - 8 : 0, nt = m - kt_first + 1;
    bf16x8 qr[4];
#pragma unroll
    for (int d0 = 0; d0 < 4; ++d0) qr[d0] = *(const bf16x8*)(Qrow + 16 * d0 + 8 * hi);
    const float negmb = -((const float*)(ws + WS_MB))[MODE == M_SLC ? 1 : 2];
    unsigned sel_lo = 0xffffffffu, sel_hi = 0xffffffffu;
    if (MODE == M_SLC) { const u32x2 sm = *(const u32x2*)((const unsigned long long*)(ws + WS_SEL) + (size_t)(b * 2 + g) * SEQ + t); sel_lo = sm.x; sel_hi = sm.y; }
    f32x16 o[2]; o[0] = splat16(0.f); o[1] = splat16(0.f);
    float lsum = 0.f;
    f32x16 cneg = splat16(negmb);
    asm volatile("" : "+v"(cneg));
    const bool grpA = (w < 4);
    KVStage sA, sB;
#define TILE_CL(i) ((kt_first + ((i) < nt ? (i) : nt - 1)) * 64)
    kv_load(sA, Kb, kpitch, Vb, vpitch, TILE_CL(0), tid);
    kv_load(sB, Kb, kpitch, Vb, vpitch, TILE_CL(1), tid);
    kv_store(sA, lds, tid);
    kv_store(sB, lds + KV_BUF, tid);
    kv_load(sA, Kb, kpitch, Vb, vpitch, TILE_CL(2), tid);
    __syncthreads();
    f32x16 SA0, SA1, SB0, SB1;
    qk_tile(SA0, SA1, cneg, lds, qr, r32, hi);
    int s0 = 0, s1 = KV_BUF, s2 = 2 * KV_BUF;
    auto step = [&](const int it, KVStage& have, KVStage& recv, f32x16& c0, f32x16& c1, f32x16& n0, f32x16& n1) __attribute__((always_inline)) {
        const int kt = kt_first + it;
        kv_load(recv, Kb, kpitch, Vb, vpitch, TILE_CL(it + 3), tid);
        const unsigned bit = ((kt < 32 ? sel_lo : sel_hi) >> (kt & 31)) & 1u;
        bf16x8 pa[4];
        bf16x8 kf[8]; s16x4 vlo[8], vhi[8];
        if (grpA) {
            k_reads(kf, lds + s1, r32, hi);
            __builtin_amdgcn_sched_barrier(0);
            __builtin_amdgcn_s_setprio(1); qk_mfma(n0, n1, cneg, kf, qr); __builtin_amdgcn_s_setprio(0);
            v_reads(vlo, vhi, lds + s0 + KV_VOFF, lane);
            __builtin_amdgcn_sched_barrier(0);
            softmax_stage<MODE>(c0, c1, pa, lsum, kt, m, trel, hi, bit);
            __builtin_amdgcn_sched_barrier(0);
            __builtin_amdgcn_s_setprio(1); pv_mfma(o, vlo, vhi, pa); __builtin_amdgcn_s_setprio(0);
        } else {
            v_reads(vlo, vhi, lds + s0 + KV_VOFF, lane);
            __builtin_amdgcn_sched_barrier(0);
            softmax_stage<MODE>(c0, c1, pa, lsum, kt, m, trel, hi, bit);
            k_reads(kf, lds + s1, r32, hi);
            __builtin_amdgcn_sched_barrier(0);
            __builtin_amdgcn_s_setprio(1); pv_mfma(o, vlo, vhi, pa);
            __builtin_amdgcn_sched_barrier(0);
            qk_mfma(n0, n1, cneg, kf, qr); __builtin_amdgcn_s_setprio(0);
        }
        kv_store(have, lds + s2, tid);
        __syncthreads();
        const int tmp = s0; s0 = s1; s1 = s2; s2 = tmp;
    };
    for (int it = 0; it < nt; it += 2) {
        step(it, sA, sB, SA0, SA1, SB0, SB1);
        if (it + 1 >= nt) break;
        step(it + 1, sB, sA, SB0, SB1, SA0, SA1);
    }
#undef TILE_CL
    lsum += __shfl_xor(lsum, 32);
    const float inv = lsum > 0.f ? 1.f / lsum : 0.f;
    const int br = MODE == M_SLC ? 1 : 2;
    const float gate = sigmoidf_(bf1(P[(size_t)(b * SEQ + t) * NCP + C_GL + hd * 3 + br]));
    const float sc = inv * gate;
    const size_t orow = (size_t)(b * SEQ + t) * 512 + hd * 64;
    if (MODE == M_SLC) {
        const bf16_t* oc = (const bf16_t*)(ws + WS_OC) + orow; const bf16_t* ow = (const bf16_t*)(ws + WS_OW) + orow;
        const bf16_t* gp = P + (size_t)(b * SEQ + t) * NCP + C_GN + hd * 64;
        bf16_t* dst = (bf16_t*)(ws + WS_XB) + (size_t)(b * SEQ + t) * DM + hd * 64;
#pragma unroll
        for (int d0 = 0; d0 < 2; ++d0)
#pragma unroll
            for (int q = 0; q < 4; ++q) { const int d = d0 * 32 + 8 * q + 4 * hi;
                const u32x2 gv = *(const u32x2*)(gp + d), cv = *(const u32x2*)(oc + d), wv = *(const u32x2*)(ow + d);
                const float g0 = bflo(gv.x), g1 = bfhi(gv.x), g2 = bflo(gv.y), g3 = bfhi(gv.y);
                const float v0 = o[d0][4 * q] * sc + bflo(cv.x) + bflo(wv.x), v1 = o[d0][4 * q + 1] * sc + bfhi(cv.x) + bfhi(wv.x);
                const float v2 = o[d0][4 * q + 2] * sc + bflo(cv.y) + bflo(wv.y), v3 = o[d0][4 * q + 3] * sc + bfhi(cv.y) + bfhi(wv.y);
                u32x2 pk; pk.x = pk2(v0 * g0 * sigmoidf_(g0), v1 * g1 * sigmoidf_(g1)); pk.y = pk2(v2 * g2 * sigmoidf_(g2), v3 * g3 * sigmoidf_(g3));
                *(u32x2*)(dst + d) = pk; }
    } else {
        bf16_t* dst = (bf16_t*)(ws + WS_OW) + orow;
#pragma unroll
        for (int d0 = 0; d0 < 2; ++d0)
#pragma unroll
            for (int q = 0; q < 4; ++q) { const int d = d0 * 32 + 8 * q + 4 * hi;
                u32x2 pk; pk.x = pk2(o[d0][4 * q] * sc, o[d0][4 * q + 1] * sc); pk.y = pk2(o[d0][4 * q + 2] * sc, o[d0][4 * q + 3] * sc);
                *(u32x2*)(dst + d) = pk; }
    }
    __syncthreads();
}

constexpr int NS_LINV = 53056, NS_SEL = 54080, NS_PW = 54784, NS_GL = 121344;

template <int MODE>
__device__ __forceinline__ void nsa_softmax(f32x16& p0, f32x16& p1, bf16x8* pa, float& lsum, float negmb, int kt, int m, int trel, int hi, unsigned bit, int nmax, LAS float* pw, float& carry) {
    if (MODE == M_CMP) {
#pragma unroll
        for (int i = 0; i < 16; ++i) { p0[i] += negmb; p1[i] += negmb; }
    }
    if (MODE == M_CMP) {
        const int lim = nmax - kt * 64;
#pragma unroll
        for (int i = 0; i < 16; ++i) { const int rel = crow(i, hi); p0[i] = rel <= lim ? ex2(p0[i]) : 0.f; p1[i] = rel + 32 <= lim ? ex2(p1[i]) : 0.f; }
#pragma unroll
        for (int q = 0; q < 8; ++q) {
            const f32x16& pq = q < 4 ? p0 : p1; const int qb = 4 * (q & 3); const float e0 = pq[qb], e1 = pq[qb + 1], e2 = pq[qb + 2], e3 = pq[qb + 3];
            float a = e0 + e1 + e2 + 0.5f * e3; const float bq = 0.5f * e3;
            const float pb = __shfl_xor(bq, 32);
            a += hi ? pb : carry;
            carry = pb;
            pw[kt * 16 + 2 * q + hi] = a;
        }
    } else {
#pragma unroll
        for (int i = 0; i < 16; ++i) { p0[i] = ex2(p0[i]); p1[i] = ex2(p1[i]); }
        if (kt == m) {
            asm volatile("" ::: "memory");
#pragma unroll
            for (int i = 0; i < 16; ++i) { const int rel = crow(i, hi); if (rel > trel) p0[i] = 0.f; if (rel + 32 > trel) p1[i] = 0.f; }
        }
        if (MODE == M_WIN && kt == m - 8) {
            asm volatile("" ::: "memory");
#pragma unroll
            for (int i = 0; i < 16; ++i) { const int rel = crow(i, hi); if (rel <= trel) p0[i] = 0.f; if (rel + 32 <= trel) p1[i] = 0.f; }
        }
    }
    float sa = 0.f, sb = 0.f, sc_ = 0.f, sd = 0.f;
#pragma unroll
    for (int i = 0; i < 16; i += 2) { sa = fadd_s(sa, p0[i]); sb = fadd_s(sb, p0[i + 1]); sc_ = fadd_s(sc_, p1[i]); sd = fadd_s(sd, p1[i + 1]); }
    float sum = fadd_s(fadd_s(sa, sb), fadd_s(sc_, sd));
    const unsigned mk = (MODE == M_SLC) ? (bit ? 0xffffffffu : 0u) : 0xffffffffu;
#pragma unroll
    for (int k = 0; k < 4; ++k) { const f32x16& p = k < 2 ? p0 : p1; const int bs = 8 * (k & 1);
        u32x4 wv = {pk2(p[bs], p[bs + 1]), pk2(p[bs + 2], p[bs + 3]), pk2(p[bs + 4], p[bs + 5]), pk2(p[bs + 6], p[bs + 7])};
        if (MODE == M_SLC) { wv.x &= mk; wv.y &= mk; wv.z &= mk; wv.w &= mk; }
        pa[k] = __builtin_bit_cast(bf16x8, wv); }
    if (MODE == M_SLC) sum = bit ? sum : 0.f;
    lsum += sum;
}

template <int MODE>
__device__ __forceinline__ void nsa_branch(LAS unsigned char* lds, const bf16_t* Kb, const int kpitch, const bf16_t* Vb, const int vpitch, const int kt_first, const int nt,
                                           const bf16x8* qr, const float negmb, f32x16* o, float& lsum, const int m, const int trel, const int tid, const int w,
                                           const unsigned sel_lo, const unsigned sel_hi, const int nmax, LAS float* pw) {
    const int lane = tid & 63, r32 = lane & 31, hi = lane >> 5;
    f32x16 cneg = splat16(MODE == M_CMP ? 0.f : negmb);
    if (MODE != M_CMP) asm volatile("" : "+v"(cneg));
    const bool grpA = (w < 4);
    float carry = 0.f;
    KVStage sA;
#define TILE_CL(i) ((kt_first + ((i) < nt ? (i) : nt - 1)) * 64)
    {   KVStage sB;
        kv_load(sA, Kb, kpitch, Vb, vpitch, TILE_CL(0), tid);
        kv_load(sB, Kb, kpitch, Vb, vpitch, TILE_CL(1), tid);
        kv_store(sA, lds, tid);
        kv_store(sB, lds + KV_BUF, tid); }
    __syncthreads();
    int s0 = 0, s1 = KV_BUF, s2 = 2 * KV_BUF;
    (void)grpA;
    for (int it = 0; it < nt; ++it) {
        const int kt = kt_first + it;
        kv_load(sA, Kb, kpitch, Vb, vpitch, TILE_CL(it + 2), tid);
        const unsigned bit = ((kt < 32 ? sel_lo : sel_hi) >> (kt & 31)) & 1u;
        bf16x8 pa[4];
        bf16x8 kf[8]; s16x4 vlo[8], vhi[8];
        f32x16 c0, c1;
        k_reads(kf, lds + s0, r32, hi);
        v_reads(vlo, vhi, lds + s0 + KV_VOFF, lane);
        __builtin_amdgcn_sched_barrier(0);
        qk_mfma(c0, c1, cneg, kf, qr);
        __builtin_amdgcn_sched_barrier(0);
        nsa_softmax<MODE>(c0, c1, pa, lsum, negmb, kt, m, trel, hi, bit, nmax, pw, carry);
        __builtin_amdgcn_sched_barrier(0);
        pv_mfma(o, vlo, vhi, pa);
        kv_store(sA, lds + s2, tid);
        __syncthreads();
        const int tmp = s0; s0 = s1; s1 = s2; s2 = tmp;
    }
#undef TILE_CL
}

__device__ __forceinline__ void nsa_item(const Args& A, LAS unsigned char* lds, int item, const int wv_) {
    unsigned char* ws = A.ws;
    const bf16_t* P = (const bf16_t*)(ws + WS_P);
    const int bg = item >> 6, m = item & 63;
    const int b = bg >> 1, g = bg & 1, T0 = 64 * m, w = wv_;
#define NSA_LANE() int tid_l = TIDX; asm volatile("" : "+v"(tid_l)); const int tid = tid_l, lane = tid & 63, r32 = lane & 31, hi = lane >> 5, hd = 4 * g + (w & 3), trel = 32 * (w >> 2) + r32, t = T0 + trel; \
                   const size_t tokrow = (size_t)(b * SEQ + t); (void)hd; (void)hi; (void)tokrow; (void)lane
    const float* mbp = (const float*)(ws + WS_MB);
    bf16x8 qr[4];
    f32x16 o[2]; float lsum;
    {   NSA_LANE();
        {
            const bf16_t* Qraw = P + tokrow * NCP + C_QN + hd * 64;
            u32x4 raw[4];
#pragma unroll
            for (int d0 = 0; d0 < 4; ++d0) raw[d0] = *(const u32x4*)(Qraw + 16 * d0 + 8 * hi);
            float y[32];
#pragma unroll
            for (int d0 = 0; d0 < 4; ++d0) { y[8 * d0] = bflo(raw[d0].x); y[8 * d0 + 1] = bfhi(raw[d0].x); y[8 * d0 + 2] = bflo(raw[d0].y); y[8 * d0 + 3] = bfhi(raw[d0].y);
                y[8 * d0 + 4] = bflo(raw[d0].z); y[8 * d0 + 5] = bfhi(raw[d0].z); y[8 * d0 + 6] = bflo(raw[d0].w); y[8 * d0 + 7] = bfhi(raw[d0].w); }
            float ss = 0.f;
#pragma unroll
            for (int i = 0; i < 32; ++i) ss += y[i] * y[i];
            ss += __shfl_xor(ss, 32);
            const float r = 1.f / sqrtf(ss * (1.f / 64.f) + EPSN);
            const float* gq = A.in[3];
#pragma unroll
            for (int d0 = 0; d0 < 4; ++d0) { const f32x4 ga = *(const f32x4*)(gq + 16 * d0 + 8 * hi), gb = *(const f32x4*)(gq + 16 * d0 + 8 * hi + 4);
                y[8 * d0] *= r * ga.x; y[8 * d0 + 1] *= r * ga.y; y[8 * d0 + 2] *= r * ga.z; y[8 * d0 + 3] *= r * ga.w; y[8 * d0 + 4] *= r * gb.x; y[8 * d0 + 5] *= r * gb.y; y[8 * d0 + 6] *= r * gb.z; y[8 * d0 + 7] *= r * gb.w; }
            const float2* rope = (const float2*)(ws + WS_ROPE) + t * 8;
#pragma unroll
            for (int j = 0; j < 8; ++j) { const float oth = __shfl_xor(y[j], 32); const float2 cs = rope[j];
                y[j] = hi ? (y[j] * cs.x + oth * cs.y) : (y[j] * cs.x - oth * cs.y); }
#pragma unroll
            for (int d0 = 0; d0 < 4; ++d0) { u32x4 u = {pk2(y[8 * d0] * C2, y[8 * d0 + 1] * C2), pk2(y[8 * d0 + 2] * C2, y[8 * d0 + 3] * C2), pk2(y[8 * d0 + 4] * C2, y[8 * d0 + 5] * C2), pk2(y[8 * d0 + 6] * C2, y[8 * d0 + 7] * C2)};
                qr[d0] = __builtin_bit_cast(bf16x8, u); }
        }
        const bf16_t* glp = P + tokrow * NCP + C_GL + hd * 3;
        LAS float* gls = (LAS float*)(lds + NS_GL) + tid;
        gls[0] = sigmoidf_(bf1(glp[0])); gls[512] = sigmoidf_(bf1(glp[1])); gls[1024] = sigmoidf_(bf1(glp[2]));
        LAS float* pw = (LAS float*)(lds + NS_PW) + (w * 32 + r32) * 65;
#pragma unroll
        for (int j = 0; j < 32; ++j) pw[hi * 32 + j] = 0.f;
        if (hi) pw[64] = 0.f;
        o[0] = splat16(0.f); o[1] = splat16(0.f); lsum = 0.f;
        const bf16_t* Kc = (const bf16_t*)(ws + WS_KCMP) + (size_t)((b * 2 + g) * 256) * 64; const bf16_t* Vc = (const bf16_t*)(ws + WS_VCMP) + (size_t)((b * 2 + g) * 256) * 64;
        nsa_branch<M_CMP>(lds, Kc, 64, Vc, 64, 0, ((4 * m + 2) >> 6) + 1, qr, -mbp[0], o, lsum, m, trel, tid, w, 0u, 0u, (t - 31) >> 4, pw);
    }
    float inv_c;
    {   NSA_LANE();
        lsum += __shfl_xor(lsum, 32);
        inv_c = lsum > 0.f ? 1.f / lsum : 0.f;
        LAS float* linv = (LAS float*)(lds + NS_LINV);
        if (hi == 0) linv[w * 32 + r32] = inv_c;
    }
    __syncthreads();
    {
        NSA_LANE();
        const LAS float* pwb = (const LAS float*)(lds + NS_PW);
        const LAS float* linv = (const LAS float*)(lds + NS_LINV);
        LAS unsigned long long* sell = (LAS unsigned long long*)(lds + NS_SEL);
        const int j = lane, blk = m;
        const bool valid = j <= blk, forced = (j == 0) || (j == blk) || (j == blk - 1);
        if (blk < 16) {
            const unsigned long long mk = __ballot(valid);
            if (lane < 8) sell[w * 8 + lane] = mk;
        } else {
            unsigned key[8], v[8];
#pragma unroll
            for (int i = 0; i < 8; ++i) {
                const int tok = w * 8 + i, half = tok >> 5, r = tok & 31;
                float sc2 = 0.f;
#pragma unroll
                for (int hh = 0; hh < 4; ++hh) sc2 += pwb[((half * 4 + hh) * 32 + r) * 65 + j] * linv[(half * 4 + hh) * 32 + r];
                const float sv = forced ? sc2 + 1.0e4f : sc2;
                key[i] = valid ? ((__float_as_uint(sv) & ~63u) | (unsigned)(63 - j)) : 0u;
                v[i] = key[i];
            }
#pragma unroll
            for (int k = 2; k <= 64; k <<= 1)
#pragma unroll
                for (int jj = k >> 1; jj > 0; jj >>= 1) {
                    const bool takemax = ((lane & jj) == 0) == ((lane & k) == 0);
#pragma unroll
                    for (int i = 0; i < 8; ++i) { const unsigned p = (unsigned)__shfl_xor((int)v[i], jj); const unsigned hi_ = v[i] > p ? v[i] : p, lo_ = v[i] > p ? p : v[i]; v[i] = takemax ? hi_ : lo_; }
                }
#pragma unroll
            for (int i = 0; i < 8; ++i) {
                const unsigned thr = (unsigned)__builtin_amdgcn_readlane((int)v[i], 15);
                const unsigned long long mk = __ballot(valid && key[i] >= thr);
                if (lane == 0) sell[w * 8 + i] = mk;
            }
        }
    }
    __syncthreads();
    {   NSA_LANE();
        const u32x2 sm = *(const LAS u32x2*)(lds + NS_SEL + trel * 8);
        LAS float* omix = (LAS float*)(lds + NS_PW) + w * 2048 + lane;
        const float sc = inv_c * ((const LAS float*)(lds + NS_GL))[tid];
#pragma unroll
        for (int i = 0; i < 16; ++i) { omix[i * 64] = o[0][i] * sc; omix[(16 + i) * 64] = o[1][i] * sc; }
        o[0] = splat16(0.f); o[1] = splat16(0.f); lsum = 0.f;
        const bf16_t* Ks = (const bf16_t*)(ws + WS_KSN) + (size_t)(b * SEQ) * 128 + g * 64; const bf16_t* Vs = P + (size_t)(b * SEQ) * NCP + C_VS + g * 64;
        nsa_branch<M_SLC>(lds, Ks, 128, Vs, NCP, 0, m + 1, qr, -mbp[1], o, lsum, m, trel, tid, w, sm.x, sm.y, 0, nullptr);
    }
    {   NSA_LANE();
        lsum += __shfl_xor(lsum, 32);
        const float inv = lsum > 0.f ? 1.f / lsum : 0.f;
        LAS float* omix = (LAS float*)(lds + NS_PW) + w * 2048 + lane;
        const float sc = inv * ((const LAS float*)(lds + NS_GL))[512 + tid];
#pragma unroll
        for (int i = 0; i < 16; ++i) { omix[i * 64] += o[0][i] * sc; omix[(16 + i) * 64] += o[1][i] * sc; }
        o[0] = splat16(0.f); o[1] = splat16(0.f); lsum = 0.f;
        const bf16_t* Kw = (const bf16_t*)(ws + WS_KWN) + (size_t)(b * SEQ) * 128 + g * 64; const bf16_t* Vw = P + (size_t)(b * SEQ) * NCP + C_VW + g * 64;
        const int kf0 = m >= 8 ? m - 8 : 0;
        nsa_branch<M_WIN>(lds, Kw, 128, Vw, NCP, kf0, m - kf0 + 1, qr, -mbp[2], o, lsum, m, trel, tid, w, 0u, 0u, 0, nullptr);
    }
    {   NSA_LANE();
        lsum += __shfl_xor(lsum, 32);
        const float inv = lsum > 0.f ? 1.f / lsum : 0.f;
        const LAS float* omix = (const LAS float*)(lds + NS_PW) + w * 2048 + lane;
        const float sc = inv * ((const LAS float*)(lds + NS_GL))[1024 + tid];
        const bf16_t* gp = P + tokrow * NCP + C_GN + hd * 64;
        bf16_t* dst = (bf16_t*)(ws + WS_XB) + tokrow * DM + hd * 64;
        u32x2 gvv[8];
#pragma unroll
        for (int e = 0; e < 8; ++e) gvv[e] = *(const u32x2*)(gp + (e >> 2) * 32 + 8 * (e & 3) + 4 * hi);
#pragma unroll
        for (int d0 = 0; d0 < 2; ++d0)
#pragma unroll
            for (int q = 0; q < 4; ++q) { const int d = d0 * 32 + 8 * q + 4 * hi;
                const u32x2 gv = gvv[d0 * 4 + q];
                const float g0 = bflo(gv.x), g1 = bfhi(gv.x), g2 = bflo(gv.y), g3 = bfhi(gv.y);
                const float v0 = o[d0][4 * q] * sc + omix[(d0 * 16 + 4 * q) * 64], v1 = o[d0][4 * q + 1] * sc + omix[(d0 * 16 + 4 * q + 1) * 64];
                const float v2 = o[d0][4 * q + 2] * sc + omix[(d0 * 16 + 4 * q + 2) * 64], v3 = o[d0][4 * q + 3] * sc + omix[(d0 * 16 + 4 * q + 3) * 64];
                u32x2 pk; pk.x = pk2(v0 * g0 * sigmoidf_(g0), v1 * g1 * sigmoidf_(g1)); pk.y = pk2(v2 * g2 * sigmoidf_(g2), v3 * g3 * sigmoidf_(g3));
                *(u32x2*)(dst + d) = pk; }
    }
#undef NSA_LANE
    __syncthreads();
}

#define XB_TMO      128
#define XB_XCNT(j)  (256  + 64 * (j))
#define XB_XSUB(j)  (1280 + 64 * (j))
#define XB_XGEN(j)  (2304 + 64 * (j))
#define XB_TOP      3328
#define XB_TOPGEN   3392
#define XCD_BAR_WORDS 3456
#define XB_SPIN_CAP (1u << 18)

__device__ __forceinline__ unsigned xb_ld(unsigned* p)              { return __hip_atomic_load(p, __ATOMIC_RELAXED, __HIP_MEMORY_SCOPE_AGENT); }
__device__ __forceinline__ unsigned xb_add(unsigned* p, unsigned v) { return __hip_atomic_fetch_add(p, v, __ATOMIC_RELAXED, __HIP_MEMORY_SCOPE_AGENT); }
__device__ __forceinline__ unsigned xb_xcc_id() { return (unsigned)__builtin_amdgcn_s_getreg((3 << 11) | 20) & 0xFu; }
#define XB_SPIN(cond, bar) do { unsigned _sp = 0; while (cond) { __builtin_amdgcn_s_sleep(1); \
    if ((++_sp & 255u) == 0u) { if (xb_ld(&(bar)[XB_TMO])) break; if (_sp > XB_SPIN_CAP) { atomicAdd(&(bar)[XB_TMO], 1u); break; } } } } while (0)

struct XcdBarrier {
    unsigned* bar; unsigned x;
    volatile LAS unsigned* st;
};

__device__ __forceinline__ XcdBarrier xcd_barrier_post(unsigned* bar, volatile LAS unsigned* st, const int wv_) {
    XcdBarrier b; b.bar = bar; b.x = xb_xcc_id(); b.st = st;
    if (TIDX == 0) (void)xb_add(&bar[XB_XCNT(b.x)], 1u);
    return b;
}
__device__ __forceinline__ void xcd_barrier_complete(unsigned* bar, unsigned x, unsigned& nloc, unsigned& nx) {
    const unsigned G = gridDim.x * gridDim.y * gridDim.z;
    unsigned sum, cnt, mine, sp = 0u;
    for (;;) {
        sum = 0u; cnt = 0u; mine = 0u;
#pragma unroll
        for (unsigned j = 0; j < 16; ++j) { const unsigned c = xb_ld(&bar[XB_XCNT(j)]); sum += c; cnt += (c > 0u) ? 1u : 0u; mine = (j == x) ? c : mine; }
        if (sum == G) break;
        __builtin_amdgcn_s_sleep(1);
        if ((++sp & 255u) == 0u) { if (xb_ld(&bar[XB_TMO])) break; if (sp > XB_SPIN_CAP) { atomicAdd(&bar[XB_TMO], 1u); break; } }
    }
    nloc = mine > 0u ? mine : 1u; nx = cnt > 0u ? cnt : 1u;
}

__device__ __forceinline__ void xcd_barrier(const XcdBarrier& b, const int wv_) {
    asm volatile("s_waitcnt vmcnt(0)" ::: "memory");
    __syncthreads();
    if (TIDX == 0) {
        unsigned* bar = b.bar;
        __builtin_amdgcn_s_waitcnt(0);
        unsigned nloc = b.st[0], nx = b.st[1];
        if (nloc == 0u) { xcd_barrier_complete(bar, b.x, nloc, nx); b.st[0] = nloc; b.st[1] = nx; }
        const unsigned old = xb_add(&bar[XB_XSUB(b.x)], 1u);
        const unsigned gen = old / nloc;
        if (old + 1u == (gen + 1u) * nloc) {
            __builtin_amdgcn_fence(__ATOMIC_RELEASE, "agent");
            asm volatile("s_waitcnt vmcnt(0)" ::: "memory");
            const unsigned og = xb_add(&bar[XB_TOP], 1u);
            const unsigned tg = og / nx;
            if (og + 1u == (tg + 1u) * nx) xb_add(&bar[XB_TOPGEN], 1u);
            else XB_SPIN(xb_ld(&bar[XB_TOPGEN]) == tg, bar);
            __builtin_amdgcn_fence(__ATOMIC_ACQUIRE, "agent");
            xb_add(&bar[XB_XGEN(b.x)], 1u);
            asm volatile("s_waitcnt vmcnt(0)" ::: "memory");
        } else {
            XB_SPIN(xb_ld(&bar[XB_XGEN(b.x)]) == gen, bar);
            __builtin_amdgcn_fence(__ATOMIC_ACQUIRE, "agent");
            asm volatile("s_waitcnt vmcnt(0)" ::: "memory");
        }
    }
    __syncthreads();
}

#define REP_P0 1
#define REP_G1 1
#define REP_P2 1
#define REP_SB 1
#define REP_WIN 1
#define REP_CMP 1
#define REP_SLC 1
#define REP_G2 1
#define XSYNC 0
__global__ void __launch_bounds__(512, 2) hybrid_fwd(Args A) {
    extern __shared__ __attribute__((aligned(16))) unsigned char lds_raw[];
    LAS unsigned char* lds = (LAS unsigned char*)lds_raw;
    cg::grid_group grid = cg::this_grid();
    const int wv_ = __builtin_amdgcn_readfirstlane((int)threadIdx.x >> 6);
    volatile LAS unsigned* bst = (volatile LAS unsigned*)(lds + 131072 + 64);
    if (TIDX < 2) bst[TIDX] = 0u;
    __syncthreads();
    XcdBarrier xbar = xcd_barrier_post((unsigned*)(A.ws + WS_CTL), bst, wv_);
    if (A.ws == nullptr) grid.sync();
#define GSYNC() xcd_barrier(xbar, wv_)
    unsigned char* ws = A.ws;
    const int G = gridDim.x, bx = blockIdx.x;

    for (int rep = 0; rep < REP_P0; ++rep) phase0(A, lds, wv_);
    GSYNC();
    for (int rep = 0; rep < XSYNC; ++rep) GSYNC();
#pragma unroll 1
    for (int rep = 0; rep < REP_G1; ++rep) {
        pg8::Gemm g{(const pg8::bf16_t*)(ws + WS_XB), (const pg8::bf16_t*)(ws + WS_WIN), NTOK, NCP, DM}; pg8::StaticOrder S; S.init(NTOK, NCP, G, bx);
        pg8::EpiProj E{(pg8::bf16_t*)(ws + WS_P), NCP, (const float*)(ws + WS_RSTD)};
        pg8::gemm_phase<pg8::EpiProj, pg8::StaticOrder, true, true>(lds, g, S, E, wv_);
    }
    GSYNC();
    if (G != 256) {
        for (int it = bx; it < 128; it += G) compress_item(A, lds, it, wv_);
        phase2_normrope(A, wv_, bx * 8 + wv_, G * 8);
        GSYNC();
    }
    if (G == 256) {
        const int x = bx & 7, j = bx >> 3;
        if (j >= 16) compress_item(A, lds, ((j - 16) >> 3) * 64 + (x >> 1) * 16 + (x & 1) * 8 + (j & 7), wv_);
        else knorm_bg(A, wv_, x, j * 8 + wv_, 16 * 8);
        group_arrive((unsigned*)(ws + WS_CTL) + 3584 + 64 * x, wv_);
    }
    for (int rep = 0; rep < REP_SB; ++rep) for (int it = bx; it < 512; it += G) {
        int item = it;
        if (G == 256) { const int x = bx & 7, idx = (bx >> 3) * 2 + (it >> 8); item = (x * 4 + (idx >> 4)) * 16 + (idx & 15); }
        attn_item<M_SB>(A, lds, item, wv_);
    }
    if (G == 256) group_wait((unsigned*)(ws + WS_CTL) + 3584 + 64 * (bx & 7), 32u, wv_);
    for (int rep = 0; rep < REP_SLC; ++rep) for (int it = bx; it < 512; it += G) {
        int item;
        if (G == 256) { const int x = bx & 7, j = bx >> 3; item = x * 64 + ((it >> 8) ? 31 - j : 32 + j); }
        else { if (it < 256) item = (it >> 5) * 64 + 32 + (it & 31); else item = ((it - 256) >> 5) * 64 + 31 - ((it - 256) & 31); }
        nsa_item(A, lds, item, wv_);
    }
    GSYNC();
    for (int rep = 0; rep < REP_G2; ++rep) {
        pg8::Gemm g{(const pg8::bf16_t*)(ws + WS_XB), (const pg8::bf16_t*)(ws + WS_WOUT), NTOK, DM, DM}; pg8::StaticOrder S; S.init(NTOK, DM, G, bx);
        pg8::EpiOut E{A.in[0], A.out, DM};
        pg8::gemm_phase<pg8::EpiOut, pg8::StaticOrder, true, true>(lds, g, S, E, wv_);
    }
}

extern "C" void kernel_launch(void* const* d_in, const int* in_sizes, int n_in, void* d_out, int out_size, void* d_ws, size_t ws_size, hipStream_t stream) {
    static int grid = 0;
    if (grid == 0) {
        if (n_in != 16 || ws_size < WS_END) { fprintf(stderr, "kernel_launch: unexpected inputs (n_in %d, ws %zu)\n", n_in, ws_size); grid = -1; return; }
        int dev = 0, cus = 0, per_cu = 0;
        hipGetDevice(&dev);
        hipDeviceGetAttribute(&cus, hipDeviceAttributeMultiprocessorCount, dev);
        if (hipFuncSetAttribute((const void*)hybrid_fwd, hipFuncAttributeMaxDynamicSharedMemorySize, LDS_BYTES) != hipSuccess) { fprintf(stderr, "kernel_launch: hipFuncSetAttribute failed\n"); }
        hipOccupancyMaxActiveBlocksPerMultiprocessor(&per_cu, (const void*)hybrid_fwd, 512, LDS_BYTES);
        if (per_cu < 1) { fprintf(stderr, "kernel_launch: occupancy query says %d blocks/CU\n", per_cu); per_cu = 1; }
        (void)hipGetLastError();
        grid = cus * 1;
    }
    if (grid < 0) return;
    Args a{};
    for (int i = 0; i < 16; ++i) a.in[i] = (const float*)d_in[i];
    a.out = (float*)d_out; a.ws = (unsigned char*)d_ws;
    for (int i = 0; i < 8; ++i) a.invf[i] = std::pow(500000.0, -(double)(2 * i) / 16.0) / 6.283185307179586476925;
    if (hipMemsetAsync((char*)d_ws + WS_CTL, 0, 16384, stream) != hipSuccess) { fprintf(stderr, "kernel_launch: memset failed\n"); return; }
    void* args[] = {&a};
    hipError_t e = hipLaunchCooperativeKernel((const void*)hybrid_fwd, dim3(grid), dim3(512), args, LDS_BYTES, stream);
    if (e != hipSuccess) fprintf(stderr, "cooperative launch failed: %s (grid %d)\n", hipGetErrorString(e), grid);
}
```
